# Optimizing an MI355X kernel written in HIP

```python
import math
import jax, jax.numpy as jnp
from jax import lax
import numpy as np

D_MODEL = 1024
BATCH = 4
SEQ = 8192
DEPTH = 2

N_EVEN = (DEPTH + 1) // 2
N_ODD = DEPTH // 2
D_FF = 2816
FFN_RES = 0.5
NORM_EPS = 1e-6
CHUNK = 64
CONV_W = 4

GLA_HEADS = 4
GLA_DK = 64
GLA_DV = 128
GLA_LORA = 16
GLA_GATE_NORM = 16.0
GLA_QK = GLA_HEADS * GLA_DK
GLA_V = GLA_HEADS * GLA_DV
GDN_HEADS = 4
GDN_DK = 128
GDN_DV = 128
GDN_QK = GDN_HEADS * GDN_DK
GDN_V = GDN_HEADS * GDN_DV
GDN_CONV_CH = 2 * GDN_QK + GDN_V
RWKV_HEADS = 8
RWKV_N = 64
RWKV_W = RWKV_HEADS * RWKV_N
RWKV_W_LORA = 64
RWKV_A_LORA = 64
RWKV_G_LORA = 128
RWKV_GN_EPS = 64e-5
RWKV_SHIFT = 3 * RWKV_W + RWKV_W_LORA + RWKV_A_LORA + RWKV_G_LORA
LRU_WIDTH = 512
LRU_BLOCKS = 8
LRU_BW = LRU_WIDTH // LRU_BLOCKS
LRU_C = 8.0

EVEN_SPLITS = (GLA_QK, GLA_QK, GLA_V, GLA_V, GLA_LORA, GDN_CONV_CH, GDN_V, GDN_HEADS, GDN_HEADS)
EVEN_IN = 2 * GLA_QK + 2 * GLA_V + GLA_LORA + GDN_CONV_CH + GDN_V + 2 * GDN_HEADS
EVEN_OUT = GLA_V + GDN_V
RWKV_SPLITS = (RWKV_W, RWKV_W, RWKV_W, RWKV_W_LORA, RWKV_A_LORA, RWKV_G_LORA)
ODD_IN = RWKV_SHIFT + 2 * LRU_WIDTH
ODD_OUT = RWKV_W + LRU_WIDTH

kernel_name = 'hybrid_gla_gdn_rwkv7_rglru_macaron'


def _split(x, sizes):
    out, o = [], 0
    for s in sizes:
        out.append(x[..., o:o + s])
        o += s
    return out


def _rmsnorm(x, w):
    xf = x.astype(jnp.float32)
    y = xf * lax.rsqrt(jnp.mean(xf * xf, -1, keepdims=True) + NORM_EPS) * w
    return y.astype(x.dtype)


def _heads(x, n_heads):
    return x.reshape(x.shape[:-1] + (n_heads, x.shape[-1] // n_heads))


def _l2norm(x):
    xf = x.astype(jnp.float32)
    return xf * lax.rsqrt(jnp.sum(xf * xf, -1, keepdims=True) + NORM_EPS)


def _head_rmsnorm(x, n_heads, w):
    xh = _heads(x.astype(jnp.float32), n_heads)
    xh = xh * lax.rsqrt(jnp.mean(xh * xh, -1, keepdims=True) + NORM_EPS) * w
    return xh.reshape(x.shape).astype(x.dtype)


def _swiglu(x, w_gate, w_up, w_down):
    return (jax.nn.silu(x @ w_gate) * (x @ w_up)) @ w_down


def _causal_dwconv(x, w):
    K, T = w.shape[0], x.shape[1]
    xp = jnp.pad(x, ((0, 0), (K - 1, 0), (0, 0)))
    y = xp[:, 0:T] * w[0]
    for j in range(1, K):
        y = y + xp[:, j:j + T] * w[j]
    return y


def _token_shift(x):
    return jnp.pad(x, ((0, 0), (1, 0), (0, 0)))[:, :-1]


def _to_chunks(x):
    B, T, H, d = x.shape
    return x.reshape(B, T // CHUNK, CHUNK, H, d).transpose(0, 3, 1, 2, 4)


def _from_chunks(o):
    B, H, N, C, d = o.shape
    return o.transpose(0, 2, 3, 1, 4).reshape(B, N * C, H * d)


def _gla_chunked(q, k, v, log_a):
    C = q.shape[-2]
    causal = jnp.tril(jnp.ones((C, C), bool))
    b = jnp.cumsum(log_a, axis=-2)
    q_e = q * jnp.exp(b)
    att = jnp.where(causal, jnp.einsum('bhncd,bhnsd->bhncs', q_e, k * jnp.exp(-b)), 0.0)
    o_intra = jnp.einsum('bhncs,bhnsv->bhncv', att, v)
    b_last = b[..., -1:, :]
    k_dec = k * jnp.exp(b_last - b)
    a_last = jnp.exp(b_last[..., 0, :])

    def step(S, xs):
        qe, kd, vv, al = xs
        o = jnp.einsum('bhcd,bhdv->bhcv', qe, S)
        S = S * al[..., None] + jnp.einsum('bhcd,bhcv->bhdv', kd, vv)
        return S, o

    B, H, _, _, dk = q.shape
    S0 = jnp.zeros((B, H, dk, v.shape[-1]), q.dtype)
    _, o_inter = lax.scan(step, S0, tuple(jnp.moveaxis(t, 2, 0) for t in (q_e, k_dec, v, a_last)))
    return o_intra + jnp.moveaxis(o_inter, 0, 2)


def _gated_delta_chunked(q, k, v, g, beta):
    C, dv = q.shape[-2], v.shape[-1]
    tril = jnp.tril(jnp.ones((C, C), bool))
    strict = jnp.tril(jnp.ones((C, C), bool), -1)
    gc = jnp.cumsum(g, axis=-1)
    diff = gc[..., :, None] - gc[..., None, :]
    decay = jnp.where(tril, jnp.exp(jnp.where(tril, diff, 0.0)), 0.0)
    kb = k * beta[..., None]
    L = jnp.where(strict, jnp.einsum('bhncd,bhnsd->bhncs', kb, k) * decay, 0.0)
    rhs = jnp.concatenate([v * beta[..., None], kb * jnp.exp(gc)[..., None]], -1)
    sol = lax.linalg.triangular_solve(L + jnp.eye(C, dtype=L.dtype), rhs,
                                      left_side=True, lower=True, unit_diagonal=True)
    u, w = sol[..., :dv], sol[..., dv:]
    att = jnp.where(tril, jnp.einsum('bhncd,bhnsd->bhncs', q, k) * decay, 0.0)
    q_e = q * jnp.exp(gc)[..., None]
    k_dec = k * jnp.exp(gc[..., -1:] - gc)[..., None]
    g_last = jnp.exp(gc[..., -1])

    def step(S, xs):
        qe, kd, uu, ww, aa, gl = xs
        v_new = uu - jnp.einsum('bhcd,bhdv->bhcv', ww, S)
        o = jnp.einsum('bhcd,bhdv->bhcv', qe, S) + jnp.einsum('bhcs,bhsv->bhcv', aa, v_new)
        S = S * gl[..., None, None] + jnp.einsum('bhcd,bhcv->bhdv', kd, v_new)
        return S, o

    B, H, _, _, dk = q.shape
    S0 = jnp.zeros((B, H, dk, dv), q.dtype)
    _, o = lax.scan(step, S0, tuple(jnp.moveaxis(t, 2, 0) for t in (q_e, k_dec, u, w, att, g_last)))
    return jnp.moveaxis(o, 0, 2)


def _rwkv7_scan(r, w, k, v, kk, a):
    B, T, H, N = r.shape

    def step(S, xs):
        rt, wt, kt, vt, kkt, at = xs
        sa = jnp.einsum('bhij,bhj->bhi', S, -kkt)
        S = S * wt[:, :, None, :] + sa[..., None] * (kkt * at)[:, :, None, :] + vt[..., None] * kt[:, :, None, :]
        return S, jnp.einsum('bhij,bhj->bhi', S, rt)

    S0 = jnp.zeros((B, H, N, N), r.dtype)
    _, y = lax.scan(step, S0, tuple(jnp.moveaxis(t, 1, 0) for t in (r, w, k, v, kk, a)))
    return jnp.moveaxis(y, 0, 1)


def _linear_scan(a, b):
    def combine(c1, c2):
        a1, b1 = c1
        a2, b2 = c2
        return a1 * a2, a2 * b1 + b2
    _, h = lax.associative_scan(combine, (a, b), axis=1)
    return h


def _even_mixer(h, w_in, w_out, gla_lora_w2, gla_lora_b, gla_norm, gdn_conv, gdn_a_log, gdn_dt_bias, gdn_norm):
    f32 = jnp.float32
    p = h @ w_in
    gq, gk, gv, gg, glr, dqkv, dz, da, db = _split(p, EVEN_SPLITS)
    log_a = jax.nn.log_sigmoid((glr @ gla_lora_w2 + gla_lora_b).astype(f32)) / GLA_GATE_NORM
    o_gla = _gla_chunked(_to_chunks(_heads(gq.astype(f32) * GLA_DK ** -0.5, GLA_HEADS)),
                         _to_chunks(_heads(gk.astype(f32), GLA_HEADS)),
                         _to_chunks(_heads(gv.astype(f32), GLA_HEADS)),
                         _to_chunks(_heads(log_a, GLA_HEADS)))
    y_gla = _head_rmsnorm(_from_chunks(o_gla).astype(h.dtype), GLA_HEADS, gla_norm) * jax.nn.silu(gg)
    c = jax.nn.silu(_causal_dwconv(dqkv, gdn_conv))
    cq, ck, cv = _split(c, (GDN_QK, GDN_QK, GDN_V))
    q = _l2norm(_heads(cq, GDN_HEADS)) * GDN_DK ** -0.5
    k = _l2norm(_heads(ck, GDN_HEADS))
    v = _heads(cv.astype(f32), GDN_HEADS)
    beta = jax.nn.sigmoid(db.astype(f32))
    g = -jnp.exp(gdn_a_log.astype(f32)) * jax.nn.softplus((da + gdn_dt_bias).astype(f32))
    o_gdn = _gated_delta_chunked(_to_chunks(q), _to_chunks(k), _to_chunks(v),
                                 _to_chunks(g[..., None])[..., 0], _to_chunks(beta[..., None])[..., 0])
    y_gdn = _head_rmsnorm(_from_chunks(o_gdn).astype(h.dtype), GDN_HEADS, gdn_norm) * jax.nn.silu(dz)
    return jnp.concatenate([y_gla, y_gdn], -1) @ w_out


def _odd_mixer(h, w_in, w_out, rwkv_mu, rwkv_w0, rwkv_w2, rwkv_a0, rwkv_a2, rwkv_g2, rwkv_k_k, rwkv_k_a,
               rwkv_r_k, rwkv_ln_w, rwkv_ln_b, lru_conv_w, lru_conv_b, lru_wa, lru_ba, lru_wx, lru_bx, lru_lambda):
    f32 = jnp.float32
    B, T, _ = h.shape
    p = h @ w_in
    ps, lx, ly = _split(p, (RWKV_SHIFT, LRU_WIDTH, LRU_WIDTH))
    ps = ps + (_token_shift(ps) - ps) * rwkv_mu
    r, k, v, wl, al, gl = _split(ps, RWKV_SPLITS)
    w = -jax.nn.softplus(-(rwkv_w0 + jnp.tanh(wl) @ rwkv_w2).astype(f32)) - 0.5
    decay = jnp.exp(-jnp.exp(w))
    a = jax.nn.sigmoid(rwkv_a0 + al @ rwkv_a2)
    g = jax.nn.sigmoid(gl) @ rwkv_g2
    kk = _l2norm(_heads(k * rwkv_k_k, RWKV_HEADS))
    k = k * (1.0 + (a - 1.0) * rwkv_k_a)
    rh, kh, vh = _heads(r, RWKV_HEADS), _heads(k, RWKV_HEADS), _heads(v, RWKV_HEADS)
    y = _rwkv7_scan(rh.astype(f32), _heads(decay, RWKV_HEADS), kh.astype(f32), vh.astype(f32),
                    kk, _heads(a, RWKV_HEADS).astype(f32))
    mu = jnp.mean(y, -1, keepdims=True)
    var = jnp.mean(jnp.square(y - mu), -1, keepdims=True)
    y = ((y - mu) * lax.rsqrt(var + RWKV_GN_EPS)).reshape(B, T, RWKV_W) * rwkv_ln_w + rwkv_ln_b
    bonus = (jnp.sum(rh * kh * rwkv_r_k, -1, keepdims=True) * vh).reshape(B, T, RWKV_W)
    y_rwkv = ((y.astype(h.dtype) + bonus) * g)
    xb = _causal_dwconv(lx, lru_conv_w) + lru_conv_b
    xblk = _heads(xb, LRU_BLOCKS)
    gate_r = jax.nn.sigmoid(jnp.einsum('btki,kij->btkj', xblk, lru_wa).reshape(B, T, LRU_WIDTH) + lru_ba).astype(f32)
    gate_i = jax.nn.sigmoid(jnp.einsum('btki,kij->btkj', xblk, lru_wx).reshape(B, T, LRU_WIDTH) + lru_bx).astype(f32)
    log_a = -LRU_C * gate_r * jax.nn.softplus(-lru_lambda.astype(f32))
    mult = jnp.sqrt(jnp.maximum(-jnp.expm1(2.0 * log_a), 0.0))
    hl = _linear_scan(jnp.exp(log_a), mult * gate_i * xb.astype(f32))
    y_lru = hl.astype(h.dtype) * jax.nn.gelu(ly)
    return jnp.concatenate([y_rwkv, y_lru], -1) @ w_out


def setup_inputs(seed: int = 0) -> dict:
    key = jax.random.key(seed)
    ks = jax.random.split(key, 34)
    f32 = jnp.float32

    def nrm(i, shape, scale):
        return jax.random.normal(ks[i], shape, f32) * scale

    def uni(i, shape, lo, hi):
        return jax.random.uniform(ks[i], shape, f32, lo, hi)

    E, O = N_EVEN, N_ODD
    dt = jnp.exp(uni(12, (E, GDN_HEADS), math.log(1e-3), math.log(1e-1)))
    s = uni(33, (O, LRU_WIDTH), 0.9, 0.999) ** (1.0 / LRU_C)
    return {
        'x': nrm(0, (BATCH, SEQ, D_MODEL), 1.0),
        'norm_w': 1.0 + nrm(1, (DEPTH, 6, D_MODEL), 0.05),
        'ffn_w_gate': nrm(2, (DEPTH, 2, D_MODEL, D_FF), D_MODEL ** -0.5),
        'ffn_w_up': nrm(3, (DEPTH, 2, D_MODEL, D_FF), D_MODEL ** -0.5),
        'ffn_w_down': nrm(4, (DEPTH, 2, D_FF, D_MODEL), D_FF ** -0.5),
        'even_w_in': nrm(5, (E, D_MODEL, EVEN_IN), D_MODEL ** -0.5),
        'even_w_out': nrm(6, (E, EVEN_OUT, D_MODEL), EVEN_OUT ** -0.5),
        'gla_lora_w2': nrm(7, (E, GLA_LORA, GLA_QK), GLA_LORA ** -0.5),
        'gla_lora_b': nrm(8, (E, GLA_QK), 0.1),
        'gla_norm': 1.0 + nrm(9, (E, GLA_DV), 0.05),
        'gdn_conv': nrm(10, (E, CONV_W, GDN_CONV_CH), CONV_W ** -0.5),
        'gdn_a_log': jnp.log(uni(11, (E, GDN_HEADS), 1.0, 16.0)),
        'gdn_dt_bias': dt + jnp.log(-jnp.expm1(-dt)),
        'gdn_norm': 1.0 + nrm(13, (E, GDN_DV), 0.05),
        'odd_w_in': nrm(14, (O, D_MODEL, ODD_IN), D_MODEL ** -0.5),
        'odd_w_out': nrm(15, (O, ODD_OUT, D_MODEL), ODD_OUT ** -0.5),
        'rwkv_mu': uni(16, (O, RWKV_SHIFT), 0.0, 1.0),
        'rwkv_w0': -6.5 + 5.0 * jnp.linspace(0.0, 1.0, RWKV_W, dtype=f32) ** 0.85 + nrm(17, (O, RWKV_W), 0.05),
        'rwkv_w2': nrm(18, (O, RWKV_W_LORA, RWKV_W), RWKV_W_LORA ** -0.5),
        'rwkv_a0': nrm(19, (O, RWKV_W), 0.1),
        'rwkv_a2': nrm(20, (O, RWKV_A_LORA, RWKV_W), RWKV_A_LORA ** -0.5),
        'rwkv_g2': nrm(21, (O, RWKV_G_LORA, RWKV_W), RWKV_G_LORA ** -0.5),
        'rwkv_k_k': 0.85 + nrm(22, (O, RWKV_W), 0.05),
        'rwkv_k_a': 1.0 + nrm(23, (O, RWKV_W), 0.05),
        'rwkv_r_k': nrm(24, (O, RWKV_HEADS, RWKV_N), 0.1),
        'rwkv_ln_w': 1.0 + nrm(25, (O, RWKV_W), 0.05),
        'rwkv_ln_b': nrm(26, (O, RWKV_W), 0.02),
        'lru_conv_w': nrm(27, (O, CONV_W, LRU_WIDTH), CONV_W ** -0.5),
        'lru_conv_b': nrm(28, (O, LRU_WIDTH), 0.02),
        'lru_wa': nrm(29, (O, LRU_BLOCKS, LRU_BW, LRU_BW), LRU_BW ** -0.5),
        'lru_ba': nrm(30, (O, LRU_WIDTH), 0.02),
        'lru_wx': nrm(31, (O, LRU_BLOCKS, LRU_BW, LRU_BW), LRU_BW ** -0.5),
        'lru_bx': nrm(32, (O, LRU_WIDTH), 0.02),
        'lru_lambda': jnp.log(s) - jnp.log1p(-s),
    }


def reference(x, norm_w, ffn_w_gate, ffn_w_up, ffn_w_down, even_w_in, even_w_out, gla_lora_w2, gla_lora_b,
              gla_norm, gdn_conv, gdn_a_log, gdn_dt_bias, gdn_norm, odd_w_in, odd_w_out, rwkv_mu, rwkv_w0,
              rwkv_w2, rwkv_a0, rwkv_a2, rwkv_g2, rwkv_k_k, rwkv_k_a, rwkv_r_k, rwkv_ln_w, rwkv_ln_b,
              lru_conv_w, lru_conv_b, lru_wa, lru_ba, lru_wx, lru_bx, lru_lambda):
    for i in range(DEPTH):
        j = i // 2
        hh = _rmsnorm(x, norm_w[i, 0])
        x = x + FFN_RES * _rmsnorm(_swiglu(hh, ffn_w_gate[i, 0], ffn_w_up[i, 0], ffn_w_down[i, 0]), norm_w[i, 1])
        hh = _rmsnorm(x, norm_w[i, 2])
        if i % 2 == 0:
            m = _even_mixer(hh, even_w_in[j], even_w_out[j], gla_lora_w2[j], gla_lora_b[j], gla_norm[j],
                            gdn_conv[j], gdn_a_log[j], gdn_dt_bias[j], gdn_norm[j])
        else:
            m = _odd_mixer(hh, odd_w_in[j], odd_w_out[j], rwkv_mu[j], rwkv_w0[j], rwkv_w2[j], rwkv_a0[j],
                           rwkv_a2[j], rwkv_g2[j], rwkv_k_k[j], rwkv_k_a[j], rwkv_r_k[j], rwkv_ln_w[j],
                           rwkv_ln_b[j], lru_conv_w[j], lru_conv_b[j], lru_wa[j], lru_ba[j], lru_wx[j],
                           lru_bx[j], lru_lambda[j])
        x = x + _rmsnorm(m, norm_w[i, 3])
        hh = _rmsnorm(x, norm_w[i, 4])
        x = x + FFN_RES * _rmsnorm(_swiglu(hh, ffn_w_gate[i, 1], ffn_w_up[i, 1], ffn_w_down[i, 1]), norm_w[i, 5])
    return x
```

```cpp
#include <hip/hip_runtime.h>
#include <hip/hip_fp16.h>
#include <hip/hip_cooperative_groups.h>
#include <cstdio>
namespace cg = cooperative_groups;

typedef _Float16 h16;
typedef h16 h16x8 __attribute__((ext_vector_type(8)));
typedef h16 h16x4 __attribute__((ext_vector_type(4)));
typedef float f32x16 __attribute__((ext_vector_type(16)));
typedef unsigned int u32x4 __attribute__((ext_vector_type(4)));
typedef float f32x4 __attribute__((ext_vector_type(4)));

#define MTOK 32768
#define SEQ 8192
#define DM 1024
#define DFF 2816
#define EIN 3608
#define EINP 3712
#define OIN 2816

#define MIB ((size_t)1 << 20)
#define OFF_WB   ((size_t)0)
#define OFF_HH   (48 * MIB)
#define OFF_BIG  (112 * MIB)
#define OFF_DM   (344 * MIB)
#define OFF_ELA  (OFF_DM)
#define OFF_GQ   (OFF_DM + 16 * MIB)
#define OFF_GK   (OFF_DM + 48 * MIB)
#define OFF_GV   (OFF_DM + 80 * MIB)
#define OFF_AB   (OFF_DM + 112 * MIB)
#define OFF_KK   (OFF_HH)
#define OFF_KKA  (OFF_HH + 32 * MIB)
#define OFF_W16  (288 * MIB)
#define OFF_KP   (320 * MIB)
#define OFF_R    (352 * MIB)
#define OFF_V    (384 * MIB)
#define OFF_LLA  (416 * MIB)
#define OFF_LB   (448 * MIB)
#define OFF_BON  (480 * MIB)
#define WGU0 0
#define WD0  5767168
#define WGU1 8650752
#define WD1  14417920
#define WIN  17301504
#define WOUT 21233664

#define SMEM_BYTES 45056
#define NPHASE 25
#define DUPMASK 0x0

struct Params {
  const float* in[34];
  float* out;
  char* ws;
};

__device__ __forceinline__ int get_tid() { int t = threadIdx.x & 255; asm volatile("" : "+v"(t)); return t; }
__device__ __forceinline__ int get_bid() { int t = blockIdx.x * 2 + __builtin_amdgcn_readfirstlane(threadIdx.x >> 8); asm volatile("" : "+s"(t)); return t; }
__device__ __forceinline__ int real_tid() { int t = threadIdx.x; asm volatile("" : "+v"(t)); return t; }
__device__ __forceinline__ int real_bid() { int t = blockIdx.x; asm volatile("" : "+s"(t)); return t; }
#define VGRID ((int)gridDim.x * 2)
__device__ __forceinline__ float sigm(float x) { return __builtin_amdgcn_rcpf(1.f + __expf(-x)); }
__device__ __forceinline__ float softplus_(float x) { return fmaxf(x, 0.f) + __logf(1.f + __expf(-fabsf(x))); }
__device__ __forceinline__ float silu_(float x) { return x * __builtin_amdgcn_rcpf(1.f + __expf(-x)); }
__device__ __forceinline__ float fast_tanh(float u) { return 1.f - 2.f * __builtin_amdgcn_rcpf(1.f + __expf(2.f * u)); }
__device__ __forceinline__ float gelu_tanh(float x) {
  float u = 0.7978845608028654f * (x + 0.044715f * x * x * x);
  return 0.5f * x * (1.f + fast_tanh(u));
}

template <int CTRL>
__device__ __forceinline__ float dpp_f(float x) {
  return __int_as_float(__builtin_amdgcn_update_dpp(0, __float_as_int(x), CTRL, 0xF, 0xF, true));
}
__device__ __forceinline__ float reduce16(float x) {
  x += dpp_f<0xB1>(x);
  x += dpp_f<0x4E>(x);
  x += dpp_f<0x141>(x);
  x += dpp_f<0x140>(x);
  return x;
}

__device__ __forceinline__ float wave_sum(float v) {
  v = reduce16(v);
  const int vi = __float_as_int(v);
  float t = __int_as_float(__builtin_amdgcn_readlane(vi, 0));
  t += __int_as_float(__builtin_amdgcn_readlane(vi, 16));
  t += __int_as_float(__builtin_amdgcn_readlane(vi, 32));
  t += __int_as_float(__builtin_amdgcn_readlane(vi, 48));
  return t;
}

#define LDS_BARRIER() do { asm volatile("s_waitcnt lgkmcnt(0)" ::: "memory"); __builtin_amdgcn_s_barrier(); asm volatile("" ::: "memory"); } while (0)

__device__ void conv_tile(const float* __restrict__ src, int K, int N, h16* __restrict__ dst, int mode, int kt, int nt,
                          float* sm) {
  const int tid = get_tid();
#pragma unroll
  for (int i = 0; i < 4; i++) {
    const int idx = tid + i * 256, r = idx >> 4, c4 = (idx & 15) * 4;
    const int n = nt * 64 + c4;
    f32x4 v = {0.f, 0.f, 0.f, 0.f};
    if (n < N) v = *(const f32x4*)(src + (size_t)(kt * 64 + r) * N + n);
#pragma unroll
    for (int e = 0; e < 4; e++) sm[r * 65 + c4 + e] = v[e];
  }
  LDS_BARRIER();
#pragma unroll
  for (int i = 0; i < 2; i++) {
    const int idx = tid + i * 256, nl = idx >> 3, kc = (idx & 7) * 8;
    const int n = nt * 64 + nl;
    const int row = (mode == 0) ? n : ((n >> 4) * 32 + (mode - 1) * 16 + (n & 15));
    h16x8 o;
#pragma unroll
    for (int j = 0; j < 8; j++) o[j] = (h16)sm[(kc + j) * 65 + nl];
    *(h16x8*)(dst + (size_t)row * K + kt * 64 + kc) = o;
  }
  LDS_BARRIER();
}

__device__ void convert_weights(const Params& p, int L, float* sm) {
  h16* wb = (h16*)(p.ws + OFF_WB);
  const int T_G = 16 * 44, T_D = 44 * 16;
  const int T_F = 2 * T_G + T_D;
  const int nin = (L == 0) ? 60 : 44;
  const int T_IN = 16 * nin, T_OUT = 256;
  const int total = 2 * T_F + T_IN + T_OUT;
  for (int j = get_bid(); j < total; j += VGRID) {
    int q = j;
    const float* src; int K, N, mode, ntn; h16* dst;
    if (q < 2 * T_F) {
      int f = q / T_F; q -= f * T_F;
      int lf = L * 2 + f;
      if (q < T_G) { src = p.in[2] + (size_t)lf * DM * DFF; K = DM; N = DFF; dst = wb + (f ? WGU1 : WGU0); mode = 1; ntn = 44; }
      else if (q < 2 * T_G) { q -= T_G; src = p.in[3] + (size_t)lf * DM * DFF; K = DM; N = DFF; dst = wb + (f ? WGU1 : WGU0); mode = 2; ntn = 44; }
      else { q -= 2 * T_G; src = p.in[4] + (size_t)lf * DFF * DM; K = DFF; N = DM; dst = wb + (f ? WD1 : WD0); mode = 0; ntn = 16; }
    } else {
      q -= 2 * T_F;
      if (q < T_IN) { src = (L == 0) ? p.in[5] : p.in[14]; K = DM; N = (L == 0) ? EIN : OIN; dst = wb + WIN; mode = 0; ntn = nin; }
      else { q -= T_IN; src = (L == 0) ? p.in[6] : p.in[15]; K = DM; N = DM; dst = wb + WOUT; mode = 0; ntn = 16; }
    }
    int kt = q / ntn, nt = q % ntn;
    conv_tile(src, K, N, dst, mode, kt, nt, sm);
  }
}

__device__ void row_phase(const float* __restrict__ xin, const h16* __restrict__ Dmat, const float* __restrict__ wpost,
                          float res, const float* __restrict__ wpre, float* __restrict__ xout, h16* __restrict__ hh, int dry = 0) {
  const int lane = get_tid() & 63;
  const int gw = get_bid() * 4 + (get_tid() >> 6);
  const int nw = VGRID * 4;
  float4 nx[4];
  h16x4 nd[4];
  if (gw < MTOK) {
#pragma unroll
    for (int i = 0; i < 4; i++) {
      nx[i] = *(const float4*)(xin + (size_t)gw * DM + i * 256 + lane * 4);
      if (Dmat) nd[i] = *(const h16x4*)(Dmat + (size_t)gw * DM + i * 256 + lane * 4);
    }
  }
  for (int row = gw; row < MTOK; row += nw) {
    float4 xv[4];
    h16x4 dh[4];
#pragma unroll
    for (int i = 0; i < 4; i++) { xv[i] = nx[i]; dh[i] = nd[i]; }
    const int nrow = row + nw;
    if (nrow < MTOK) {
#pragma unroll
      for (int i = 0; i < 4; i++) {
        nx[i] = *(const float4*)(xin + (size_t)nrow * DM + i * 256 + lane * 4);
        if (Dmat) nd[i] = *(const h16x4*)(Dmat + (size_t)nrow * DM + i * 256 + lane * 4);
      }
    }
    if (Dmat) {
      float4 dv[4];
      float ss = 0.f;
#pragma unroll
      for (int i = 0; i < 4; i++) {
        dv[i].x = (float)dh[i][0]; dv[i].y = (float)dh[i][1]; dv[i].z = (float)dh[i][2]; dv[i].w = (float)dh[i][3];
        ss += dv[i].x * dv[i].x + dv[i].y * dv[i].y + dv[i].z * dv[i].z + dv[i].w * dv[i].w;
      }
      ss = wave_sum(ss);
      float inv = rsqrtf(ss * (1.f / DM) + 1e-6f) * res;
#pragma unroll
      for (int i = 0; i < 4; i++) {
        float4 w = *(const float4*)(wpost + i * 256 + lane * 4);
        xv[i].x += dv[i].x * inv * w.x; xv[i].y += dv[i].y * inv * w.y;
        xv[i].z += dv[i].z * inv * w.z; xv[i].w += dv[i].w * inv * w.w;
        if (!dry) *(float4*)(xout + (size_t)row * DM + i * 256 + lane * 4) = xv[i];
      }
    }
    if (hh) {
      float ss = 0.f;
#pragma unroll
      for (int i = 0; i < 4; i++) ss += xv[i].x * xv[i].x + xv[i].y * xv[i].y + xv[i].z * xv[i].z + xv[i].w * xv[i].w;
      ss = wave_sum(ss);
      float inv = rsqrtf(ss * (1.f / DM) + 1e-6f);
#pragma unroll
      for (int i = 0; i < 4; i++) {
        float4 w = *(const float4*)(wpre + i * 256 + lane * 4);
        h16x4 o;
        o[0] = (h16)(xv[i].x * inv * w.x); o[1] = (h16)(xv[i].y * inv * w.y);
        o[2] = (h16)(xv[i].z * inv * w.z); o[3] = (h16)(xv[i].w * inv * w.w);
        if (!dry) *(h16x4*)(hh + (size_t)row * DM + i * 256 + lane * 4) = o;
      }
    }
  }
}

typedef float f32x4v __attribute__((ext_vector_type(4)));
#define G_BM 256
#define G_BK 64
#define G_HALF 128
#define G_HT (G_HALF * G_BK)
__device__ __forceinline__ int lds_byte(int r, int c) {
  int st = (r >> 4) * 2 + (c >> 5), rr = r & 15, cc = c & 31, ob = rr * 64 + cc * 2;
  return st * 1024 + (ob ^ (((ob >> 9) & 1) << 5));
}
__device__ __forceinline__ void stage_rc(int b, int& R, int& C) {
  int st = b / 1024, sb = b % 1024, swz = sb ^ (((sb >> 9) & 1) << 5);
  R = (st >> 1) * 16 + swz / 64; C = (st & 1) * 32 + (swz % 64) / 2;
}
template <int EPI>
__device__ void gemm_phase(const h16* __restrict__ A, const h16* __restrict__ Bt, int K, int nM, int nN,
                           void* __restrict__ Cout, int ldc, int ncv, char* smem) {
  h16* shm = (h16*)smem;
#define SA(b, h) (shm + ((b) * 2 + (h)) * G_HT)
#define SB(b, h) (shm + (4 + (b) * 2 + (h)) * G_HT)
#define STAGE(P, BASE, br, kt) do { const char* _gb = (const char*)(BASE) + ((long)(br) * K + (long)(kt) * G_BK) * 2; \
    __builtin_amdgcn_global_load_lds((const unsigned*)(_gb + voff), (unsigned*)((char*)(P) + tid * 16), 16, 0, 0); \
    __builtin_amdgcn_global_load_lds((const unsigned*)(_gb + (long)K * 128 + voff), (unsigned*)((char*)(P) + tid * 16 + 8192), 16, 0, 0); } while (0)
#define LDA(dst, b, h) for (int m = 0; m < 4; ++m) for (int k = 0; k < 2; ++k) \
    dst[m][k] = *reinterpret_cast<const h16x8*>((char*)SA(b, h) + lds_byte(wr * 64 + m * 16 + fr, k * 32 + fq * 8))
#define LDB(dst, b, h) for (int n = 0; n < 2; ++n) for (int k = 0; k < 2; ++k) \
    dst[n][k] = *reinterpret_cast<const h16x8*>((char*)SB(b, h) + lds_byte(wc * 32 + n * 16 + fr, k * 32 + fq * 8))
#define MMA(ai, bj, At_, Bt_) do { __builtin_amdgcn_s_setprio(1); \
    for (int m = 0; m < 4; ++m) for (int n = 0; n < 2; ++n) for (int k = 0; k < 2; ++k) \
      acc[ai][bj][m][n] = __builtin_amdgcn_mfma_f32_16x16x32_f16(Bt_[n][k], At_[m][k], acc[ai][bj][m][n], 0, 0, 0); \
    __builtin_amdgcn_s_setprio(0); } while (0)
#define WAIT_V(n) asm volatile("s_waitcnt vmcnt(" #n ")" ::: "memory")
#define WAIT_L(n) asm volatile("s_waitcnt lgkmcnt(" #n ")" ::: "memory")
#define BAR __builtin_amdgcn_s_barrier()
#define SCHED __builtin_amdgcn_sched_barrier(0)
  const int tid = real_tid();
  const int G = gridDim.x;
  const int nwg = nM * nN;
  const int wid = tid >> 6, lane = tid & 63, wr = wid >> 2, wc = wid & 3, fr = lane & 15, fq = lane >> 4;
  const int nt = K / G_BK;
  unsigned voff;
  { int R0, C0; stage_rc(tid * 16, R0, C0); voff = (unsigned)((R0 * K + C0) * 2); }
  for (int L = real_bid(); L < nwg; L += G) {
    int wgid = L;
    { int q = nwg / 8, r = nwg % 8, xcd = wgid % 8, off = wgid / 8;
      wgid = (xcd < r ? xcd * (q + 1) : r * (q + 1) + (xcd - r) * q) + off; }
    const int nig = 4 * nN, gid = wgid / nig, fm = gid * 4, gsz = min(nM - fm, 4);
    const int pm = fm + ((wgid % nig) % gsz), pn = (wgid % nig) / gsz, brow = pm * G_BM, bcol = pn * G_BM;
    f32x4v acc[2][2][4][2];
#pragma unroll
    for (int a_ = 0; a_ < 2; a_++)
#pragma unroll
      for (int b_ = 0; b_ < 2; b_++)
#pragma unroll
        for (int m = 0; m < 4; m++)
#pragma unroll
          for (int n = 0; n < 2; n++) acc[a_][b_][m][n] = f32x4v{0.f, 0.f, 0.f, 0.f};
    h16x8 At[4][2], B0[2][2], B1[2][2];
    WAIT_V(0);
    __syncthreads();
    STAGE(SB(0, 0), Bt, bcol, 0); STAGE(SA(0, 0), A, brow, 0);
    STAGE(SB(0, 1), Bt, bcol + G_HALF, 0); STAGE(SA(0, 1), A, brow + G_HALF, 0);
    if (wr == 1) BAR;
    WAIT_V(4); BAR;
    STAGE(SB(1, 0), Bt, bcol, 1); STAGE(SA(1, 0), A, brow, 1); STAGE(SB(1, 1), Bt, bcol + G_HALF, 1);
    WAIT_V(6); BAR;
    for (int t = 0; t < nt - 2; t += 2) {
      LDB(B0, 0, 0); SCHED; LDA(At, 0, 0); STAGE(SA(1, 1), A, brow + G_HALF, t + 1);
      WAIT_L(8); BAR; WAIT_L(0); MMA(0, 0, At, B0); BAR; SCHED;
      LDB(B1, 0, 1); STAGE(SB(0, 0), Bt, bcol, t + 2);
      BAR; WAIT_L(0); MMA(0, 1, At, B1); BAR;
      LDA(At, 0, 1); STAGE(SA(0, 0), A, brow, t + 2);
      BAR; WAIT_L(0); MMA(1, 0, At, B0); BAR; SCHED;
      STAGE(SB(0, 1), Bt, bcol + G_HALF, t + 2);
      WAIT_V(6); BAR; MMA(1, 1, At, B1); BAR;
      LDB(B0, 1, 0); SCHED; LDA(At, 1, 0); STAGE(SA(0, 1), A, brow + G_HALF, t + 2);
      WAIT_L(8); BAR; WAIT_L(0); MMA(0, 0, At, B0); BAR; SCHED;
      LDB(B1, 1, 1); STAGE(SB(1, 0), Bt, bcol, t + 3);
      BAR; WAIT_L(0); MMA(0, 1, At, B1); BAR;
      LDA(At, 1, 1); STAGE(SA(1, 0), A, brow, t + 3);
      BAR; WAIT_L(0); MMA(1, 0, At, B0); BAR; SCHED;
      STAGE(SB(1, 1), Bt, bcol + G_HALF, t + 3);
      WAIT_V(6); BAR; MMA(1, 1, At, B1); BAR;
    }
    { LDB(B0, 0, 0); LDA(At, 0, 0); STAGE(SA(1, 1), A, brow + G_HALF, nt - 1);
      BAR; WAIT_L(0); MMA(0, 0, At, B0); BAR;
      LDB(B1, 0, 1); BAR; WAIT_L(0); MMA(0, 1, At, B1); BAR;
      LDA(At, 0, 1); WAIT_V(4); BAR; WAIT_L(0); MMA(1, 0, At, B0); MMA(1, 1, At, B1); BAR; }
    { LDB(B0, 1, 0); LDA(At, 1, 0); WAIT_V(2); BAR; WAIT_L(0); MMA(0, 0, At, B0); BAR;
      LDB(B1, 1, 1); WAIT_V(0); BAR; WAIT_L(0); MMA(0, 1, At, B1); BAR;
      LDA(At, 1, 1); BAR; WAIT_L(0); MMA(1, 0, At, B0); MMA(1, 1, At, B1); BAR; }
    if (wr == 0) BAR;
#pragma unroll
    for (int ai = 0; ai < 2; ++ai)
#pragma unroll
      for (int bj = 0; bj < 2; ++bj)
#pragma unroll
        for (int m = 0; m < 4; ++m) {
          const long row = brow + ai * G_HALF + wr * 64 + m * 16 + fr;
          if (EPI == 2) {
            const f32x4v g = acc[ai][bj][m][0], u = acc[ai][bj][m][1];
            const int col = (bcol >> 1) + bj * 64 + wc * 16 + fq * 4;
            h16x4 o;
#pragma unroll
            for (int j = 0; j < 4; ++j) o[j] = (h16)(silu_(g[j]) * u[j]);
            *(h16x4*)((h16*)Cout + row * ldc + col) = o;
          } else {
#pragma unroll
            for (int n = 0; n < 2; ++n) {
              const int col = bcol + bj * G_HALF + wc * 32 + n * 16 + fq * 4;
              if (EPI == 0) {
                *(f32x4v*)((float*)Cout + row * ldc + col) = acc[ai][bj][m][n];
              } else if (col < ncv) {
                h16x4 o;
#pragma unroll
                for (int j = 0; j < 4; ++j) o[j] = (h16)acc[ai][bj][m][n][j];
                *(h16x4*)((h16*)Cout + row * ldc + col) = o;
              }
            }
          }
        }
  }
#undef SA
#undef SB
}

#define TT 32
template <int MODE> struct ScanCfg;
template <> struct ScanCfg<0> { static constexpr int NF = 200, E = 2, NA = 3, VOFF = 192; };
template <> struct ScanCfg<1> { static constexpr int NF = 268, E = 4, NA = 4, VOFF = 256; };
template <> struct ScanCfg<2> { static constexpr int NF = 328, E = 2, NA = 5, VOFF = 320; };
typedef float f32x2 __attribute__((ext_vector_type(2)));

__device__ __forceinline__ float reduce32(float x) {
  x = reduce16(x);
  const unsigned xi = __float_as_uint(x);
  auto r = __builtin_amdgcn_permlane32_swap(xi, xi, false, false);
  return __uint_as_float(r[0]) + __uint_as_float(r[1]);
}

template <int MODE>
__device__ void scan_task(const Params& p, int task, char* smem, int dry) {
  constexpr int NF = ScanCfg<MODE>::NF, E = ScanCfg<MODE>::E, NA = ScanCfg<MODE>::NA, VOFF = ScanCfg<MODE>::VOFF;
  float* rec = (float*)smem;
  const int tid = get_tid(), lane = tid & 63, wave = tid >> 6;
  const int sub = (lane & 15) + ((lane >> 5) << 4), row = wave * 2 + ((lane >> 4) & 1);
  int b, h, rowbase;
  if (MODE == 2) { int bh = task >> 3; b = bh >> 3; h = bh & 7; rowbase = (task & 7) * 8; }
  else { int bh = task >> 4; b = bh >> 2; h = bh & 3; rowbase = (task & 15) * 8; }
  char* ws = p.ws;
  const size_t bS = (size_t)b * SEQ;

  const h16* src[NA];
  int dsto[NA];
  int ldm;
  const h16* srcv;
  int ldv;
  const int tokv = tid & 31;
  const int dstv = tokv * NF + VOFF;
  if (MODE == 0) {
    const int tok = tid >> 3, ch = tid & 7;
    const h16* P = (const h16*)(ws + OFF_BIG);
    src[0] = (const h16*)(ws + OFF_ELA) + (bS + tok) * 256 + h * 64 + ch * 8;
    src[1] = P + (bS + tok) * EINP + 256 + h * 64 + ch * 8;
    src[2] = P + (bS + tok) * EINP + h * 64 + ch * 8;
    for (int a = 0; a < NA; a++) dsto[a] = tok * NF + a * 64 + ch * 8;
    ldm = EINP;
    srcv = P + (bS + tokv) * EINP + 512 + h * 128 + rowbase; ldv = EINP;
  } else if (MODE == 1) {
    for (int a = 0; a < NA; a++) {
      const int idx = tid + (a & 1) * 256, tok = idx >> 4, ch = idx & 15;
      src[a] = (const h16*)(ws + (a < 2 ? OFF_GK : OFF_GQ)) + (bS + tok) * 512 + h * 128 + ch * 8;
      dsto[a] = tok * NF + (a < 2 ? 0 : 128) + ch * 8;
    }
    ldm = 512;
    srcv = (const h16*)(ws + OFF_GV) + (bS + tokv) * 512 + h * 128 + rowbase; ldv = 512;
  } else {
    const int tok = tid >> 3, ch = tid & 7;
    for (int a = 0; a < NA; a++) {
      const size_t off = a == 0 ? OFF_W16 : a == 1 ? OFF_KK : a == 2 ? OFF_KKA : a == 3 ? OFF_KP : OFF_R;
      src[a] = (const h16*)(ws + off) + (bS + tok) * 512 + h * 64 + ch * 8;
      dsto[a] = tok * NF + a * 64 + ch * 8;
    }
    ldm = 512;
    srcv = (const h16*)(ws + OFF_V) + (bS + tokv) * 512 + h * 64 + rowbase; ldv = 512;
  }
  const float* srcab = (const float*)(ws + OFF_AB) + ((bS + (tid & 31)) * 4 + h) * 2;

  h16* outp; int ldo;
  if (MODE == 0) { outp = (h16*)(ws + OFF_BIG) + 512 + h * 128 + rowbase; ldo = EINP; }
  else if (MODE == 1) { outp = (h16*)(ws + OFF_GV) + h * 128 + rowbase; ldo = 512; }
  else { outp = (h16*)(ws + OFF_V) + h * 64 + rowbase; ldo = 512; }
  outp += bS * ldo;

  float s[E];
#pragma unroll
  for (int e = 0; e < E; e++) s[e] = 0.f;

  u32x4 pre[NA];
  u32x4 prev = {0u, 0u, 0u, 0u};
  float pab0 = 0.f, pab1 = 0.f;
#pragma unroll
  for (int a = 0; a < NA; a++) pre[a] = *(const u32x4*)(src[a]);
  if (tid < 32) prev = *(const u32x4*)(srcv);
  if (MODE == 1 && tid < 32) { pab0 = srcab[0]; pab1 = srcab[1]; }

  for (int t0 = 0; t0 < SEQ; t0 += TT) {
#pragma unroll
    for (int a = 0; a < NA; a++) {
      h16x8 hv = __builtin_bit_cast(h16x8, pre[a]);
      float f[8];
#pragma unroll
      for (int j = 0; j < 8; j++) {
        float x = (float)hv[j];
        if (MODE == 0 && a == 0) x = __expf(x);
        if (MODE == 0 && a == 2) x *= 0.125f;
        if (MODE == 2 && a == 0) x = __expf(-__expf(x));
        f[j] = x;
      }
      f32x4 lo = {f[0], f[1], f[2], f[3]}, hi = {f[4], f[5], f[6], f[7]};
      *(f32x4*)(rec + dsto[a]) = lo;
      *(f32x4*)(rec + dsto[a] + 4) = hi;
    }
    if (tid < 32) {
      h16x8 hv = __builtin_bit_cast(h16x8, prev);
      f32x4 lo = {(float)hv[0], (float)hv[1], (float)hv[2], (float)hv[3]};
      f32x4 hi = {(float)hv[4], (float)hv[5], (float)hv[6], (float)hv[7]};
      *(f32x4*)(rec + dstv) = lo;
      *(f32x4*)(rec + dstv + 4) = hi;
    }
    if (MODE == 1 && tid < 32) { rec[tid * NF + 264] = pab0; rec[tid * NF + 265] = pab1; }
    LDS_BARRIER();
    if (t0 + TT < SEQ) {
      const size_t tn = (size_t)(t0 + TT);
#pragma unroll
      for (int a = 0; a < NA; a++) {
        const int ld = (MODE == 0 && a == 0) ? 256 : ldm;
        pre[a] = *(const u32x4*)(src[a] + tn * ld);
      }
      if (tid < 32) prev = *(const u32x4*)(srcv + tn * ldv);
      if (MODE == 1 && tid < 32) { pab0 = srcab[tn * 8]; pab1 = srcab[tn * 8 + 1]; }
    }
    float yk = 0.f;
#pragma unroll 1
    for (int hb = 0; hb < TT / 16; hb++) {
      float yp[16];
#pragma unroll
      for (int j = 0; j < 16; j++) {
        const float* rc = rec + (hb * 16 + j) * NF;
        float y;
        if (MODE == 0) {
          f32x2 W = *(const f32x2*)(rc + sub * 2);
          f32x2 Kv = *(const f32x2*)(rc + 64 + sub * 2);
          f32x2 R = *(const f32x2*)(rc + 128 + sub * 2);
          float v = rc[VOFF + row];
          s[0] = fmaf(v, Kv[0], s[0] * W[0]);
          s[1] = fmaf(v, Kv[1], s[1] * W[1]);
          y = s[0] * R[0] + s[1] * R[1];
        } else if (MODE == 1) {
          f32x4 Kv = *(const f32x4*)(rc + sub * 4);
          f32x4 R = *(const f32x4*)(rc + 128 + sub * 4);
          float v = rc[VOFF + row];
          f32x2 ab = *(const f32x2*)(rc + 264);
          const float al = ab[0], be = ab[1];
          float d = (s[0] * Kv[0] + s[1] * Kv[1]) + (s[2] * Kv[2] + s[3] * Kv[3]);
          d = reduce32(d);
          float c = be * (v - al * d);
#pragma unroll
          for (int e = 0; e < 4; e++) s[e] = fmaf(c, Kv[e], al * s[e]);
          y = (s[0] * R[0] + s[1] * R[1]) + (s[2] * R[2] + s[3] * R[3]);
        } else {
          f32x2 W = *(const f32x2*)(rc + sub * 2);
          f32x2 Pv = *(const f32x2*)(rc + 64 + sub * 2);
          f32x2 Av = *(const f32x2*)(rc + 128 + sub * 2);
          f32x2 Kv = *(const f32x2*)(rc + 192 + sub * 2);
          f32x2 R = *(const f32x2*)(rc + 256 + sub * 2);
          float v = rc[VOFF + row];
          float d = s[0] * Pv[0] + s[1] * Pv[1];
          d = reduce32(d);
          s[0] = fmaf(v, Kv[0], fmaf(-d, Av[0], s[0] * W[0]));
          s[1] = fmaf(v, Kv[1], fmaf(-d, Av[1], s[1] * W[1]));
          y = s[0] * R[0] + s[1] * R[1];
        }
        yp[j] = y;
      }
      {
        const bool b3 = (lane & 8) != 0, b2 = (lane & 4) != 0, b1 = (lane & 2) != 0, b0 = (lane & 1) != 0;
        float q8[8], q4[4], q2[2];
#pragma unroll
        for (int i = 0; i < 8; i++) {
          float keep = b3 ? yp[i + 8] : yp[i], send = b3 ? yp[i] : yp[i + 8];
          q8[i] = keep + dpp_f<0x140>(send);
        }
#pragma unroll
        for (int i = 0; i < 4; i++) {
          float keep = b2 ? q8[i + 4] : q8[i], send = b2 ? q8[i] : q8[i + 4];
          q4[i] = keep + dpp_f<0x141>(send);
        }
#pragma unroll
        for (int i = 0; i < 2; i++) {
          float keep = b1 ? q4[i + 2] : q4[i], send = b1 ? q4[i] : q4[i + 2];
          q2[i] = keep + dpp_f<0x4E>(send);
        }
        float keep = b0 ? q2[1] : q2[0], send = b0 ? q2[0] : q2[1];
        float q1 = keep + dpp_f<0xB1>(send);
        const unsigned qi = __float_as_uint(q1);
        auto r = __builtin_amdgcn_permlane32_swap(qi, qi, false, false);
        q1 = __uint_as_float(r[0]) + __uint_as_float(r[1]);
        yk = ((sub >> 4) == hb) ? q1 : yk;
      }
    }
    if (!dry) outp[(size_t)(t0 + sub) * ldo + row] = (h16)yk;
    LDS_BARRIER();
  }
}
#define SCAN_BARRIERS (2 * (SEQ / TT))

#define OFF_SUMA (OFF_BON + 1 * MIB)
#define OFF_SUMH (OFF_BON + 1 * MIB + 256 * 1024)
__device__ void lru_scan_task(const Params& p, int task, int dry) {
  const int tid = get_tid();
  const int half = task & 1, seg = (task >> 1) & 31, b = task >> 6;
  const int c = half * 256 + tid;
  const size_t base = ((size_t)b * SEQ + seg * 256) * 512 + c;
  h16* la = (h16*)(p.ws + OFF_LLA) + base;
  h16* bb = (h16*)(p.ws + OFF_LB) + base;
  float hs = 0.f, ap = 1.f;
  h16 na[16], nb[16];
#pragma unroll
  for (int i = 0; i < 16; i++) { na[i] = la[(size_t)i * 512]; nb[i] = bb[(size_t)i * 512]; }
  for (int t0 = 0; t0 < 256; t0 += 16) {
    h16 ca[16], cb[16];
#pragma unroll
    for (int i = 0; i < 16; i++) { ca[i] = na[i]; cb[i] = nb[i]; }
    if (t0 + 16 < 256) {
#pragma unroll
      for (int i = 0; i < 16; i++) { na[i] = la[(size_t)(t0 + 16 + i) * 512]; nb[i] = bb[(size_t)(t0 + 16 + i) * 512]; }
    }
#pragma unroll
    for (int i = 0; i < 16; i++) {
      float a = __expf((float)ca[i]);
      hs = fmaf(a, hs, (float)cb[i]);
      ap *= a;
      if (!dry) { bb[(size_t)(t0 + i) * 512] = (h16)hs;
      la[(size_t)(t0 + i) * 512] = (h16)ap; }
    }
  }
  if (!dry) { ((float*)(p.ws + OFF_SUMA))[(b * 32 + seg) * 512 + c] = ap;
  ((float*)(p.ws + OFF_SUMH))[(b * 32 + seg) * 512 + c] = hs; }
}

#define PR_NF 600
__device__ __forceinline__ float treduce16(const float (&yp)[16], int lane) {
  const bool b3 = (lane & 8) != 0, b2 = (lane & 4) != 0, b1 = (lane & 2) != 0, b0 = (lane & 1) != 0;
  float q8[8], q4[4], q2[2];
#pragma unroll
  for (int i = 0; i < 8; i++) { float keep = b3 ? yp[i + 8] : yp[i], send = b3 ? yp[i] : yp[i + 8]; q8[i] = keep + dpp_f<0x140>(send); }
#pragma unroll
  for (int i = 0; i < 4; i++) { float keep = b2 ? q8[i + 4] : q8[i], send = b2 ? q8[i] : q8[i + 4]; q4[i] = keep + dpp_f<0x141>(send); }
#pragma unroll
  for (int i = 0; i < 2; i++) { float keep = b1 ? q4[i + 2] : q4[i], send = b1 ? q4[i] : q4[i + 2]; q2[i] = keep + dpp_f<0x4E>(send); }
  float keep = b0 ? q2[1] : q2[0], send = b0 ? q2[0] : q2[1];
  float q1 = keep + dpp_f<0xB1>(send);
  const unsigned qi = __float_as_uint(q1);
  auto r = __builtin_amdgcn_permlane32_swap(qi, qi, false, false);
  return __uint_as_float(r[0]) + __uint_as_float(r[1]);
}

__device__ void lru_scan_task(const Params& p, int task, int dry);

__device__ void rwkv_scan_pc(const Params& p, int blk, char* gsm, int dry) {
  const int rtid = real_tid();
  const int vb = __builtin_amdgcn_readfirstlane(rtid >> 8), tid = rtid & 255, lane = tid & 63, wave = tid >> 6;
  float* bufs = (float*)gsm;
  const int bh = blk >> 3, b = bh >> 3, h = bh & 7, rowbase = (blk & 7) * 8;
  const size_t bS = (size_t)b * SEQ;
  char* ws = p.ws;
  if (vb == 1) {
    const int pair = tid >> 4, l15 = tid & 15, c4 = l15 * 4;
    const size_t cofs = (size_t)h * 64 + c4;
    const h16* aW = (const h16*)(ws + OFF_W16) + cofs;
    const h16* aP = (const h16*)(ws + OFF_KK) + cofs;
    const h16* aA = (const h16*)(ws + OFF_KKA) + cofs;
    const h16* aK = (const h16*)(ws + OFF_KP) + cofs;
    const h16* aR = (const h16*)(ws + OFF_R) + cofs;
    const h16* aV = (const h16*)(ws + OFF_V) + (size_t)h * 64 + rowbase;
    const int lhalf = blk & 1, lseg = (blk >> 1) & 31, lb_ = blk >> 6;
    const int lc = lhalf * 256 + tid;
    const size_t lbase = ((size_t)lb_ * SEQ + lseg * 256) * 512 + lc;
    h16* lla = (h16*)(ws + OFF_LLA) + lbase;
    h16* lbb = (h16*)(ws + OFF_LB) + lbase;
    float lhs = 0.f, lap = 1.f;
    h16x4 nw1, nw2, np1, np2, na1, na2, nk1, nk2, nr1, nr2;
    h16x8 nv1, nv2;
    {
      const size_t tok = bS + pair * 2;
      nw1 = *(const h16x4*)(aW + tok * 512); nw2 = *(const h16x4*)(aW + (tok + 1) * 512);
      np1 = *(const h16x4*)(aP + tok * 512); np2 = *(const h16x4*)(aP + (tok + 1) * 512);
      na1 = *(const h16x4*)(aA + tok * 512); na2 = *(const h16x4*)(aA + (tok + 1) * 512);
      nk1 = *(const h16x4*)(aK + tok * 512); nk2 = *(const h16x4*)(aK + (tok + 1) * 512);
      nr1 = *(const h16x4*)(aR + tok * 512); nr2 = *(const h16x4*)(aR + (tok + 1) * 512);
      if (l15 == 1) { nv1 = *(const h16x8*)(aV + tok * 512); nv2 = *(const h16x8*)(aV + (tok + 1) * 512); }
    }
#pragma unroll 1
    for (int tile = 0; tile < SEQ / 32; tile++) {
      const h16x4 hw1 = nw1, hw2 = nw2, hp1 = np1, hp2 = np2, ha1 = na1, ha2 = na2, hk1 = nk1, hk2 = nk2, hr1 = nr1, hr2 = nr2;
      const h16x8 hv1 = nv1, hv2 = nv2;
      const h16 l_a = lla[(size_t)tile * 512], l_b = lbb[(size_t)tile * 512];
      if (tile + 1 < SEQ / 32) {
        const size_t tok = bS + (size_t)(tile + 1) * 32 + pair * 2;
        nw1 = *(const h16x4*)(aW + tok * 512); nw2 = *(const h16x4*)(aW + (tok + 1) * 512);
        np1 = *(const h16x4*)(aP + tok * 512); np2 = *(const h16x4*)(aP + (tok + 1) * 512);
        na1 = *(const h16x4*)(aA + tok * 512); na2 = *(const h16x4*)(aA + (tok + 1) * 512);
        nk1 = *(const h16x4*)(aK + tok * 512); nk2 = *(const h16x4*)(aK + (tok + 1) * 512);
        nr1 = *(const h16x4*)(aR + tok * 512); nr2 = *(const h16x4*)(aR + (tok + 1) * 512);
        if (l15 == 1) { nv1 = *(const h16x8*)(aV + tok * 512); nv2 = *(const h16x8*)(aV + (tok + 1) * 512); }
      }
      f32x4 P1, P2p, R1p, R2p, W12, AW, KW, A2, K2;
      float sc[8];
#pragma unroll
      for (int e = 0; e < 8; e++) sc[e] = 0.f;
#pragma unroll
      for (int e = 0; e < 4; e++) {
        const float W1 = __expf(-__expf((float)hw1[e])), W2 = __expf(-__expf((float)hw2[e]));
        const float p1 = (float)hp1[e], p2 = (float)hp2[e], a1 = (float)ha1[e], a2 = (float)ha2[e];
        const float k1 = (float)hk1[e], k2 = (float)hk2[e], r1 = (float)hr1[e], r2 = (float)hr2[e];
        const float w12 = W1 * W2, aw = a1 * W2, kw = k1 * W2;
        P1[e] = p1; P2p[e] = W1 * p2; R1p[e] = W1 * r1; R2p[e] = w12 * r2; W12[e] = w12; AW[e] = aw; KW[e] = kw; A2[e] = a2; K2[e] = k2;
        sc[0] += a1 * p2; sc[1] += k1 * p2; sc[2] += a1 * r1; sc[3] += k1 * r1;
        sc[4] += aw * r2; sc[5] += kw * r2; sc[6] += a2 * r2; sc[7] += k2 * r2;
      }
#pragma unroll
      for (int e = 0; e < 8; e++) sc[e] = reduce16(sc[e]);
      float* rec = bufs + (tile & 1) * (16 * PR_NF) + pair * PR_NF;
      *(f32x4*)(rec + c4) = P1;        *(f32x4*)(rec + 64 + c4) = P2p;  *(f32x4*)(rec + 128 + c4) = R1p;
      *(f32x4*)(rec + 192 + c4) = R2p; *(f32x4*)(rec + 256 + c4) = W12; *(f32x4*)(rec + 320 + c4) = AW;
      *(f32x4*)(rec + 384 + c4) = KW;  *(f32x4*)(rec + 448 + c4) = A2;  *(f32x4*)(rec + 512 + c4) = K2;
      if (l15 == 0) {
        f32x4 s0 = {sc[0], sc[1], sc[2], sc[3]}, s1 = {sc[4], sc[5], sc[6], sc[7]};
        *(f32x4*)(rec + 576) = s0; *(f32x4*)(rec + 580) = s1;
      }
      if (l15 == 1) {
#pragma unroll
        for (int r = 0; r < 8; r++) { rec[584 + r] = (float)hv1[r]; rec[592 + r] = (float)hv2[r]; }
      }
      {
        const float a_ = __expf((float)l_a);
        lhs = fmaf(a_, lhs, (float)l_b);
        lap *= a_;
        if (!dry) { lbb[(size_t)tile * 512] = (h16)lhs; lla[(size_t)tile * 512] = (h16)lap; }
      }
      LDS_BARRIER();
    }
    LDS_BARRIER();
    if (!dry) {
      ((float*)(ws + OFF_SUMA))[(lb_ * 32 + lseg) * 512 + lc] = lap;
      ((float*)(ws + OFF_SUMH))[(lb_ * 32 + lseg) * 512 + lc] = lhs;
    }
  } else {
    const int sub = (lane & 15) + ((lane >> 5) << 4), row = wave * 2 + ((lane >> 4) & 1);
    const float m0 = (sub == 0) ? 1.f : 0.f;
    h16* outp = (h16*)(ws + OFF_V) + bS * 512 + (size_t)h * 64 + rowbase;
    f32x2 s = {0.f, 0.f};
    LDS_BARRIER();
#pragma unroll 1
    for (int tile = 0; tile < SEQ / 32; tile++) {
      const float* recb = bufs + (tile & 1) * (16 * PR_NF);
      float yk = 0.f;
#pragma unroll 1
      for (int hb = 0; hb < 2; hb++) {
        float yp[16];
        f32x2 nP1, nP2p, nR1p, nR2p, nW12, nAW, nKW, nA2, nK2; f32x4 nc0, nc1; float nv1, nv2;
        {
          const float* rc = recb + (hb * 8) * PR_NF;
          nP1 = *(const f32x2*)(rc + sub * 2); nP2p = *(const f32x2*)(rc + 64 + sub * 2);
          nR1p = *(const f32x2*)(rc + 128 + sub * 2); nR2p = *(const f32x2*)(rc + 192 + sub * 2);
          nW12 = *(const f32x2*)(rc + 256 + sub * 2); nAW = *(const f32x2*)(rc + 320 + sub * 2);
          nKW = *(const f32x2*)(rc + 384 + sub * 2); nA2 = *(const f32x2*)(rc + 448 + sub * 2); nK2 = *(const f32x2*)(rc + 512 + sub * 2);
          nc0 = *(const f32x4*)(rc + 576); nc1 = *(const f32x4*)(rc + 580);
          nv1 = rc[584 + row]; nv2 = rc[592 + row];
        }
#pragma unroll
        for (int jp = 0; jp < 8; jp++) {
          const f32x2 P1 = nP1, P2p = nP2p, R1p = nR1p, R2p = nR2p, W12 = nW12, AW = nAW, KW = nKW, A2 = nA2, K2 = nK2;
          const f32x4 c0 = nc0, c1 = nc1;
          const float v1 = nv1, v2 = nv2;
          if (jp + 1 < 8) {
            const float* rc = recb + (hb * 8 + jp + 1) * PR_NF;
            nP1 = *(const f32x2*)(rc + sub * 2); nP2p = *(const f32x2*)(rc + 64 + sub * 2);
            nR1p = *(const f32x2*)(rc + 128 + sub * 2); nR2p = *(const f32x2*)(rc + 192 + sub * 2);
            nW12 = *(const f32x2*)(rc + 256 + sub * 2); nAW = *(const f32x2*)(rc + 320 + sub * 2);
            nKW = *(const f32x2*)(rc + 384 + sub * 2); nA2 = *(const f32x2*)(rc + 448 + sub * 2); nK2 = *(const f32x2*)(rc + 512 + sub * 2);
            nc0 = *(const f32x4*)(rc + 576); nc1 = *(const f32x4*)(rc + 580);
            nv1 = rc[584 + row]; nv2 = rc[592 + row];
          }
          float d1 = s[0] * P1[0] + s[1] * P1[1];
          float d2 = s[0] * P2p[0] + s[1] * P2p[1];
          float y1 = s[0] * R1p[0] + s[1] * R1p[1];
          float y2 = s[0] * R2p[0] + s[1] * R2p[1];
          d1 += dpp_f<0xB1>(d1); d2 += dpp_f<0xB1>(d2);
          d1 += dpp_f<0x4E>(d1); d2 += dpp_f<0x4E>(d2);
          d1 += dpp_f<0x141>(d1); d2 += dpp_f<0x141>(d2);
          d1 += dpp_f<0x140>(d1); d2 += dpp_f<0x140>(d2);
          {
            auto r1 = __builtin_amdgcn_permlane32_swap(__float_as_uint(d1), __float_as_uint(d1), false, false);
            auto r2 = __builtin_amdgcn_permlane32_swap(__float_as_uint(d2), __float_as_uint(d2), false, false);
            d1 = __uint_as_float(r1[0]) + __uint_as_float(r1[1]);
            d2 = __uint_as_float(r2[0]) + __uint_as_float(r2[1]);
          }
          d2 = d2 - d1 * c0[0] + v1 * c0[1];
          const f32x2 base = s * W12 + (f32x2{v1, v1} * KW - f32x2{d1, d1} * AW);
          s = base + (f32x2{v2, v2} * K2 - f32x2{d2, d2} * A2);
          y1 += m0 * (v1 * c0[3] - d1 * c0[2]);
          y2 += m0 * (v1 * c1[1] - d1 * c1[0] + v2 * c1[3] - d2 * c1[2]);
          yp[2 * jp] = y1; yp[2 * jp + 1] = y2;
        }
        const float q1 = treduce16(yp, lane);
        yk = ((sub >> 4) == hb) ? q1 : yk;
      }
      if (!dry) outp[(size_t)(tile * 32 + sub) * 512 + row] = (h16)yk;
      LDS_BARRIER();
    }
  }
}

__device__ void even_pre(const Params& p, char* smem) {
  const int tid = get_tid(), lane = tid & 63, wave = tid >> 6;
  const h16* P = (const h16*)(p.ws + OFF_BIG);
  for (int blk = get_bid(); blk < MTOK / 64; blk += VGRID) {
    const int tgs = blk * 64;
    const int t0 = tgs & (SEQ - 1);
    if (wave < 3) {
      const int c0 = wave * 512 + lane * 8;
      const float* cw = p.in[10];
      float cwr[4][8];
#pragma unroll
      for (int j = 0; j < 4; j++) {
        f32x4 x0 = *(const f32x4*)(cw + j * 1536 + c0), x1 = *(const f32x4*)(cw + j * 1536 + c0 + 4);
#pragma unroll
        for (int e = 0; e < 4; e++) { cwr[j][e] = x0[e]; cwr[j][4 + e] = x1[e]; }
      }
      h16* dst = (h16*)(p.ws + (wave == 0 ? OFF_GQ : wave == 1 ? OFF_GK : OFF_GV)) + lane * 8;
      const h16* src = P + 1552 + c0;
      h16x8 xm[3];
#pragma unroll
      for (int j = 0; j < 3; j++) {
#pragma unroll
        for (int e = 0; e < 8; e++) xm[j][e] = (h16)0.f;
        if (t0 > 0) xm[j] = *(const h16x8*)(src + (size_t)(tgs - 3 + j) * EINP);
      }
      const float qs = (wave == 0) ? 0.08838834764831845f : 1.f;
      h16x8 xq[4];
#pragma unroll
      for (int u = 0; u < 4; u++) xq[u] = *(const h16x8*)(src + (size_t)(tgs + u) * EINP);
#pragma unroll 1
      for (int tb = 0; tb < 64; tb += 4) {
        h16x8 xn[4];
#pragma unroll
        for (int u = 0; u < 4; u++) xn[u] = xq[u];
        if (tb + 4 < 64) {
#pragma unroll
          for (int u = 0; u < 4; u++) xq[u] = *(const h16x8*)(src + (size_t)(tgs + tb + 4 + u) * EINP);
        }
#pragma unroll
        for (int u = 0; u < 4; u++) {
          float val[8];
          float ss = 0.f;
#pragma unroll
          for (int e = 0; e < 8; e++) {
            float v = (float)xm[0][e] * cwr[0][e] + (float)xm[1][e] * cwr[1][e] + (float)xm[2][e] * cwr[2][e] + (float)xn[u][e] * cwr[3][e];
            v = silu_(v);
            val[e] = v;
            ss += v * v;
          }
          float sc = 1.f;
          if (wave < 2) { ss = reduce16(ss); sc = rsqrtf(ss + 1e-6f) * qs; }
          h16x8 o;
#pragma unroll
          for (int e = 0; e < 8; e++) o[e] = (h16)(val[e] * sc);
          *(h16x8*)(dst + (size_t)(tgs + tb + u) * 512) = o;
          xm[0] = xm[1]; xm[1] = xm[2]; xm[2] = xn[u];
        }
      }
    } else {
      const int c4 = lane * 4;
      const float* w2 = p.in[7];
      float w2r[16][4];
#pragma unroll
      for (int j = 0; j < 16; j++) {
        f32x4 x0 = *(const f32x4*)(w2 + j * 256 + c4);
#pragma unroll
        for (int e = 0; e < 4; e++) w2r[j][e] = x0[e];
      }
      const f32x4 lb4 = *(const f32x4*)(p.in[8] + c4);
      h16* ELA = (h16*)(p.ws + OFF_ELA);
      float* AB = (float*)(p.ws + OFF_AB);
      const float alog = (lane < 4) ? p.in[11][lane] : 0.f, dtb = (lane < 4) ? p.in[12][lane] : 0.f;
#pragma unroll 2
      for (int tok = 0; tok < 64; tok++) {
        const size_t tg = (size_t)tgs + tok;
        const h16* pr = P + tg * EINP + 1536;
        h16x8 g0 = *(const h16x8*)(pr), g1 = *(const h16x8*)(pr + 8);
        float z[4] = {lb4[0], lb4[1], lb4[2], lb4[3]};
#pragma unroll
        for (int j = 0; j < 16; j++) {
          const float gj = (float)(j < 8 ? g0[j] : g1[j - 8]);
#pragma unroll
          for (int e = 0; e < 4; e++) z[e] = fmaf(gj, w2r[j][e], z[e]);
        }
        h16x4 o;
#pragma unroll
        for (int e = 0; e < 4; e++) o[e] = (h16)(-softplus_(-z[e]) * (1.f / 16.f));
        *(h16x4*)(ELA + tg * 256 + c4) = o;
        if (lane < 4) {
          float da = (float)P[tg * EINP + 3600 + lane];
          float db = (float)P[tg * EINP + 3604 + lane];
          float g = -__expf(alog) * softplus_(da + dtb);
          AB[(tg * 4 + lane) * 2 + 0] = __expf(g);
          AB[(tg * 4 + lane) * 2 + 1] = sigm(db);
        }
      }
    }
  }
}

__device__ void even_post(const Params& p) {
  const int lane = get_tid() & 63;
  const int gw = get_bid() * 4 + (get_tid() >> 6);
  const int nw = VGRID * 4;
  const int half = gw & 1, c8 = lane * 8;
  const h16* __restrict__ P = (const h16*)(p.ws + OFF_BIG);
  const h16* __restrict__ GV = (const h16*)(p.ws + OFF_GV);
  h16* __restrict__ Y = (h16*)(p.ws + OFF_HH);
  const float* nwp = (half ? p.in[13] : p.in[9]) + (c8 & 127);
  float wn[8];
#pragma unroll
  for (int e = 0; e < 8; e++) wn[e] = nwp[e];
  const int tstep = nw >> 1;
  for (int tg = gw >> 1; tg < MTOK; tg += 2 * tstep) {
    h16x8 o[2], z[2];
#pragma unroll
    for (int u = 0; u < 2; u++) {
      const int t = tg + u * tstep;
      if (t < MTOK) {
        const h16* pr = P + (size_t)t * EINP;
        o[u] = half ? *(const h16x8*)(GV + (size_t)t * 512 + c8) : *(const h16x8*)(pr + 512 + c8);
        z[u] = *(const h16x8*)(pr + (half ? 3088 : 1024) + c8);
      }
    }
#pragma unroll
    for (int u = 0; u < 2; u++) {
      const int t = tg + u * tstep;
      if (t < MTOK) {
        float of[8], ss = 0.f;
#pragma unroll
        for (int e = 0; e < 8; e++) { of[e] = (float)o[u][e]; ss += of[e] * of[e]; }
        ss = reduce16(ss);
        const float inv = rsqrtf(ss * (1.f / 128.f) + 1e-6f);
        h16x8 r;
#pragma unroll
        for (int e = 0; e < 8; e++) r[e] = (h16)(of[e] * inv * wn[e] * silu_((float)z[u][e]));
        *(h16x8*)(Y + (size_t)t * DM + half * 512 + c8) = r;
      }
    }
  }
}

__device__ __forceinline__ float psmix(const h16* __restrict__ P, const float* __restrict__ mu, size_t tg, int t, int c) {
  float cur = (float)P[tg * OIN + c];
  float prev = (t > 0) ? (float)P[(tg - 1) * OIN + c] : 0.f;
  return cur + (prev - cur) * mu[c];
}
__device__ __forceinline__ float psmixm(const h16* __restrict__ P, float m, size_t tg, int t, int c) {
  float cur = (float)P[tg * OIN + c];
  float prev = (t > 0) ? (float)P[(tg - 1) * OIN + c] : 0.f;
  return cur + (prev - cur) * m;
}
__device__ __forceinline__ void psmix8(const h16* __restrict__ P, const float* __restrict__ mu, size_t tg, int t, int c0, float* o) {
  h16x8 cur = *(const h16x8*)(P + tg * OIN + c0);
  h16x8 prv = cur;
  if (t > 0) prv = *(const h16x8*)(P + (tg - 1) * OIN + c0);
  f32x4 m0 = *(const f32x4*)(mu + c0), m1 = *(const f32x4*)(mu + c0 + 4);
#pragma unroll
  for (int j = 0; j < 8; j++) {
    float cf = (float)cur[j];
    float pf = (t > 0) ? (float)prv[j] : 0.f;
    o[j] = cf + (pf - cf) * (j < 4 ? m0[j] : m1[j - 4]);
  }
}
__device__ __forceinline__ float half_sum(float x, int lane) {
  x = reduce16(x);
  const unsigned xi = __float_as_uint(x);
  auto r = __builtin_amdgcn_permlane16_swap(xi, xi, false, false);
  return __uint_as_float(r[0]) + __uint_as_float(r[1]);
}

#define OFF_SW (483 * MIB)
#define SW_W2T 0
#define SW_A2T 32768
#define SW_WAT 65536
#define SW_WXT 98304
#define SW_G2T 131072
__device__ void convert_small(const Params& p) {
  h16* sw = (h16*)(p.ws + OFF_SW);
  for (int idx = get_bid() * 256 + get_tid(); idx < 196608; idx += VGRID * 256) {
    float v;
    if (idx < 131072) {
      const int which = idx >> 15, n = (idx >> 6) & 511, k = idx & 63;
      if (which == 0) v = p.in[18][k * 512 + n];
      else if (which == 1) v = p.in[20][k * 512 + n];
      else if (which == 2) v = p.in[29][((n >> 6) * 64 + k) * 64 + (n & 63)];
      else v = p.in[31][((n >> 6) * 64 + k) * 64 + (n & 63)];
    } else {
      const int j = idx - 131072, n = j >> 7, k = j & 127;
      v = p.in[21][k * 512 + n];
    }
    sw[idx] = (h16)v;
  }
}

#define TLD 136
__device__ void odd_pre(const Params& p, char* smem) {
  const int tid = get_tid(), lane = tid & 63, wave = tid >> 6;
  const int l31 = lane & 31, lh = lane >> 5;
  const h16* P = (const h16*)(p.ws + OFF_BIG);
  const float* mu = p.in[16];
  const h16* sw = (const h16*)(p.ws + OFF_SW);
  for (int job = get_bid(); job < 2048; job += VGRID) {
    if (job < 1024) {
#ifndef NO_RWKVPRE
      const int tg0 = job * 32, t0 = tg0 & (SEQ - 1);
      h16* AL = (h16*)smem;
#pragma unroll
      for (int i = 0; i < 2; i++) {
        const int e = tid + i * 256, tok = e >> 4, ch = e & 15;
        float o[8];
        psmix8(P, mu, (size_t)tg0 + tok, t0 + tok, 1536 + ch * 8, o);
        h16x8 hv;
#pragma unroll
        for (int j = 0; j < 8; j++) hv[j] = (h16)(ch < 8 ? fast_tanh(o[j]) : o[j]);
        *(h16x8*)(AL + tok * TLD + ch * 8) = hv;
      }
      LDS_BARRIER();
      h16* W16 = (h16*)(p.ws + OFF_W16);
      h16* KK = (h16*)(p.ws + OFF_KK);
      h16* KKA = (h16*)(p.ws + OFF_KKA);
      h16* KP = (h16*)(p.ws + OFF_KP);
      h16* RR = (h16*)(p.ws + OFF_R);
      h16* VV = (h16*)(p.ws + OFF_V);
      float* BON = (float*)(p.ws + OFF_BON);
#pragma unroll 1
      for (int hh = 0; hh < 2; hh++) {
        const int head = wave * 2 + hh;
        f32x16 accw[2], acca[2];
#pragma unroll
        for (int n = 0; n < 2; n++)
#pragma unroll
          for (int r = 0; r < 16; r++) { accw[n][r] = 0.f; acca[n][r] = 0.f; }
#pragma unroll
        for (int ks = 0; ks < 4; ks++) {
          h16x8 aw = *(const h16x8*)(AL + l31 * TLD + ks * 16 + lh * 8);
          h16x8 aa = *(const h16x8*)(AL + l31 * TLD + 64 + ks * 16 + lh * 8);
#pragma unroll
          for (int q = 0; q < 2; q++) {
            const int n = wave * 128 + (hh * 2 + q) * 32 + l31;
            h16x8 bw = *(const h16x8*)(sw + SW_W2T + n * 64 + ks * 16 + lh * 8);
            h16x8 ba = *(const h16x8*)(sw + SW_A2T + n * 64 + ks * 16 + lh * 8);
            accw[q] = __builtin_amdgcn_mfma_f32_32x32x16_f16(aw, bw, accw[q], 0, 0, 0);
            acca[q] = __builtin_amdgcn_mfma_f32_32x32x16_f16(aa, ba, acca[q], 0, 0, 0);
          }
        }
        float w0c[2], a0c[2], kkc[2], kac[2], rkc[2], mur[2], muk[2], muv[2];
#pragma unroll
        for (int q = 0; q < 2; q++) {
          const int c = wave * 128 + (hh * 2 + q) * 32 + l31;
          w0c[q] = p.in[17][c]; a0c[q] = p.in[19][c]; kkc[q] = p.in[22][c]; kac[q] = p.in[23][c]; rkc[q] = p.in[24][c];
          mur[q] = mu[c]; muk[q] = mu[512 + c]; muv[q] = mu[1024 + c];
        }
        int tgb = tg0;
#pragma unroll
        for (int r = 0; r < 16; r++) {
          if ((r & 3) == 0) asm volatile("" : "+s"(tgb));
          const int tr = (r & 3) + 8 * (r >> 2) + 4 * lh;
          const size_t tg = (size_t)tgb + tr;
          const int t = (tgb & (SEQ - 1)) + tr;
          float kr[2], av[2];
          float ssp = 0.f, bonp = 0.f;
#pragma unroll
          for (int q = 0; q < 2; q++) {
            const int nt = hh * 2 + q;
            const int c = wave * 128 + nt * 32 + l31;
            float r_ = psmixm(P, mur[q], tg, t, c);
            float k_ = psmixm(P, muk[q], tg, t, 512 + c);
            float v_ = psmixm(P, muv[q], tg, t, 1024 + c);
            float w = -softplus_(-(w0c[q] + accw[q][r])) - 0.5f;
            float a = sigm(a0c[q] + acca[q][r]);
            kr[q] = k_ * kkc[q];
            av[q] = a;
            float kp = k_ * (1.f + (a - 1.f) * kac[q]);
            ssp += kr[q] * kr[q];
            bonp += r_ * kp * rkc[q];
            W16[tg * 512 + c] = (h16)w;
            KP[tg * 512 + c] = (h16)kp;
            RR[tg * 512 + c] = (h16)r_;
            VV[tg * 512 + c] = (h16)v_;
          }
          const float ss = half_sum(ssp, lane);
          const float bon = half_sum(bonp, lane);
          const float inv = rsqrtf(ss + 1e-6f);
#pragma unroll
          for (int q = 0; q < 2; q++) {
            const int c = wave * 128 + (hh * 2 + q) * 32 + l31;
            const float kk = kr[q] * inv;
            KK[tg * 512 + c] = (h16)kk;
            KKA[tg * 512 + c] = (h16)(kk * av[q]);
          }
          if (l31 == 0) BON[tg * 8 + head] = bon;
          if ((r & 3) == 3) asm volatile("" ::: "memory");
        }
      }
      LDS_BARRIER();
#endif
    } else {
#ifndef NO_LRUPRE
      const int tg0 = (job - 1024) * 32, t0 = tg0 & (SEQ - 1);
      h16* XB = (h16*)smem + wave * (32 * TLD);
      {
        const int ch = lane & 15, tq = lane >> 4;
        const int c0 = wave * 128 + ch * 8;
        const float* cw = p.in[27];
        float cwr[4][8], cbr[8];
#pragma unroll
        for (int j = 0; j < 4; j++) {
          f32x4 x0 = *(const f32x4*)(cw + j * 512 + c0), x1 = *(const f32x4*)(cw + j * 512 + c0 + 4);
#pragma unroll
          for (int e = 0; e < 4; e++) { cwr[j][e] = x0[e]; cwr[j][4 + e] = x1[e]; }
        }
        {
          f32x4 x0 = *(const f32x4*)(p.in[28] + c0), x1 = *(const f32x4*)(p.in[28] + c0 + 4);
#pragma unroll
          for (int e = 0; e < 4; e++) { cbr[e] = x0[e]; cbr[4 + e] = x1[e]; }
        }
        h16x8 x[11];
#pragma unroll
        for (int j = 0; j < 11; j++) {
          const int tt = tq * 8 - 3 + j;
          h16x8 z;
#pragma unroll
          for (int e = 0; e < 8; e++) z[e] = (h16)0.f;
          x[j] = z;
          if (t0 + tt >= 0) x[j] = *(const h16x8*)(P + (size_t)((long)tg0 + tt) * OIN + 1792 + c0);
        }
#pragma unroll
        for (int tok = 0; tok < 8; tok++) {
          h16x8 hv;
#pragma unroll
          for (int e = 0; e < 8; e++) {
            float xb = cbr[e] + (float)x[tok][e] * cwr[0][e] + (float)x[tok + 1][e] * cwr[1][e] +
                       (float)x[tok + 2][e] * cwr[2][e] + (float)x[tok + 3][e] * cwr[3][e];
            hv[e] = (h16)xb;
          }
          *(h16x8*)(XB + (tq * 8 + tok) * TLD + ch * 8) = hv;
        }
      }
      LDS_BARRIER();
      h16* LLA = (h16*)(p.ws + OFF_LLA);
      h16* LB = (h16*)(p.ws + OFF_LB);
#pragma unroll 1
      for (int blk = 0; blk < 2; blk++) {
        f32x16 accr[2], acci[2];
#pragma unroll
        for (int n = 0; n < 2; n++)
#pragma unroll
          for (int r = 0; r < 16; r++) { accr[n][r] = 0.f; acci[n][r] = 0.f; }
#pragma unroll
        for (int ks = 0; ks < 4; ks++) {
          h16x8 a = *(const h16x8*)(XB + l31 * TLD + blk * 64 + ks * 16 + lh * 8);
#pragma unroll
          for (int q = 0; q < 2; q++) {
            const int n = wave * 128 + (blk * 2 + q) * 32 + l31;
            h16x8 br, bi;
#pragma unroll
            for (int j = 0; j < 8; j++) {
              br[j] = (h16)p.in[29][((n >> 6) * 64 + ks * 16 + lh * 8 + j) * 64 + (n & 63)];
              bi[j] = (h16)p.in[31][((n >> 6) * 64 + ks * 16 + lh * 8 + j) * 64 + (n & 63)];
            }
            accr[q] = __builtin_amdgcn_mfma_f32_32x32x16_f16(a, br, accr[q], 0, 0, 0);
            acci[q] = __builtin_amdgcn_mfma_f32_32x32x16_f16(a, bi, acci[q], 0, 0, 0);
          }
        }
#pragma unroll
        for (int q = 0; q < 2; q++) {
          const int nt = blk * 2 + q;
          const int c = wave * 128 + nt * 32 + l31;
          const float bac = p.in[30][c], bxc = p.in[32][c];
          const float spl = softplus_(-p.in[33][c]);
          int tgb = tg0;
#pragma unroll
          for (int r = 0; r < 16; r++) {
            if ((r & 7) == 0) asm volatile("" : "+s"(tgb));
            const int tr = (r & 3) + 8 * (r >> 2) + 4 * lh;
            const size_t tg = (size_t)tgb + tr;
            float gr = sigm(accr[q][r] + bac);
            float gi = sigm(acci[q][r] + bxc);
            float la = -8.f * gr * spl;
            float mult = __builtin_amdgcn_sqrtf(fmaxf(1.f - __expf(2.f * la), 0.f));
            float xbv = (float)XB[tr * TLD + nt * 32 + l31];
            LLA[tg * 512 + c] = (h16)la;
            LB[tg * 512 + c] = (h16)(mult * gi * xbv);
            if ((r & 7) == 7) asm volatile("" ::: "memory");
          }
        }
      }
      LDS_BARRIER();
#endif
    }
  }
}

__device__ void odd_post(const Params& p, char* smem) {
  const int tid = get_tid(), lane = tid & 63, wave = tid >> 6;
  const int l31 = lane & 31, lh = lane >> 5;
  const h16* P = (const h16*)(p.ws + OFF_BIG);
  const float* mu = p.in[16];
  const h16* G2T = (const h16*)(p.ws + OFF_SW) + SW_G2T;
  const h16* YS = (const h16*)(p.ws + OFF_V);
  const h16* HL = (const h16*)(p.ws + OFF_LB);
  const h16* CA = (const h16*)(p.ws + OFF_LLA);
  const float* BON = (const float*)(p.ws + OFF_BON);
  h16* Y = (h16*)(p.ws + OFF_HH);
  h16* SG = (h16*)smem;
#ifndef NO_POST
  for (int job = get_bid(); job < 1024; job += VGRID) {
    const int tg0 = job * 32, t0 = tg0 & (SEQ - 1);
#pragma unroll
    for (int i = 0; i < 2; i++) {
      const int e = tid + i * 256, tok = e >> 4, ch = e & 15;
      float o[8];
      psmix8(P, mu, (size_t)tg0 + tok, t0 + tok, 1664 + ch * 8, o);
      h16x8 hv;
#pragma unroll
      for (int j = 0; j < 8; j++) hv[j] = (h16)sigm(o[j]);
      *(h16x8*)(SG + tok * TLD + ch * 8) = hv;
    }
    LDS_BARRIER();
    float hin[4] = {0.f, 0.f, 0.f, 0.f};
    {
      const int bq = tg0 >> 13, seg = t0 >> 8;
      const float* SA = (const float*)(p.ws + OFF_SUMA) + (size_t)bq * 32 * 512;
      const float* SH = (const float*)(p.ws + OFF_SUMH) + (size_t)bq * 32 * 512;
      for (int sq = 0; sq < seg; sq++) {
#pragma unroll
        for (int nt = 0; nt < 4; nt++) {
          const int c = wave * 128 + nt * 32 + l31;
          hin[nt] = fmaf(SA[sq * 512 + c], hin[nt], SH[sq * 512 + c]);
        }
      }
    }
#pragma unroll 1
    for (int hh = 0; hh < 2; hh++) {
      const int head = wave * 2 + hh;
      f32x16 accg[2];
#pragma unroll
      for (int n = 0; n < 2; n++)
#pragma unroll
        for (int r = 0; r < 16; r++) accg[n][r] = 0.f;
#pragma unroll
      for (int ks = 0; ks < 8; ks++) {
        h16x8 a = *(const h16x8*)(SG + l31 * TLD + ks * 16 + lh * 8);
#pragma unroll
        for (int q = 0; q < 2; q++) {
          const int n = wave * 128 + (hh * 2 + q) * 32 + l31;
          h16x8 bg = *(const h16x8*)(G2T + n * 128 + ks * 16 + lh * 8);
          accg[q] = __builtin_amdgcn_mfma_f32_32x32x16_f16(a, bg, accg[q], 0, 0, 0);
        }
      }
      const float hin0 = hh ? hin[2] : hin[0], hin1 = hh ? hin[3] : hin[1];
      float lnw[2], lnb[2], muv[2];
#pragma unroll
      for (int q = 0; q < 2; q++) {
        const int c = wave * 128 + (hh * 2 + q) * 32 + l31;
        lnw[q] = p.in[25][c]; lnb[q] = p.in[26][c]; muv[q] = mu[1024 + c];
      }
      int tgb = tg0;
#pragma unroll
      for (int r = 0; r < 16; r++) {
        if ((r & 3) == 0) asm volatile("" : "+s"(tgb));
        const int tr = (r & 3) + 8 * (r >> 2) + 4 * lh;
        const size_t tg = (size_t)tgb + tr;
        const int t = (tgb & (SEQ - 1)) + tr;
        float y[2];
#pragma unroll
        for (int q = 0; q < 2; q++) y[q] = (float)YS[tg * 512 + wave * 128 + (hh * 2 + q) * 32 + l31];
        const float mean = half_sum(y[0] + y[1], lane) * (1.f / 64.f);
        const float d0 = y[0] - mean, d1 = y[1] - mean;
        const float var = half_sum(d0 * d0 + d1 * d1, lane) * (1.f / 64.f);
        const float rs = rsqrtf(var + 64e-5f);
        const float bon = BON[tg * 8 + head];
#pragma unroll
        for (int q = 0; q < 2; q++) {
          const int nt = hh * 2 + q;
          const int c = wave * 128 + nt * 32 + l31;
          const float yn = (q == 0 ? d0 : d1) * rs * lnw[q] + lnb[q];
          const float v = psmixm(P, muv[q], tg, t, 1024 + c);
          Y[tg * DM + c] = (h16)((yn + bon * v) * accg[q][r]);
          const float hl = (float)HL[tg * 512 + c] + (float)CA[tg * 512 + c] * (q == 0 ? hin0 : hin1);
          const float ly = (float)P[tg * OIN + 2304 + c];
          Y[tg * DM + 512 + c] = (h16)(hl * gelu_tanh(ly));
        }
        if ((r & 3) == 3) asm volatile("" ::: "memory");
      }
    }
    LDS_BARRIER();
  }
#endif
}

__device__ void run_phase(const Params& pin, int ph, char* gsm, int dry) {
  char* smem = gsm + (size_t)__builtin_amdgcn_readfirstlane(threadIdx.x >> 8) * 65536;
  Params p = pin;
  asm volatile("" : "+s"(p.ws));
  char* ws = p.ws;
  h16* wb = (h16*)(ws + OFF_WB);
  h16* HH = (h16*)(ws + OFF_HH);
  h16* BIG = (h16*)(ws + OFF_BIG);
  h16* DMb = (h16*)(ws + OFF_DM);
  const float* nw = p.in[1];
  if (ph == 0) {
    convert_weights(p, 0, (float*)smem);
    row_phase(p.in[0], nullptr, nullptr, 0.f, nw, nullptr, HH);
    return;
  }
  const int L = (ph - 1) / 12, s = (ph - 1) % 12;
  const float* nwl = nw + (size_t)L * 6 * DM;
  if (s == 0 || s == 1 || s == 3 || s == 7 || s == 9 || s == 10) {
    const h16* Ap; const h16* Bp; int K, nN, ldc, epi; void* Cp;
    if (s == 0 || s == 9) { Ap = HH; Bp = wb + (s == 0 ? WGU0 : WGU1); K = DM; nN = 22; Cp = BIG; ldc = DFF; epi = 2; }
    else if (s == 1 || s == 10) { Ap = BIG; Bp = wb + (s == 1 ? WD0 : WD1); K = DFF; nN = 4; Cp = DMb; ldc = DM; epi = 1; }
    else if (s == 3) { Ap = HH; Bp = wb + WIN; K = DM; nN = (L == 0) ? 15 : 11; Cp = BIG; ldc = (L == 0) ? EINP : OIN; epi = 1; }
    else { Ap = HH; Bp = wb + WOUT; K = DM; nN = 4; Cp = DMb; ldc = DM; epi = 1; }
    if (epi == 0) gemm_phase<0>(Ap, Bp, K, 128, nN, Cp, ldc, ldc, gsm);
    else if (epi == 1) gemm_phase<1>(Ap, Bp, K, 128, nN, Cp, ldc, ldc, gsm);
    else gemm_phase<2>(Ap, Bp, K, 128, nN, Cp, ldc, ldc, gsm);
    return;
  }
  switch (s) {
    case 2:
      row_phase(L == 0 ? p.in[0] : p.out, DMb, nwl + 1 * DM, 0.5f, nwl + 2 * DM, p.out, HH, dry);
      break;
    case 4:
      if (L == 0) even_pre(p, smem); else odd_pre(p, smem);
      break;
    case 5: {
      const int vb = __builtin_amdgcn_readfirstlane(threadIdx.x >> 8);
      for (int blk = real_bid(); blk < 256; blk += (int)gridDim.x) {
        if (L == 0) {
          if (vb == 0) scan_task<1>(p, blk, smem, dry); else scan_task<0>(p, blk, smem, dry);
        } else {
          rwkv_scan_pc(p, blk, gsm, dry);
        }
      }
      break;
    }
    case 6:
      if (L == 0) even_post(p); else odd_post(p, smem);
      break;
    case 8:
      row_phase(p.out, DMb, nwl + 3 * DM, 1.0f, nwl + 4 * DM, p.out, HH, dry);
      break;
    case 11:
      if (L == 0) {
        convert_weights(p, 1, (float*)smem);
        convert_small(p);
        row_phase(p.out, DMb, nwl + 5 * DM, 0.5f, nw + 6 * DM, p.out, HH, dry);
      } else {
        row_phase(p.out, DMb, nwl + 5 * DM, 0.5f, nullptr, p.out, nullptr, dry);
      }
      break;
  }
}

#define OFF_BAR (484 * MIB)
#define XB_TMO      128
#define XB_XCNT(j)  (256  + 64 * (j))
#define XB_XSUB(j)  (1280 + 64 * (j))
#define XB_XGEN(j)  (2304 + 64 * (j))
#define XB_TOP      3328
#define XB_TOPGEN   3392
#define XCD_BAR_WORDS 3456
#define XB_SPIN_CAP (1u << 18)
#define LAS __attribute__((address_space(3)))
__device__ __forceinline__ unsigned xb_ld(unsigned* p) { return __hip_atomic_load(p, __ATOMIC_RELAXED, __HIP_MEMORY_SCOPE_AGENT); }
__device__ __forceinline__ unsigned xb_add(unsigned* p, unsigned v) { return __hip_atomic_fetch_add(p, v, __ATOMIC_RELAXED, __HIP_MEMORY_SCOPE_AGENT); }
__device__ __forceinline__ unsigned xb_xcc_id() { return (unsigned)__builtin_amdgcn_s_getreg((3 << 11) | 20) & 0xFu; }
#define XB_SPIN(cond, bar) do { unsigned _sp = 0; while (cond) { __builtin_amdgcn_s_sleep(1); \
    if ((++_sp & 255u) == 0u) { if (xb_ld(&(bar)[XB_TMO])) break; if (_sp > XB_SPIN_CAP) { atomicAdd(&(bar)[XB_TMO], 1u); break; } } } } while (0)
struct XcdBarrier { unsigned* bar; unsigned x; volatile LAS unsigned* st; };
__device__ __forceinline__ XcdBarrier xcd_barrier_post(unsigned* bar, volatile LAS unsigned* st) {
  XcdBarrier b; b.bar = bar; b.x = xb_xcc_id(); b.st = st;
  if (threadIdx.x == 0) (void)xb_add(&bar[XB_XCNT(b.x)], 1u);
  return b;
}
__device__ __forceinline__ void xcd_barrier_complete(unsigned* bar, unsigned x, unsigned& nloc, unsigned& nx) {
  const unsigned G = gridDim.x * gridDim.y * gridDim.z;
  unsigned sum, cnt, mine, sp = 0u;
  for (;;) {
    sum = 0u; cnt = 0u; mine = 0u;
#pragma unroll
    for (unsigned j = 0; j < 16; ++j) { const unsigned c = xb_ld(&bar[XB_XCNT(j)]); sum += c; cnt += (c > 0u) ? 1u : 0u; mine = (j == x) ? c : mine; }
    if (sum == G) break;
    __builtin_amdgcn_s_sleep(1);
    if ((++sp & 255u) == 0u) { if (xb_ld(&bar[XB_TMO])) break; if (sp > XB_SPIN_CAP) { atomicAdd(&bar[XB_TMO], 1u); break; } }
  }
  nloc = mine > 0u ? mine : 1u; nx = cnt > 0u ? cnt : 1u;
}
__device__ __forceinline__ void xcd_barrier(const XcdBarrier& b) {
  asm volatile("s_waitcnt vmcnt(0)" ::: "memory");
  __syncthreads();
  if (threadIdx.x == 0) {
    unsigned* bar = b.bar;
    __builtin_amdgcn_s_waitcnt(0);
    unsigned nloc = b.st[0], nx = b.st[1];
    if (nloc == 0u) { xcd_barrier_complete(bar, b.x, nloc, nx); b.st[0] = nloc; b.st[1] = nx; }
    const unsigned old = xb_add(&bar[XB_XSUB(b.x)], 1u);
    const unsigned gen = old / nloc;
    if (old + 1u == (gen + 1u) * nloc) {
      __builtin_amdgcn_fence(__ATOMIC_RELEASE, "agent");
      asm volatile("s_waitcnt vmcnt(0)" ::: "memory");
      const unsigned og = xb_add(&bar[XB_TOP], 1u);
      const unsigned tg = og / nx;
      if (og + 1u == (tg + 1u) * nx) xb_add(&bar[XB_TOPGEN], 1u);
      else XB_SPIN(xb_ld(&bar[XB_TOPGEN]) == tg, bar);
      __builtin_amdgcn_fence(__ATOMIC_ACQUIRE, "agent");
      xb_add(&bar[XB_XGEN(b.x)], 1u);
      asm volatile("s_waitcnt vmcnt(0)" ::: "memory");
    } else {
      XB_SPIN(xb_ld(&bar[XB_XGEN(b.x)]) == gen, bar);
      __builtin_amdgcn_fence(__ATOMIC_ACQUIRE, "agent");
      asm volatile("s_waitcnt vmcnt(0)" ::: "memory");
    }
  }
  __syncthreads();
}

__global__ void __launch_bounds__(512, 2) mega_kernel(Params p, int ph0, int ph1, int dup_mask) {
  extern __shared__ __attribute__((aligned(16))) char smem[];
  __shared__ uint4 xb_words;
  cg::grid_group grid = cg::this_grid();
  if (threadIdx.x == 0) xb_words = make_uint4(0u, 0u, 0u, 0u);
  __syncthreads();
  XcdBarrier xb = xcd_barrier_post((unsigned*)(p.ws + OFF_BAR), (volatile LAS unsigned*)&xb_words);
  int rep = 0;
  for (int ph = ph0; ph < ph1;) {
    run_phase(p, ph, smem, rep);
    const int bit = (ph == 0) ? 12 : (ph - 1) % 12;
    if (((dup_mask >> bit) & 1) && rep == 0) { rep = 1; } else { rep = 0; ph++; }
    if (ph < ph1) { if (ph1 < 0) grid.sync(); else xcd_barrier(xb); }
  }
}

extern "C" void kernel_launch(void* const* d_in, const int* in_sizes, int n_in, void* d_out, int out_size, void* d_ws,
                              size_t ws_size, hipStream_t stream) {
  static int grid_blocks = 0;
  if (!grid_blocks) {
    int dev = 0, cus = 0, per_cu = 0;
    hipGetDevice(&dev);
    hipDeviceGetAttribute(&cus, hipDeviceAttributeMultiprocessorCount, dev);
    hipFuncSetAttribute((const void*)mega_kernel, hipFuncAttributeMaxDynamicSharedMemorySize, 131072);
    hipOccupancyMaxActiveBlocksPerMultiprocessor(&per_cu, mega_kernel, 512, 131072);
    if (per_cu > 1) per_cu = 1;
    if (per_cu < 1) per_cu = 1;
    grid_blocks = cus * per_cu;
  }
  Params p{};
  for (int i = 0; i < 34; i++) p.in[i] = (const float*)d_in[i];
  p.out = (float*)d_out;
  p.ws = (char*)d_ws;
  int ph0 = 0, ph1 = NPHASE, dup = DUPMASK;
  void* args[] = {&p, &ph0, &ph1, &dup};
  hipMemsetAsync((char*)d_ws + OFF_BAR, 0, XCD_BAR_WORDS * sizeof(unsigned), stream);
  hipError_t e = hipLaunchCooperativeKernel((void*)mega_kernel, dim3(grid_blocks), dim3(512), args, 131072, stream);
  if (e != hipSuccess) fprintf(stderr, "cooperative launch failed: %s (grid %d)\n", hipGetErrorString(e), grid_blocks);
}
```

```cpp
#include <hip/hip_runtime.h>
#include <hip/hip_fp16.h>
#include <hip/hip_cooperative_groups.h>
#include <cstdio>
namespace cg = cooperative_groups;

typedef _Float16 h16;
typedef h16 h16x8 __attribute__((ext_vector_type(8)));
typedef h16 h16x4 __attribute__((ext_vector_type(4)));
typedef float f32x16 __attribute__((ext_vector_type(16)));
typedef unsigned int u32x4 __attribute__((ext_vector_type(4)));
typedef float f32x4 __attribute__((ext_vector_type(4)));

#define MTOK 32768
#define SEQ 8192
#define DM 1024
#define DFF 2816
#define EIN 3608
#define EINP 3712
#define OIN 2816

#define MIB ((size_t)1 << 20)
#define OFF_WB   ((size_t)0)
#define OFF_HH   (48 * MIB)
#define OFF_BIG  (112 * MIB)
#define OFF_DM   (344 * MIB)
#define OFF_ELA  (OFF_DM)
#define OFF_GQ   (OFF_DM + 16 * MIB)
#define OFF_GK   (OFF_DM + 48 * MIB)
#define OFF_GV   (OFF_DM + 80 * MIB)
#define OFF_AB   (OFF_DM + 112 * MIB)
#define OFF_KK   (OFF_HH)
#define OFF_KKA  (OFF_HH + 32 * MIB)
#define OFF_W16  (288 * MIB)
#define OFF_KP   (320 * MIB)
#define OFF_R    (352 * MIB)
#define OFF_V    (384 * MIB)
#define OFF_LLA  (416 * MIB)
#define OFF_LB   (448 * MIB)
#define OFF_BON  (480 * MIB)
#define WGU0 0
#define WD0  5767168
#define WGU1 8650752
#define WD1  14417920
#define WIN  17301504
#define WOUT 21233664

#define SMEM_BYTES 45056
#define NPHASE 25
#define DUPMASK 0x0

struct Params {
  const float* in[34];
  float* out;
  char* ws;
};

__device__ __forceinline__ int get_tid() { int t = threadIdx.x & 255; asm volatile("" : "+v"(t)); return t; }
__device__ __forceinline__ int get_bid() { int t = blockIdx.x * 2 + __builtin_amdgcn_readfirstlane(threadIdx.x >> 8); asm volatile("" : "+s"(t)); return t; }
__device__ __forceinline__ int real_tid() { int t = threadIdx.x; asm volatile("" : "+v"(t)); return t; }
__device__ __forceinline__ int real_bid() { int t = blockIdx.x; asm volatile("" : "+s"(t)); return t; }
#define VGRID ((int)gridDim.x * 2)
__device__ __forceinline__ float sigm(float x) { return __builtin_amdgcn_rcpf(1.f + __expf(-x)); }
__device__ __forceinline__ float softplus_(float x) { return fmaxf(x, 0.f) + __logf(1.f + __expf(-fabsf(x))); }
__device__ __forceinline__ float silu_(float x) { return x * __builtin_amdgcn_rcpf(1.f + __expf(-x)); }
__device__ __forceinline__ float fast_tanh(float u) { return 1.f - 2.f * __builtin_amdgcn_rcpf(1.f + __expf(2.f * u)); }
__device__ __forceinline__ float gelu_tanh(float x) {
  float u = 0.7978845608028654f * (x + 0.044715f * x * x * x);
  return 0.5f * x * (1.f + fast_tanh(u));
}

template <int CTRL>
__device__ __forceinline__ float dpp_f(float x) {
  return __int_as_float(__builtin_amdgcn_update_dpp(0, __float_as_int(x), CTRL, 0xF, 0xF, true));
}
__device__ __forceinline__ float reduce16(float x) {
  x += dpp_f<0xB1>(x);
  x += dpp_f<0x4E>(x);
  x += dpp_f<0x141>(x);
  x += dpp_f<0x140>(x);
  return x;
}

__device__ __forceinline__ float wave_sum(float v) {
  v = reduce16(v);
  const int vi = __float_as_int(v);
  float t = __int_as_float(__builtin_amdgcn_readlane(vi, 0));
  t += __int_as_float(__builtin_amdgcn_readlane(vi, 16));
  t += __int_as_float(__builtin_amdgcn_readlane(vi, 32));
  t += __int_as_float(__builtin_amdgcn_readlane(vi, 48));
  return t;
}

#define LDS_BARRIER() do { asm volatile("s_waitcnt lgkmcnt(0)" ::: "memory"); __builtin_amdgcn_s_barrier(); asm volatile("" ::: "memory"); } while (0)

__device__ void conv_tile(const float* __restrict__ src, int K, int N, h16* __restrict__ dst, int mode, int kt, int nt,
                          float* sm) {
  const int tid = get_tid();
#pragma unroll
  for (int i = 0; i < 4; i++) {
    const int idx = tid + i * 256, r = idx >> 4, c4 = (idx & 15) * 4;
    const int n = nt * 64 + c4;
    f32x4 v = {0.f, 0.f, 0.f, 0.f};
    if (n < N) v = *(const f32x4*)(src + (size_t)(kt * 64 + r) * N + n);
#pragma unroll
    for (int e = 0; e < 4; e++) sm[r * 65 + c4 + e] = v[e];
  }
  LDS_BARRIER();
#pragma unroll
  for (int i = 0; i < 2; i++) {
    const int idx = tid + i * 256, nl = idx >> 3, kc = (idx & 7) * 8;
    const int n = nt * 64 + nl;
    const int row = (mode == 0) ? n : ((n >> 4) * 32 + (mode - 1) * 16 + (n & 15));
    h16x8 o;
#pragma unroll
    for (int j = 0; j < 8; j++) o[j] = (h16)sm[(kc + j) * 65 + nl];
    *(h16x8*)(dst + (size_t)row * K + kt * 64 + kc) = o;
  }
  LDS_BARRIER();
}

__device__ void convert_weights(const Params& p, int L, float* sm) {
  h16* wb = (h16*)(p.ws + OFF_WB);
  const int T_G = 16 * 44, T_D = 44 * 16;
  const int T_F = 2 * T_G + T_D;
  const int nin = (L == 0) ? 60 : 44;
  const int T_IN = 16 * nin, T_OUT = 256;
  const int total = 2 * T_F + T_IN + T_OUT;
  for (int j = get_bid(); j < total; j += VGRID) {
    int q = j;
    const float* src; int K, N, mode, ntn; h16* dst;
    if (q < 2 * T_F) {
      int f = q / T_F; q -= f * T_F;
      int lf = L * 2 + f;
      if (q < T_G) { src = p.in[2] + (size_t)lf * DM * DFF; K = DM; N = DFF; dst = wb + (f ? WGU1 : WGU0); mode = 1; ntn = 44; }
      else if (q < 2 * T_G) { q -= T_G; src = p.in[3] + (size_t)lf * DM * DFF; K = DM; N = DFF; dst = wb + (f ? WGU1 : WGU0); mode = 2; ntn = 44; }
      else { q -= 2 * T_G; src = p.in[4] + (size_t)lf * DFF * DM; K = DFF; N = DM; dst = wb + (f ? WD1 : WD0); mode = 0; ntn = 16; }
    } else {
      q -= 2 * T_F;
      if (q < T_IN) { src = (L == 0) ? p.in[5] : p.in[14]; K = DM; N = (L == 0) ? EIN : OIN; dst = wb + WIN; mode = 0; ntn = nin; }
      else { q -= T_IN; src = (L == 0) ? p.in[6] : p.in[15]; K = DM; N = DM; dst = wb + WOUT; mode = 0; ntn = 16; }
    }
    int kt = q / ntn, nt = q % ntn;
    conv_tile(src, K, N, dst, mode, kt, nt, sm);
  }
}

__device__ void row_phase(const float* __restrict__ xin, const h16* __restrict__ Dmat, const float* __restrict__ wpost,
                          float res, const float* __restrict__ wpre, float* __restrict__ xout, h16* __restrict__ hh, int dry = 0) {
  const int lane = get_tid() & 63;
  const int gw = get_bid() * 4 + (get_tid() >> 6);
  const int nw = VGRID * 4;
  float4 nx[4];
  h16x4 nd[4];
  if (gw < MTOK) {
#pragma unroll
    for (int i = 0; i < 4; i++) {
      nx[i] = *(const float4*)(xin + (size_t)gw * DM + i * 256 + lane * 4);
      if (Dmat) nd[i] = *(const h16x4*)(Dmat + (size_t)gw * DM + i * 256 + lane * 4);
    }
  }
  for (int row = gw; row < MTOK; row += nw) {
    float4 xv[4];
    h16x4 dh[4];
#pragma unroll
    for (int i = 0; i < 4; i++) { xv[i] = nx[i]; dh[i] = nd[i]; }
    const int nrow = row + nw;
    if (nrow < MTOK) {
#pragma unroll
      for (int i = 0; i < 4; i++) {
        nx[i] = *(const float4*)(xin + (size_t)nrow * DM + i * 256 + lane * 4);
        if (Dmat) nd[i] = *(const h16x4*)(Dmat + (size_t)nrow * DM + i * 256 + lane * 4);
      }
    }
    if (Dmat) {
      float4 dv[4];
      float ss = 0.f;
#pragma unroll
      for (int i = 0; i < 4; i++) {
        dv[i].x = (float)dh[i][0]; dv[i].y = (float)dh[i][1]; dv[i].z = (float)dh[i][2]; dv[i].w = (float)dh[i][3];
        ss += dv[i].x * dv[i].x + dv[i].y * dv[i].y + dv[i].z * dv[i].z + dv[i].w * dv[i].w;
      }
      ss = wave_sum(ss);
      float inv = rsqrtf(ss * (1.f / DM) + 1e-6f) * res;
#pragma unroll
      for (int i = 0; i < 4; i++) {
        float4 w = *(const float4*)(wpost + i * 256 + lane * 4);
        xv[i].x += dv[i].x * inv * w.x; xv[i].y += dv[i].y * inv * w.y;
        xv[i].z += dv[i].z * inv * w.z; xv[i].w += dv[i].w * inv * w.w;
        if (!dry) *(float4*)(xout + (size_t)row * DM + i * 256 + lane * 4) = xv[i];
      }
    }
    if (hh) {
      float ss = 0.f;
#pragma unroll
      for (int i = 0; i < 4; i++) ss += xv[i].x * xv[i].x + xv[i].y * xv[i].y + xv[i].z * xv[i].z + xv[i].w * xv[i].w;
      ss = wave_sum(ss);
      float inv = rsqrtf(ss * (1.f / DM) + 1e-6f);
#pragma unroll
      for (int i = 0; i < 4; i++) {
        float4 w = *(const float4*)(wpre + i * 256 + lane * 4);
        h16x4 o;
        o[0] = (h16)(xv[i].x * inv * w.x); o[1] = (h16)(xv[i].y * inv * w.y);
        o[2] = (h16)(xv[i].z * inv * w.z); o[3] = (h16)(xv[i].w * inv * w.w);
        if (!dry) *(h16x4*)(hh + (size_t)row * DM + i * 256 + lane * 4) = o;
      }
    }
  }
}

typedef float f32x4v __attribute__((ext_vector_type(4)));
#define G_BM 256
#define G_BK 64
#define G_HALF 128
#define G_HT (G_HALF * G_BK)
__device__ __forceinline__ int lds_byte(int r, int c) {
  int st = (r >> 4) * 2 + (c >> 5), rr = r & 15, cc = c & 31, ob = rr * 64 + cc * 2;
  return st * 1024 + (ob ^ (((ob >> 9) & 1) << 5));
}
__device__ __forceinline__ void stage_rc(int b, int& R, int& C) {
  int st = b / 1024, sb = b % 1024, swz = sb ^ (((sb >> 9) & 1) << 5);
  R = (st >> 1) * 16 + swz / 64; C = (st & 1) * 32 + (swz % 64) / 2;
}
template <int EPI>
__device__ void gemm_phase(const h16* __restrict__ A, const h16* __restrict__ Bt, int K, int nM, int nN,
                           void* __restrict__ Cout, int ldc, int ncv, char* smem) {
  h16* shm = (h16*)smem;
#define SA(b, h) (shm + ((b) * 2 + (h)) * G_HT)
#define SB(b, h) (shm + (4 + (b) * 2 + (h)) * G_HT)
#define STAGE(P, BASE, br, kt) do { const char* _gb = (const char*)(BASE) + ((long)(br) * K + (long)(kt) * G_BK) * 2; \
    __builtin_amdgcn_global_load_lds((const unsigned*)(_gb + voff), (unsigned*)((char*)(P) + tid * 16), 16, 0, 0); \
    __builtin_amdgcn_global_load_lds((const unsigned*)(_gb + (long)K * 128 + voff), (unsigned*)((char*)(P) + tid * 16 + 8192), 16, 0, 0); } while (0)
#define LDA(dst, b, h) for (int m = 0; m < 4; ++m) for (int k = 0; k < 2; ++k) \
    dst[m][k] = *reinterpret_cast<const h16x8*>((char*)SA(b, h) + lds_byte(wr * 64 + m * 16 + fr, k * 32 + fq * 8))
#define LDB(dst, b, h) for (int n = 0; n < 2; ++n) for (int k = 0; k < 2; ++k) \
    dst[n][k] = *reinterpret_cast<const h16x8*>((char*)SB(b, h) + lds_byte(wc * 32 + n * 16 + fr, k * 32 + fq * 8))
#define MMA(ai, bj, At_, Bt_) do { __builtin_amdgcn_s_setprio(1); \
    for (int m = 0; m < 4; ++m) for (int n = 0; n < 2; ++n) for (int k = 0; k < 2; ++k) \
      acc[ai][bj][m][n] = __builtin_amdgcn_mfma_f32_16x16x32_f16(Bt_[n][k], At_[m][k], acc[ai][bj][m][n], 0, 0, 0); \
    __builtin_amdgcn_s_setprio(0); } while (0)
#define WAIT_V(n) asm volatile("s_waitcnt vmcnt(" #n ")" ::: "memory")
#define WAIT_L(n) asm volatile("s_waitcnt lgkmcnt(" #n ")" ::: "memory")
#define BAR __builtin_amdgcn_s_barrier()
#define SCHED __builtin_amdgcn_sched_barrier(0)
  const int tid = real_tid();
  const int G = gridDim.x;
  const int nwg = nM * nN;
  const int wid = tid >> 6, lane = tid & 63, wr = wid >> 2, wc = wid & 3, fr = lane & 15, fq = lane >> 4;
  const int nt = K / G_BK;
  unsigned voff;
  { int R0, C0; stage_rc(tid * 16, R0, C0); voff = (unsigned)((R0 * K + C0) * 2); }
  for (int L = real_bid(); L < nwg; L += G) {
    int wgid = L;
    { int q = nwg / 8, r = nwg % 8, xcd = wgid % 8, off = wgid / 8;
      wgid = (xcd < r ? xcd * (q + 1) : r * (q + 1) + (xcd - r) * q) + off; }
    const int nig = 4 * nN, gid = wgid / nig, fm = gid * 4, gsz = min(nM - fm, 4);
    const int pm = fm + ((wgid % nig) % gsz), pn = (wgid % nig) / gsz, brow = pm * G_BM, bcol = pn * G_BM;
    f32x4v acc[2][2][4][2];
#pragma unroll
    for (int a_ = 0; a_ < 2; a_++)
#pragma unroll
      for (int b_ = 0; b_ < 2; b_++)
#pragma unroll
        for (int m = 0; m < 4; m++)
#pragma unroll
          for (int n = 0; n < 2; n++) acc[a_][b_][m][n] = f32x4v{0.f, 0.f, 0.f, 0.f};
    h16x8 At[4][2], B0[2][2], B1[2][2];
    WAIT_V(0);
    __syncthreads();
    STAGE(SB(0, 0), Bt, bcol, 0); STAGE(SA(0, 0), A, brow, 0);
    STAGE(SB(0, 1), Bt, bcol + G_HALF, 0); STAGE(SA(0, 1), A, brow + G_HALF, 0);
    if (wr == 1) BAR;
    WAIT_V(4); BAR;
    STAGE(SB(1, 0), Bt, bcol, 1); STAGE(SA(1, 0), A, brow, 1); STAGE(SB(1, 1), Bt, bcol + G_HALF, 1);
    WAIT_V(6); BAR;
    for (int t = 0; t < nt - 2; t += 2) {
      LDB(B0, 0, 0); SCHED; LDA(At, 0, 0); STAGE(SA(1, 1), A, brow + G_HALF, t + 1);
      WAIT_L(8); BAR; WAIT_L(0); MMA(0, 0, At, B0); BAR; SCHED;
      LDB(B1, 0, 1); STAGE(SB(0, 0), Bt, bcol, t + 2);
      BAR; WAIT_L(0); MMA(0, 1, At, B1); BAR;
      LDA(At, 0, 1); STAGE(SA(0, 0), A, brow, t + 2);
      BAR; WAIT_L(0); MMA(1, 0, At, B0); BAR; SCHED;
      STAGE(SB(0, 1), Bt, bcol + G_HALF, t + 2);
      WAIT_V(6); BAR; MMA(1, 1, At, B1); BAR;
      LDB(B0, 1, 0); SCHED; LDA(At, 1, 0); STAGE(SA(0, 1), A, brow + G_HALF, t + 2);
      WAIT_L(8); BAR; WAIT_L(0); MMA(0, 0, At, B0); BAR; SCHED;
      LDB(B1, 1, 1); STAGE(SB(1, 0), Bt, bcol, t + 3);
      BAR; WAIT_L(0); MMA(0, 1, At, B1); BAR;
      LDA(At, 1, 1); STAGE(SA(1, 0), A, brow, t + 3);
      BAR; WAIT_L(0); MMA(1, 0, At, B0); BAR; SCHED;
      STAGE(SB(1, 1), Bt, bcol + G_HALF, t + 3);
      WAIT_V(6); BAR; MMA(1, 1, At, B1); BAR;
    }
    { LDB(B0, 0, 0); LDA(At, 0, 0); STAGE(SA(1, 1), A, brow + G_HALF, nt - 1);
      BAR; WAIT_L(0); MMA(0, 0, At, B0); BAR;
      LDB(B1, 0, 1); BAR; WAIT_L(0); MMA(0, 1, At, B1); BAR;
      LDA(At, 0, 1); WAIT_V(4); BAR; WAIT_L(0); MMA(1, 0, At, B0); MMA(1, 1, At, B1); BAR; }
    { LDB(B0, 1, 0); LDA(At, 1, 0); WAIT_V(2); BAR; WAIT_L(0); MMA(0, 0, At, B0); BAR;
      LDB(B1, 1, 1); WAIT_V(0); BAR; WAIT_L(0); MMA(0, 1, At, B1); BAR;
      LDA(At, 1, 1); BAR; WAIT_L(0); MMA(1, 0, At, B0); MMA(1, 1, At, B1); BAR; }
    if (wr == 0) BAR;
#pragma unroll
    for (int ai = 0; ai < 2; ++ai)
#pragma unroll
      for (int bj = 0; bj < 2; ++bj)
#pragma unroll
        for (int m = 0; m < 4; ++m) {
          const long row = brow + ai * G_HALF + wr * 64 + m * 16 + fr;
          if (EPI == 2) {
            const f32x4v g = acc[ai][bj][m][0], u = acc[ai][bj][m][1];
            const int col = (bcol >> 1) + bj * 64 + wc * 16 + fq * 4;
            h16x4 o;
#pragma unroll
            for (int j = 0; j < 4; ++j) o[j] = (h16)(silu_(g[j]) * u[j]);
            *(h16x4*)((h16*)Cout + row * ldc + col) = o;
          } else {
#pragma unroll
            for (int n = 0; n < 2; ++n) {
              const int col = bcol + bj * G_HALF + wc * 32 + n * 16 + fq * 4;
              if (EPI == 0) {
                *(f32x4v*)((float*)Cout + row * ldc + col) = acc[ai][bj][m][n];
              } else if (col < ncv) {
                h16x4 o;
#pragma unroll
                for (int j = 0; j < 4; ++j) o[j] = (h16)acc[ai][bj][m][n][j];
                *(h16x4*)((h16*)Cout + row * ldc + col) = o;
              }
            }
          }
        }
  }
#undef SA
#undef SB
}

#define TT 32
template <int MODE> struct ScanCfg;
template <> struct ScanCfg<0> { static constexpr int NF = 200, E = 2, NA = 3, VOFF = 192; };
template <> struct ScanCfg<1> { static constexpr int NF = 268, E = 4, NA = 4, VOFF = 256; };
template <> struct ScanCfg<2> { static constexpr int NF = 328, E = 2, NA = 5, VOFF = 320; };
typedef float f32x2 __attribute__((ext_vector_type(2)));

__device__ __forceinline__ float reduce32(float x) {
  x = reduce16(x);
  const unsigned xi = __float_as_uint(x);
  auto r = __builtin_amdgcn_permlane32_swap(xi, xi, false, false);
  return __uint_as_float(r[0]) + __uint_as_float(r[1]);
}

template <int MODE>
__device__ void scan_task(const Params& p, int task, char* smem, int dry) {
  constexpr int NF = ScanCfg<MODE>::NF, E = ScanCfg<MODE>::E, NA = ScanCfg<MODE>::NA, VOFF = ScanCfg<MODE>::VOFF;
  float* rec = (float*)smem;
  const int tid = get_tid(), lane = tid & 63, wave = tid >> 6;
  const int sub = (lane & 15) + ((lane >> 5) << 4), row = wave * 2 + ((lane >> 4) & 1);
  int b, h, rowbase;
  if (MODE == 2) { int bh = task >> 3; b = bh >> 3; h = bh & 7; rowbase = (task & 7) * 8; }
  else { int bh = task >> 4; b = bh >> 2; h = bh & 3; rowbase = (task & 15) * 8; }
  char* ws = p.ws;
  const size_t bS = (size_t)b * SEQ;

  const h16* src[NA];
  int dsto[NA];
  int ldm;
  const h16* srcv;
  int ldv;
  const int tokv = tid & 31;
  const int dstv = tokv * NF + VOFF;
  if (MODE == 0) {
    const int tok = tid >> 3, ch = tid & 7;
    const h16* P = (const h16*)(ws + OFF_BIG);
    src[0] = (const h16*)(ws + OFF_ELA) + (bS + tok) * 256 + h * 64 + ch * 8;
    src[1] = P + (bS + tok) * EINP + 256 + h * 64 + ch * 8;
    src[2] = P + (bS + tok) * EINP + h * 64 + ch * 8;
    for (int a = 0; a < NA; a++) dsto[a] = tok * NF + a * 64 + ch * 8;
    ldm = EINP;
    srcv = P + (bS + tokv) * EINP + 512 + h * 128 + rowbase; ldv = EINP;
  } else if (MODE == 1) {
    for (int a = 0; a < NA; a++) {
      const int idx = tid + (a & 1) * 256, tok = idx >> 4, ch = idx & 15;
      src[a] = (const h16*)(ws + (a < 2 ? OFF_GK : OFF_GQ)) + (bS + tok) * 512 + h * 128 + ch * 8;
      dsto[a] = tok * NF + (a < 2 ? 0 : 128) + ch * 8;
    }
    ldm = 512;
    srcv = (const h16*)(ws + OFF_GV) + (bS + tokv) * 512 + h * 128 + rowbase; ldv = 512;
  } else {
    const int tok = tid >> 3, ch = tid & 7;
    for (int a = 0; a < NA; a++) {
      const size_t off = a == 0 ? OFF_W16 : a == 1 ? OFF_KK : a == 2 ? OFF_KKA : a == 3 ? OFF_KP : OFF_R;
      src[a] = (const h16*)(ws + off) + (bS + tok) * 512 + h * 64 + ch * 8;
      dsto[a] = tok * NF + a * 64 + ch * 8;
    }
    ldm = 512;
    srcv = (const h16*)(ws + OFF_V) + (bS + tokv) * 512 + h * 64 + rowbase; ldv = 512;
  }
  const float* srcab = (const float*)(ws + OFF_AB) + ((bS + (tid & 31)) * 4 + h) * 2;

  h16* outp; int ldo;
  if (MODE == 0) { outp = (h16*)(ws + OFF_BIG) + 512 + h * 128 + rowbase; ldo = EINP; }
  else if (MODE == 1) { outp = (h16*)(ws + OFF_GV) + h * 128 + rowbase; ldo = 512; }
  else { outp = (h16*)(ws + OFF_V) + h * 64 + rowbase; ldo = 512; }
  outp += bS * ldo;

  float s[E];
#pragma unroll
  for (int e = 0; e < E; e++) s[e] = 0.f;

  u32x4 pre[NA];
  u32x4 prev = {0u, 0u, 0u, 0u};
  float pab0 = 0.f, pab1 = 0.f;
#pragma unroll
  for (int a = 0; a < NA; a++) pre[a] = *(const u32x4*)(src[a]);
  if (tid < 32) prev = *(const u32x4*)(srcv);
  if (MODE == 1 && tid < 32) { pab0 = srcab[0]; pab1 = srcab[1]; }

  for (int t0 = 0; t0 < SEQ; t0 += TT) {
#pragma unroll
    for (int a = 0; a < NA; a++) {
      h16x8 hv = __builtin_bit_cast(h16x8, pre[a]);
      float f[8];
#pragma unroll
      for (int j = 0; j < 8; j++) {
        float x = (float)hv[j];
        if (MODE == 0 && a == 0) x = __expf(x);
        if (MODE == 0 && a == 2) x *= 0.125f;
        if (MODE == 2 && a == 0) x = __expf(-__expf(x));
        f[j] = x;
      }
      f32x4 lo = {f[0], f[1], f[2], f[3]}, hi = {f[4], f[5], f[6], f[7]};
      *(f32x4*)(rec + dsto[a]) = lo;
      *(f32x4*)(rec + dsto[a] + 4) = hi;
    }
    if (tid < 32) {
      h16x8 hv = __builtin_bit_cast(h16x8, prev);
      f32x4 lo = {(float)hv[0], (float)hv[1], (float)hv[2], (float)hv[3]};
      f32x4 hi = {(float)hv[4], (float)hv[5], (float)hv[6], (float)hv[7]};
      *(f32x4*)(rec + dstv) = lo;
      *(f32x4*)(rec + dstv + 4) = hi;
    }
    if (MODE == 1 && tid < 32) { rec[tid * NF + 264] = pab0; rec[tid * NF + 265] = pab1; }
    LDS_BARRIER();
    if (t0 + TT < SEQ) {
      const size_t tn = (size_t)(t0 + TT);
#pragma unroll
      for (int a = 0; a < NA; a++) {
        const int ld = (MODE == 0 && a == 0) ? 256 : ldm;
        pre[a] = *(const u32x4*)(src[a] + tn * ld);
      }
      if (tid < 32) prev = *(const u32x4*)(srcv + tn * ldv);
      if (MODE == 1 && tid < 32) { pab0 = srcab[tn * 8]; pab1 = srcab[tn * 8 + 1]; }
    }
    float yk = 0.f;
#pragma unroll 1
    for (int hb = 0; hb < TT / 16; hb++) {
      float yp[16];
#pragma unroll
      for (int j = 0; j < 16; j++) {
        const float* rc = rec + (hb * 16 + j) * NF;
        float y;
        if (MODE == 0) {
          f32x2 W = *(const f32x2*)(rc + sub * 2);
          f32x2 Kv = *(const f32x2*)(rc + 64 + sub * 2);
          f32x2 R = *(const f32x2*)(rc + 128 + sub * 2);
          float v = rc[VOFF + row];
          s[0] = fmaf(v, Kv[0], s[0] * W[0]);
          s[1] = fmaf(v, Kv[1], s[1] * W[1]);
          y = s[0] * R[0] + s[1] * R[1];
        } else if (MODE == 1) {
          f32x4 Kv = *(const f32x4*)(rc + sub * 4);
          f32x4 R = *(const f32x4*)(rc + 128 + sub * 4);
          float v = rc[VOFF + row];
          f32x2 ab = *(const f32x2*)(rc + 264);
          const float al = ab[0], be = ab[1];
          float d = (s[0] * Kv[0] + s[1] * Kv[1]) + (s[2] * Kv[2] + s[3] * Kv[3]);
          d = reduce32(d);
          float c = be * (v - al * d);
#pragma unroll
          for (int e = 0; e < 4; e++) s[e] = fmaf(c, Kv[e], al * s[e]);
          y = (s[0] * R[0] + s[1] * R[1]) + (s[2] * R[2] + s[3] * R[3]);
        } else {
          f32x2 W = *(const f32x2*)(rc + sub * 2);
          f32x2 Pv = *(const f32x2*)(rc + 64 + sub * 2);
          f32x2 Av = *(const f32x2*)(rc + 128 + sub * 2);
          f32x2 Kv = *(const f32x2*)(rc + 192 + sub * 2);
          f32x2 R = *(const f32x2*)(rc + 256 + sub * 2);
          float v = rc[VOFF + row];
          float d = s[0] * Pv[0] + s[1] * Pv[1];
          d = reduce32(d);
          s[0] = fmaf(v, Kv[0], fmaf(-d, Av[0], s[0] * W[0]));
          s[1] = fmaf(v, Kv[1], fmaf(-d, Av[1], s[1] * W[1]));
          y = s[0] * R[0] + s[1] * R[1];
        }
        yp[j] = y;
      }
      {
        const bool b3 = (lane & 8) != 0, b2 = (lane & 4) != 0, b1 = (lane & 2) != 0, b0 = (lane & 1) != 0;
        float q8[8], q4[4], q2[2];
#pragma unroll
        for (int i = 0; i < 8; i++) {
          float keep = b3 ? yp[i + 8] : yp[i], send = b3 ? yp[i] : yp[i + 8];
          q8[i] = keep + dpp_f<0x140>(send);
        }
#pragma unroll
        for (int i = 0; i < 4; i++) {
          float keep = b2 ? q8[i + 4] : q8[i], send = b2 ? q8[i] : q8[i + 4];
          q4[i] = keep + dpp_f<0x141>(send);
        }
#pragma unroll
        for (int i = 0; i < 2; i++) {
          float keep = b1 ? q4[i + 2] : q4[i], send = b1 ? q4[i] : q4[i + 2];
          q2[i] = keep + dpp_f<0x4E>(send);
        }
        float keep = b0 ? q2[1] : q2[0], send = b0 ? q2[0] : q2[1];
        float q1 = keep + dpp_f<0xB1>(send);
        const unsigned qi = __float_as_uint(q1);
        auto r = __builtin_amdgcn_permlane32_swap(qi, qi, false, false);
        q1 = __uint_as_float(r[0]) + __uint_as_float(r[1]);
        yk = ((sub >> 4) == hb) ? q1 : yk;
      }
    }
    if (!dry) outp[(size_t)(t0 + sub) * ldo + row] = (h16)yk;
    LDS_BARRIER();
  }
}
#define SCAN_BARRIERS (2 * (SEQ / TT))

#define OFF_SUMA (OFF_BON + 1 * MIB)
#define OFF_SUMH (OFF_BON + 1 * MIB + 256 * 1024)
__device__ void lru_scan_task(const Params& p, int task, int dry) {
  const int tid = get_tid();
  const int half = task & 1, seg = (task >> 1) & 31, b = task >> 6;
  const int c = half * 256 + tid;
  const size_t base = ((size_t)b * SEQ + seg * 256) * 512 + c;
  h16* la = (h16*)(p.ws + OFF_LLA) + base;
  h16* bb = (h16*)(p.ws + OFF_LB) + base;
  float hs = 0.f, ap = 1.f;
  h16 na[16], nb[16];
#pragma unroll
  for (int i = 0; i < 16; i++) { na[i] = la[(size_t)i * 512]; nb[i] = bb[(size_t)i * 512]; }
  for (int t0 = 0; t0 < 256; t0 += 16) {
    h16 ca[16], cb[16];
#pragma unroll
    for (int i = 0; i < 16; i++) { ca[i] = na[i]; cb[i] = nb[i]; }
    if (t0 + 16 < 256) {
#pragma unroll
      for (int i = 0; i < 16; i++) { na[i] = la[(size_t)(t0 + 16 + i) * 512]; nb[i] = bb[(size_t)(t0 + 16 + i) * 512]; }
    }
#pragma unroll
    for (int i = 0; i < 16; i++) {
      float a = __expf((float)ca[i]);
      hs = fmaf(a, hs, (float)cb[i]);
      ap *= a;
      if (!dry) { bb[(size_t)(t0 + i) * 512] = (h16)hs;
      la[(size_t)(t0 + i) * 512] = (h16)ap; }
    }
  }
  if (!dry) { ((float*)(p.ws + OFF_SUMA))[(b * 32 + seg) * 512 + c] = ap;
  ((float*)(p.ws + OFF_SUMH))[(b * 32 + seg) * 512 + c] = hs; }
}

#define PR_NF 600
__device__ __forceinline__ float treduce16(const float (&yp)[16], int lane) {
  const bool b3 = (lane & 8) != 0, b2 = (lane & 4) != 0, b1 = (lane & 2) != 0, b0 = (lane & 1) != 0;
  float q8[8], q4[4], q2[2];
#pragma unroll
  for (int i = 0; i < 8; i++) { float keep = b3 ? yp[i + 8] : yp[i], send = b3 ? yp[i] : yp[i + 8]; q8[i] = keep + dpp_f<0x140>(send); }
#pragma unroll
  for (int i = 0; i < 4; i++) { float keep = b2 ? q8[i + 4] : q8[i], send = b2 ? q8[i] : q8[i + 4]; q4[i] = keep + dpp_f<0x141>(send); }
#pragma unroll
  for (int i = 0; i < 2; i++) { float keep = b1 ? q4[i + 2] : q4[i], send = b1 ? q4[i] : q4[i + 2]; q2[i] = keep + dpp_f<0x4E>(send); }
  float keep = b0 ? q2[1] : q2[0], send = b0 ? q2[0] : q2[1];
  float q1 = keep + dpp_f<0xB1>(send);
  const unsigned qi = __float_as_uint(q1);
  auto r = __builtin_amdgcn_permlane32_swap(qi, qi, false, false);
  return __uint_as_float(r[0]) + __uint_as_float(r[1]);
}

__device__ void lru_scan_task(const Params& p, int task, int dry);

__device__ void rwkv_scan_pc(const Params& p, int blk, char* gsm, int dry) {
  const int rtid = real_tid();
  const int vb = __builtin_amdgcn_readfirstlane(rtid >> 8), tid = rtid & 255, lane = tid & 63, wave = tid >> 6;
  float* bufs = (float*)gsm;
  const int bh = blk >> 3, b = bh >> 3, h = bh & 7, rowbase = (blk & 7) * 8;
  const size_t bS = (size_t)b * SEQ;
  char* ws = p.ws;
  if (vb == 1) {
    const int pair = tid >> 4, l15 = tid & 15, c4 = l15 * 4;
    const size_t cofs = (size_t)h * 64 + c4;
    const h16* aW = (const h16*)(ws + OFF_W16) + cofs;
    const h16* aP = (const h16*)(ws + OFF_KK) + cofs;
    const h16* aA = (const h16*)(ws + OFF_KKA) + cofs;
    const h16* aK = (const h16*)(ws + OFF_KP) + cofs;
    const h16* aR = (const h16*)(ws + OFF_R) + cofs;
    const h16* aV = (const h16*)(ws + OFF_V) + (size_t)h * 64 + rowbase;
    const int lhalf = blk & 1, lseg = (blk >> 1) & 31, lb_ = blk >> 6;
    const int lc = lhalf * 256 + tid;
    const size_t lbase = ((size_t)lb_ * SEQ + lseg * 256) * 512 + lc;
    h16* lla = (h16*)(ws + OFF_LLA) + lbase;
    h16* lbb = (h16*)(ws + OFF_LB) + lbase;
    float lhs = 0.f, lap = 1.f;
    h16x4 nw1, nw2, np1, np2, na1, na2, nk1, nk2, nr1, nr2;
    h16x8 nv1, nv2;
    {
      const size_t tok = bS + pair * 2;
      nw1 = *(const h16x4*)(aW + tok * 512); nw2 = *(const h16x4*)(aW + (tok + 1) * 512);
      np1 = *(const h16x4*)(aP + tok * 512); np2 = *(const h16x4*)(aP + (tok + 1) * 512);
      na1 = *(const h16x4*)(aA + tok * 512); na2 = *(const h16x4*)(aA + (tok + 1) * 512);
      nk1 = *(const h16x4*)(aK + tok * 512); nk2 = *(const h16x4*)(aK + (tok + 1) * 512);
      nr1 = *(const h16x4*)(aR + tok * 512); nr2 = *(const h16x4*)(aR + (tok + 1) * 512);
      if (l15 == 1) { nv1 = *(const h16x8*)(aV + tok * 512); nv2 = *(const h16x8*)(aV + (tok + 1) * 512); }
    }
#pragma unroll 1
    for (int tile = 0; tile < SEQ / 32; tile++) {
      const h16x4 hw1 = nw1, hw2 = nw2, hp1 = np1, hp2 = np2, ha1 = na1, ha2 = na2, hk1 = nk1, hk2 = nk2, hr1 = nr1, hr2 = nr2;
      const h16x8 hv1 = nv1, hv2 = nv2;
      const h16 l_a = lla[(size_t)tile * 512], l_b = lbb[(size_t)tile * 512];
      if (tile + 1 < SEQ / 32) {
        const size_t tok = bS + (size_t)(tile + 1) * 32 + pair * 2;
        nw1 = *(const h16x4*)(aW + tok * 512); nw2 = *(const h16x4*)(aW + (tok + 1) * 512);
        np1 = *(const h16x4*)(aP + tok * 512); np2 = *(const h16x4*)(aP + (tok + 1) * 512);
        na1 = *(const h16x4*)(aA + tok * 512); na2 = *(const h16x4*)(aA + (tok + 1) * 512);
        nk1 = *(const h16x4*)(aK + tok * 512); nk2 = *(const h16x4*)(aK + (tok + 1) * 512);
        nr1 = *(const h16x4*)(aR + tok * 512); nr2 = *(const h16x4*)(aR + (tok + 1) * 512);
        if (l15 == 1) { nv1 = *(const h16x8*)(aV + tok * 512); nv2 = *(const h16x8*)(aV + (tok + 1) * 512); }
      }
      f32x4 P1, P2p, R1p, R2p, W12, AW, KW, A2, K2;
      float sc[8];
#pragma unroll
      for (int e = 0; e < 8; e++) sc[e] = 0.f;
#pragma unroll
      for (int e = 0; e < 4; e++) {
        const float W1 = __expf(-__expf((float)hw1[e])), W2 = __expf(-__expf((float)hw2[e]));
        const float p1 = (float)hp1[e], p2 = (float)hp2[e], a1 = (float)ha1[e], a2 = (float)ha2[e];
        const float k1 = (float)hk1[e], k2 = (float)hk2[e], r1 = (float)hr1[e], r2 = (float)hr2[e];
        const float w12 = W1 * W2, aw = a1 * W2, kw = k1 * W2;
        P1[e] = p1; P2p[e] = W1 * p2; R1p[e] = W1 * r1; R2p[e] = w12 * r2; W12[e] = w12; AW[e] = aw; KW[e] = kw; A2[e] = a2; K2[e] = k2;
        sc[0] += a1 * p2; sc[1] += k1 * p2; sc[2] += a1 * r1; sc[3] += k1 * r1;
        sc[4] += aw * r2; sc[5] += kw * r2; sc[6] += a2 * r2; sc[7] += k2 * r2;
      }
#pragma unroll
      for (int e = 0; e < 8; e++) sc[e] = reduce16(sc[e]);
      float* rec = bufs + (tile & 1) * (16 * PR_NF) + pair * PR_NF;
      *(f32x4*)(rec + c4) = P1;        *(f32x4*)(rec + 64 + c4) = P2p;  *(f32x4*)(rec + 128 + c4) = R1p;
      *(f32x4*)(rec + 192 + c4) = R2p; *(f32x4*)(rec + 256 + c4) = W12; *(f32x4*)(rec + 320 + c4) = AW;
      *(f32x4*)(rec + 384 + c4) = KW;  *(f32x4*)(rec + 448 + c4) = A2;  *(f32x4*)(rec + 512 + c4) = K2;
      if (l15 == 0) {
        f32x4 s0 = {sc[0], sc[1], sc[2], sc[3]}, s1 = {sc[4], sc[5], sc[6], sc[7]};
        *(f32x4*)(rec + 576) = s0; *(f32x4*)(rec + 580) = s1;
      }
      if (l15 == 1) {
#pragma unroll
        for (int r = 0; r < 8; r++) { rec[584 + r] = (float)hv1[r]; rec[592 + r] = (float)hv2[r]; }
      }
      {
        const float a_ = __expf((float)l_a);
        lhs = fmaf(a_, lhs, (float)l_b);
        lap *= a_;
        if (!dry) { lbb[(size_t)tile * 512] = (h16)lhs; lla[(size_t)tile * 512] = (h16)lap; }
      }
      LDS_BARRIER();
    }
    LDS_BARRIER();
    if (!dry) {
      ((float*)(ws + OFF_SUMA))[(lb_ * 32 + lseg) * 512 + lc] = lap;
      ((float*)(ws + OFF_SUMH))[(lb_ * 32 + lseg) * 512 + lc] = lhs;
    }
  } else {
    const int sub = (lane & 15) + ((lane >> 5) << 4), row = wave * 2 + ((lane >> 4) & 1);
    const float m0 = (sub == 0) ? 1.f : 0.f;
    h16* outp = (h16*)(ws + OFF_V) + bS * 512 + (size_t)h * 64 + rowbase;
    f32x2 s = {0.f, 0.f};
    LDS_BARRIER();
#pragma unroll 1
    for (int tile = 0; tile < SEQ / 32; tile++) {
      const float* recb = bufs + (tile & 1) * (16 * PR_NF);
      float yk = 0.f;
#pragma unroll 1
      for (int hb = 0; hb < 2; hb++) {
        float yp[16];
        f32x2 nP1, nP2p, nR1p, nR2p, nW12, nAW, nKW, nA2, nK2; f32x4 nc0, nc1; float nv1, nv2;
        {
          const float* rc = recb + (hb * 8) * PR_NF;
          nP1 = *(const f32x2*)(rc + sub * 2); nP2p = *(const f32x2*)(rc + 64 + sub * 2);
          nR1p = *(const f32x2*)(rc + 128 + sub * 2); nR2p = *(const f32x2*)(rc + 192 + sub * 2);
          nW12 = *(const f32x2*)(rc + 256 + sub * 2); nAW = *(const f32x2*)(rc + 320 + sub * 2);
          nKW = *(const f32x2*)(rc + 384 + sub * 2); nA2 = *(const f32x2*)(rc + 448 + sub * 2); nK2 = *(const f32x2*)(rc + 512 + sub * 2);
          nc0 = *(const f32x4*)(rc + 576); nc1 = *(const f32x4*)(rc + 580);
          nv1 = rc[584 + row]; nv2 = rc[592 + row];
        }
#pragma unroll
        for (int jp = 0; jp < 8; jp++) {
          const f32x2 P1 = nP1, P2p = nP2p, R1p = nR1p, R2p = nR2p, W12 = nW12, AW = nAW, KW = nKW, A2 = nA2, K2 = nK2;
          const f32x4 c0 = nc0, c1 = nc1;
          const float v1 = nv1, v2 = nv2;
          if (jp + 1 < 8) {
            const float* rc = recb + (hb * 8 + jp + 1) * PR_NF;
            nP1 = *(const f32x2*)(rc + sub * 2); nP2p = *(const f32x2*)(rc + 64 + sub * 2);
            nR1p = *(const f32x2*)(rc + 128 + sub * 2); nR2p = *(const f32x2*)(rc + 192 + sub * 2);
            nW12 = *(const f32x2*)(rc + 256 + sub * 2); nAW = *(const f32x2*)(rc + 320 + sub * 2);
            nKW = *(const f32x2*)(rc + 384 + sub * 2); nA2 = *(const f32x2*)(rc + 448 + sub * 2); nK2 = *(const f32x2*)(rc + 512 + sub * 2);
            nc0 = *(const f32x4*)(rc + 576); nc1 = *(const f32x4*)(rc + 580);
            nv1 = rc[584 + row]; nv2 = rc[592 + row];
          }
          float d1 = s[0] * P1[0] + s[1] * P1[1];
          float d2 = s[0] * P2p[0] + s[1] * P2p[1];
          float y1 = s[0] * R1p[0] + s[1] * R1p[1];
          float y2 = s[0] * R2p[0] + s[1] * R2p[1];
          d1 += dpp_f<0xB1>(d1); d2 += dpp_f<0xB1>(d2);
          d1 += dpp_f<0x4E>(d1); d2 += dpp_f<0x4E>(d2);
          d1 += dpp_f<0x141>(d1); d2 += dpp_f<0x141>(d2);
          d1 += dpp_f<0x140>(d1); d2 += dpp_f<0x140>(d2);
          {
            auto r1 = __builtin_amdgcn_permlane32_swap(__float_as_uint(d1), __float_as_uint(d1), false, false);
            auto r2 = __builtin_amdgcn_permlane32_swap(__float_as_uint(d2), __float_as_uint(d2), false, false);
            d1 = __uint_as_float(r1[0]) + __uint_as_float(r1[1]);
            d2 = __uint_as_float(r2[0]) + __uint_as_float(r2[1]);
          }
          d2 = d2 - d1 * c0[0] + v1 * c0[1];
          const f32x2 base = s * W12 + (f32x2{v1, v1} * KW - f32x2{d1, d1} * AW);
          s = base + (f32x2{v2, v2} * K2 - f32x2{d2, d2} * A2);
          y1 += m0 * (v1 * c0[3] - d1 * c0[2]);
          y2 += m0 * (v1 * c1[1] - d1 * c1[0] + v2 * c1[3] - d2 * c1[2]);
          yp[2 * jp] = y1; yp[2 * jp + 1] = y2;
        }
        const float q1 = treduce16(yp, lane);
        yk = ((sub >> 4) == hb) ? q1 : yk;
      }
      if (!dry) outp[(size_t)(tile * 32 + sub) * 512 + row] = (h16)yk;
      LDS_BARRIER();
    }
  }
}

__device__ void even_pre(const Params& p, char* smem) {
  const int tid = get_tid(), lane = tid & 63, wave = tid >> 6;
  const h16* P = (const h16*)(p.ws + OFF_BIG);
  for (int blk = get_bid(); blk < MTOK / 64; blk += VGRID) {
    const int tgs = blk * 64;
    const int t0 = tgs & (SEQ - 1);
    if (wave < 3) {
      const int c0 = wave * 512 + lane * 8;
      const float* cw = p.in[10];
      float cwr[4][8];
#pragma unroll
      for (int j = 0; j < 4; j++) {
        f32x4 x0 = *(const f32x4*)(cw + j * 1536 + c0), x1 = *(const f32x4*)(cw + j * 1536 + c0 + 4);
#pragma unroll
        for (int e = 0; e < 4; e++) { cwr[j][e] = x0[e]; cwr[j][4 + e] = x1[e]; }
      }
      h16* dst = (h16*)(p.ws + (wave == 0 ? OFF_GQ : wave == 1 ? OFF_GK : OFF_GV)) + lane * 8;
      const h16* src = P + 1552 + c0;
      h16x8 xm[3];
#pragma unroll
      for (int j = 0; j < 3; j++) {
#pragma unroll
        for (int e = 0; e < 8; e++) xm[j][e] = (h16)0.f;
        if (t0 > 0) xm[j] = *(const h16x8*)(src + (size_t)(tgs - 3 + j) * EINP);
      }
      const float qs = (wave == 0) ? 0.08838834764831845f : 1.f;
#pragma unroll 1
      for (int tb = 0; tb < 64; tb += 4) {
        h16x8 xn[4];
#pragma unroll
        for (int u = 0; u < 4; u++) xn[u] = *(const h16x8*)(src + (size_t)(tgs + tb + u) * EINP);
#pragma unroll
        for (int u = 0; u < 4; u++) {
          float val[8];
          float ss = 0.f;
#pragma unroll
          for (int e = 0; e < 8; e++) {
            float v = (float)xm[0][e] * cwr[0][e] + (float)xm[1][e] * cwr[1][e] + (float)xm[2][e] * cwr[2][e] + (float)xn[u][e] * cwr[3][e];
            v = silu_(v);
            val[e] = v;
            ss += v * v;
          }
          float sc = 1.f;
          if (wave < 2) { ss = reduce16(ss); sc = rsqrtf(ss + 1e-6f) * qs; }
          h16x8 o;
#pragma unroll
          for (int e = 0; e < 8; e++) o[e] = (h16)(val[e] * sc);
          *(h16x8*)(dst + (size_t)(tgs + tb + u) * 512) = o;
          xm[0] = xm[1]; xm[1] = xm[2]; xm[2] = xn[u];
        }
      }
    } else {
      const int c4 = lane * 4;
      const float* w2 = p.in[7];
      float w2r[16][4];
#pragma unroll
      for (int j = 0; j < 16; j++) {
        f32x4 x0 = *(const f32x4*)(w2 + j * 256 + c4);
#pragma unroll
        for (int e = 0; e < 4; e++) w2r[j][e] = x0[e];
      }
      const f32x4 lb4 = *(const f32x4*)(p.in[8] + c4);
      h16* ELA = (h16*)(p.ws + OFF_ELA);
      float* AB = (float*)(p.ws + OFF_AB);
      const float alog = (lane < 4) ? p.in[11][lane] : 0.f, dtb = (lane < 4) ? p.in[12][lane] : 0.f;
#pragma unroll 2
      for (int tok = 0; tok < 64; tok++) {
        const size_t tg = (size_t)tgs + tok;
        const h16* pr = P + tg * EINP + 1536;
        h16x8 g0 = *(const h16x8*)(pr), g1 = *(const h16x8*)(pr + 8);
        float z[4] = {lb4[0], lb4[1], lb4[2], lb4[3]};
#pragma unroll
        for (int j = 0; j < 16; j++) {
          const float gj = (float)(j < 8 ? g0[j] : g1[j - 8]);
#pragma unroll
          for (int e = 0; e < 4; e++) z[e] = fmaf(gj, w2r[j][e], z[e]);
        }
        h16x4 o;
#pragma unroll
        for (int e = 0; e < 4; e++) o[e] = (h16)(-softplus_(-z[e]) * (1.f / 16.f));
        *(h16x4*)(ELA + tg * 256 + c4) = o;
        if (lane < 4) {
          float da = (float)P[tg * EINP + 3600 + lane];
          float db = (float)P[tg * EINP + 3604 + lane];
          float g = -__expf(alog) * softplus_(da + dtb);
          AB[(tg * 4 + lane) * 2 + 0] = __expf(g);
          AB[(tg * 4 + lane) * 2 + 1] = sigm(db);
        }
      }
    }
  }
}

__device__ void even_post(const Params& p) {
  const int lane = get_tid() & 63;
  const int gw = get_bid() * 4 + (get_tid() >> 6);
  const int nw = VGRID * 4;
  const int half = gw & 1, c8 = lane * 8;
  const h16* __restrict__ P = (const h16*)(p.ws + OFF_BIG);
  const h16* __restrict__ GV = (const h16*)(p.ws + OFF_GV);
  h16* __restrict__ Y = (h16*)(p.ws + OFF_HH);
  const float* nwp = (half ? p.in[13] : p.in[9]) + (c8 & 127);
  float wn[8];
#pragma unroll
  for (int e = 0; e < 8; e++) wn[e] = nwp[e];
  const int tstep = nw >> 1;
  for (int tg = gw >> 1; tg < MTOK; tg += 2 * tstep) {
    h16x8 o[2], z[2];
#pragma unroll
    for (int u = 0; u < 2; u++) {
      const int t = tg + u * tstep;
      if (t < MTOK) {
        const h16* pr = P + (size_t)t * EINP;
        o[u] = half ? *(const h16x8*)(GV + (size_t)t * 512 + c8) : *(const h16x8*)(pr + 512 + c8);
        z[u] = *(const h16x8*)(pr + (half ? 3088 : 1024) + c8);
      }
    }
#pragma unroll
    for (int u = 0; u < 2; u++) {
      const int t = tg + u * tstep;
      if (t < MTOK) {
        float of[8], ss = 0.f;
#pragma unroll
        for (int e = 0; e < 8; e++) { of[e] = (float)o[u][e]; ss += of[e] * of[e]; }
        ss = reduce16(ss);
        const float inv = rsqrtf(ss * (1.f / 128.f) + 1e-6f);
        h16x8 r;
#pragma unroll
        for (int e = 0; e < 8; e++) r[e] = (h16)(of[e] * inv * wn[e] * silu_((float)z[u][e]));
        *(h16x8*)(Y + (size_t)t * DM + half * 512 + c8) = r;
      }
    }
  }
}

__device__ __forceinline__ float psmix(const h16* __restrict__ P, const float* __restrict__ mu, size_t tg, int t, int c) {
  float cur = (float)P[tg * OIN + c];
  float prev = (t > 0) ? (float)P[(tg - 1) * OIN + c] : 0.f;
  return cur + (prev - cur) * mu[c];
}
__device__ __forceinline__ float psmixm(const h16* __restrict__ P, float m, size_t tg, int t, int c) {
  float cur = (float)P[tg * OIN + c];
  float prev = (t > 0) ? (float)P[(tg - 1) * OIN + c] : 0.f;
  return cur + (prev - cur) * m;
}
__device__ __forceinline__ void psmix8(const h16* __restrict__ P, const float* __restrict__ mu, size_t tg, int t, int c0, float* o) {
  h16x8 cur = *(const h16x8*)(P + tg * OIN + c0);
  h16x8 prv = cur;
  if (t > 0) prv = *(const h16x8*)(P + (tg - 1) * OIN + c0);
  f32x4 m0 = *(const f32x4*)(mu + c0), m1 = *(const f32x4*)(mu + c0 + 4);
#pragma unroll
  for (int j = 0; j < 8; j++) {
    float cf = (float)cur[j];
    float pf = (t > 0) ? (float)prv[j] : 0.f;
    o[j] = cf + (pf - cf) * (j < 4 ? m0[j] : m1[j - 4]);
  }
}
__device__ __forceinline__ float half_sum(float x, int lane) {
  x = reduce16(x);
  const unsigned xi = __float_as_uint(x);
  auto r = __builtin_amdgcn_permlane16_swap(xi, xi, false, false);
  return __uint_as_float(r[0]) + __uint_as_float(r[1]);
}

#define OFF_SW (483 * MIB)
#define SW_W2T 0
#define SW_A2T 32768
#define SW_WAT 65536
#define SW_WXT 98304
#define SW_G2T 131072
__device__ void convert_small(const Params& p) {
  h16* sw = (h16*)(p.ws + OFF_SW);
  for (int idx = get_bid() * 256 + get_tid(); idx < 196608; idx += VGRID * 256) {
    float v;
    if (idx < 131072) {
      const int which = idx >> 15, n = (idx >> 6) & 511, k = idx & 63;
      if (which == 0) v = p.in[18][k * 512 + n];
      else if (which == 1) v = p.in[20][k * 512 + n];
      else if (which == 2) v = p.in[29][((n >> 6) * 64 + k) * 64 + (n & 63)];
      else v = p.in[31][((n >> 6) * 64 + k) * 64 + (n & 63)];
    } else {
      const int j = idx - 131072, n = j >> 7, k = j & 127;
      v = p.in[21][k * 512 + n];
    }
    sw[idx] = (h16)v;
  }
}

#define TLD 136
__device__ void odd_pre(const Params& p, char* smem) {
  const int tid = get_tid(), lane = tid & 63, wave = tid >> 6;
  const int l31 = lane & 31, lh = lane >> 5;
  const h16* P = (const h16*)(p.ws + OFF_BIG);
  const float* mu = p.in[16];
  const h16* sw = (const h16*)(p.ws + OFF_SW);
  for (int job = get_bid(); job < 2048; job += VGRID) {
    if (job < 1024) {
#ifndef NO_RWKVPRE
      const int tg0 = job * 32, t0 = tg0 & (SEQ - 1);
      h16* AL = (h16*)smem;
#pragma unroll
      for (int i = 0; i < 2; i++) {
        const int e = tid + i * 256, tok = e >> 4, ch = e & 15;
        float o[8];
        psmix8(P, mu, (size_t)tg0 + tok, t0 + tok, 1536 + ch * 8, o);
        h16x8 hv;
#pragma unroll
        for (int j = 0; j < 8; j++) hv[j] = (h16)(ch < 8 ? fast_tanh(o[j]) : o[j]);
        *(h16x8*)(AL + tok * TLD + ch * 8) = hv;
      }
      LDS_BARRIER();
      h16* W16 = (h16*)(p.ws + OFF_W16);
      h16* KK = (h16*)(p.ws + OFF_KK);
      h16* KKA = (h16*)(p.ws + OFF_KKA);
      h16* KP = (h16*)(p.ws + OFF_KP);
      h16* RR = (h16*)(p.ws + OFF_R);
      h16* VV = (h16*)(p.ws + OFF_V);
      float* BON = (float*)(p.ws + OFF_BON);
#pragma unroll 1
      for (int hh = 0; hh < 2; hh++) {
        const int head = wave * 2 + hh;
        f32x16 accw[2], acca[2];
#pragma unroll
        for (int n = 0; n < 2; n++)
#pragma unroll
          for (int r = 0; r < 16; r++) { accw[n][r] = 0.f; acca[n][r] = 0.f; }
#pragma unroll
        for (int ks = 0; ks < 4; ks++) {
          h16x8 aw = *(const h16x8*)(AL + l31 * TLD + ks * 16 + lh * 8);
          h16x8 aa = *(const h16x8*)(AL + l31 * TLD + 64 + ks * 16 + lh * 8);
#pragma unroll
          for (int q = 0; q < 2; q++) {
            const int n = wave * 128 + (hh * 2 + q) * 32 + l31;
            h16x8 bw = *(const h16x8*)(sw + SW_W2T + n * 64 + ks * 16 + lh * 8);
            h16x8 ba = *(const h16x8*)(sw + SW_A2T + n * 64 + ks * 16 + lh * 8);
            accw[q] = __builtin_amdgcn_mfma_f32_32x32x16_f16(aw, bw, accw[q], 0, 0, 0);
            acca[q] = __builtin_amdgcn_mfma_f32_32x32x16_f16(aa, ba, acca[q], 0, 0, 0);
          }
        }
        float w0c[2], a0c[2], kkc[2], kac[2], rkc[2], mur[2], muk[2], muv[2];
#pragma unroll
        for (int q = 0; q < 2; q++) {
          const int c = wave * 128 + (hh * 2 + q) * 32 + l31;
          w0c[q] = p.in[17][c]; a0c[q] = p.in[19][c]; kkc[q] = p.in[22][c]; kac[q] = p.in[23][c]; rkc[q] = p.in[24][c];
          mur[q] = mu[c]; muk[q] = mu[512 + c]; muv[q] = mu[1024 + c];
        }
        int tgb = tg0;
#pragma unroll
        for (int r = 0; r < 16; r++) {
          if ((r & 3) == 0) asm volatile("" : "+s"(tgb));
          const int tr = (r & 3) + 8 * (r >> 2) + 4 * lh;
          const size_t tg = (size_t)tgb + tr;
          const int t = (tgb & (SEQ - 1)) + tr;
          float kr[2], av[2];
          float ssp = 0.f, bonp = 0.f;
#pragma unroll
          for (int q = 0; q < 2; q++) {
            const int nt = hh * 2 + q;
            const int c = wave * 128 + nt * 32 + l31;
            float r_ = psmixm(P, mur[q], tg, t, c);
            float k_ = psmixm(P, muk[q], tg, t, 512 + c);
            float v_ = psmixm(P, muv[q], tg, t, 1024 + c);
            float w = -softplus_(-(w0c[q] + accw[q][r])) - 0.5f;
            float a = sigm(a0c[q] + acca[q][r]);
            kr[q] = k_ * kkc[q];
            av[q] = a;
            float kp = k_ * (1.f + (a - 1.f) * kac[q]);
            ssp += kr[q] * kr[q];
            bonp += r_ * kp * rkc[q];
            W16[tg * 512 + c] = (h16)w;
            KP[tg * 512 + c] = (h16)kp;
            RR[tg * 512 + c] = (h16)r_;
            VV[tg * 512 + c] = (h16)v_;
          }
          const float ss = half_sum(ssp, lane);
          const float bon = half_sum(bonp, lane);
          const float inv = rsqrtf(ss + 1e-6f);
#pragma unroll
          for (int q = 0; q < 2; q++) {
            const int c = wave * 128 + (hh * 2 + q) * 32 + l31;
            const float kk = kr[q] * inv;
            KK[tg * 512 + c] = (h16)kk;
            KKA[tg * 512 + c] = (h16)(kk * av[q]);
          }
          if (l31 == 0) BON[tg * 8 + head] = bon;
          if ((r & 3) == 3) asm volatile("" ::: "memory");
        }
      }
      LDS_BARRIER();
#endif
    } else {
#ifndef NO_LRUPRE
      const int tg0 = (job - 1024) * 32, t0 = tg0 & (SEQ - 1);
      h16* XB = (h16*)smem + wave * (32 * TLD);
      {
        const int ch = lane & 15, tq = lane >> 4;
        const int c0 = wave * 128 + ch * 8;
        const float* cw = p.in[27];
        float cwr[4][8], cbr[8];
#pragma unroll
        for (int j = 0; j < 4; j++) {
          f32x4 x0 = *(const f32x4*)(cw + j * 512 + c0), x1 = *(const f32x4*)(cw + j * 512 + c0 + 4);
#pragma unroll
          for (int e = 0; e < 4; e++) { cwr[j][e] = x0[e]; cwr[j][4 + e] = x1[e]; }
        }
        {
          f32x4 x0 = *(const f32x4*)(p.in[28] + c0), x1 = *(const f32x4*)(p.in[28] + c0 + 4);
#pragma unroll
          for (int e = 0; e < 4; e++) { cbr[e] = x0[e]; cbr[4 + e] = x1[e]; }
        }
        h16x8 x[11];
#pragma unroll
        for (int j = 0; j < 11; j++) {
          const int tt = tq * 8 - 3 + j;
          h16x8 z;
#pragma unroll
          for (int e = 0; e < 8; e++) z[e] = (h16)0.f;
          x[j] = z;
          if (t0 + tt >= 0) x[j] = *(const h16x8*)(P + (size_t)((long)tg0 + tt) * OIN + 1792 + c0);
        }
#pragma unroll
        for (int tok = 0; tok < 8; tok++) {
          h16x8 hv;
#pragma unroll
          for (int e = 0; e < 8; e++) {
            float xb = cbr[e] + (float)x[tok][e] * cwr[0][e] + (float)x[tok + 1][e] * cwr[1][e] +
                       (float)x[tok + 2][e] * cwr[2][e] + (float)x[tok + 3][e] * cwr[3][e];
            hv[e] = (h16)xb;
          }
          *(h16x8*)(XB + (tq * 8 + tok) * TLD + ch * 8) = hv;
        }
      }
      LDS_BARRIER();
      h16* LLA = (h16*)(p.ws + OFF_LLA);
      h16* LB = (h16*)(p.ws + OFF_LB);
#pragma unroll 1
      for (int blk = 0; blk < 2; blk++) {
        f32x16 accr[2], acci[2];
#pragma unroll
        for (int n = 0; n < 2; n++)
#pragma unroll
          for (int r = 0; r < 16; r++) { accr[n][r] = 0.f; acci[n][r] = 0.f; }
#pragma unroll
        for (int ks = 0; ks < 4; ks++) {
          h16x8 a = *(const h16x8*)(XB + l31 * TLD + blk * 64 + ks * 16 + lh * 8);
#pragma unroll
          for (int q = 0; q < 2; q++) {
            const int n = wave * 128 + (blk * 2 + q) * 32 + l31;
            h16x8 br, bi;
#pragma unroll
            for (int j = 0; j < 8; j++) {
              br[j] = (h16)p.in[29][((n >> 6) * 64 + ks * 16 + lh * 8 + j) * 64 + (n & 63)];
              bi[j] = (h16)p.in[31][((n >> 6) * 64 + ks * 16 + lh * 8 + j) * 64 + (n & 63)];
            }
            accr[q] = __builtin_amdgcn_mfma_f32_32x32x16_f16(a, br, accr[q], 0, 0, 0);
            acci[q] = __builtin_amdgcn_mfma_f32_32x32x16_f16(a, bi, acci[q], 0, 0, 0);
          }
        }
#pragma unroll
        for (int q = 0; q < 2; q++) {
          const int nt = blk * 2 + q;
          const int c = wave * 128 + nt * 32 + l31;
          const float bac = p.in[30][c], bxc = p.in[32][c];
          const float spl = softplus_(-p.in[33][c]);
          int tgb = tg0;
#pragma unroll
          for (int r = 0; r < 16; r++) {
            if ((r & 7) == 0) asm volatile("" : "+s"(tgb));
            const int tr = (r & 3) + 8 * (r >> 2) + 4 * lh;
            const size_t tg = (size_t)tgb + tr;
            float gr = sigm(accr[q][r] + bac);
            float gi = sigm(acci[q][r] + bxc);
            float la = -8.f * gr * spl;
            float mult = __builtin_amdgcn_sqrtf(fmaxf(1.f - __expf(2.f * la), 0.f));
            float xbv = (float)XB[tr * TLD + nt * 32 + l31];
            LLA[tg * 512 + c] = (h16)la;
            LB[tg * 512 + c] = (h16)(mult * gi * xbv);
            if ((r & 7) == 7) asm volatile("" ::: "memory");
          }
        }
      }
      LDS_BARRIER();
#endif
    }
  }
}

__device__ void odd_post(const Params& p, char* smem) {
  const int tid = get_tid(), lane = tid & 63, wave = tid >> 6;
  const int l31 = lane & 31, lh = lane >> 5;
  const h16* P = (const h16*)(p.ws + OFF_BIG);
  const float* mu = p.in[16];
  const h16* G2T = (const h16*)(p.ws + OFF_SW) + SW_G2T;
  const h16* YS = (const h16*)(p.ws + OFF_V);
  const h16* HL = (const h16*)(p.ws + OFF_LB);
  const h16* CA = (const h16*)(p.ws + OFF_LLA);
  const float* BON = (const float*)(p.ws + OFF_BON);
  h16* Y = (h16*)(p.ws + OFF_HH);
  h16* SG = (h16*)smem;
#ifndef NO_POST
  for (int job = get_bid(); job < 1024; job += VGRID) {
    const int tg0 = job * 32, t0 = tg0 & (SEQ - 1);
#pragma unroll
    for (int i = 0; i < 2; i++) {
      const int e = tid + i * 256, tok = e >> 4, ch = e & 15;
      float o[8];
      psmix8(P, mu, (size_t)tg0 + tok, t0 + tok, 1664 + ch * 8, o);
      h16x8 hv;
#pragma unroll
      for (int j = 0; j < 8; j++) hv[j] = (h16)sigm(o[j]);
      *(h16x8*)(SG + tok * TLD + ch * 8) = hv;
    }
    LDS_BARRIER();
    {
      const int c8 = lane * 8, tq = wave;
      float hin[8];
#pragma unroll
      for (int e = 0; e < 8; e++) hin[e] = 0.f;
      const int bq = tg0 >> 13, seg = t0 >> 8;
      const float* SA = (const float*)(p.ws + OFF_SUMA) + (size_t)bq * 32 * 512 + c8;
      const float* SH = (const float*)(p.ws + OFF_SUMH) + (size_t)bq * 32 * 512 + c8;
      for (int sq = 0; sq < seg; sq++) {
        const f32x4 a0 = *(const f32x4*)(SA + sq * 512), a1 = *(const f32x4*)(SA + sq * 512 + 4);
        const f32x4 h0 = *(const f32x4*)(SH + sq * 512), h1 = *(const f32x4*)(SH + sq * 512 + 4);
#pragma unroll
        for (int e = 0; e < 4; e++) { hin[e] = fmaf(a0[e], hin[e], h0[e]); hin[4 + e] = fmaf(a1[e], hin[4 + e], h1[e]); }
      }
#pragma unroll 2
      for (int tk = 0; tk < 8; tk++) {
        const size_t tg = (size_t)tg0 + tq * 8 + tk;
        const h16x8 hl = *(const h16x8*)(HL + tg * 512 + c8);
        const h16x8 ca = *(const h16x8*)(CA + tg * 512 + c8);
        const h16x8 ly = *(const h16x8*)(P + tg * OIN + 2304 + c8);
        h16x8 o;
#pragma unroll
        for (int e = 0; e < 8; e++) o[e] = (h16)(((float)hl[e] + (float)ca[e] * hin[e]) * gelu_tanh((float)ly[e]));
        *(h16x8*)(Y + tg * DM + 512 + c8) = o;
      }
    }
#pragma unroll 1
    for (int hh = 0; hh < 2; hh++) {
      const int head = wave * 2 + hh;
      f32x16 accg[2];
#pragma unroll
      for (int n = 0; n < 2; n++)
#pragma unroll
        for (int r = 0; r < 16; r++) accg[n][r] = 0.f;
#pragma unroll
      for (int ks = 0; ks < 8; ks++) {
        h16x8 a = *(const h16x8*)(SG + l31 * TLD + ks * 16 + lh * 8);
#pragma unroll
        for (int q = 0; q < 2; q++) {
          const int n = wave * 128 + (hh * 2 + q) * 32 + l31;
          h16x8 bg = *(const h16x8*)(G2T + n * 128 + ks * 16 + lh * 8);
          accg[q] = __builtin_amdgcn_mfma_f32_32x32x16_f16(a, bg, accg[q], 0, 0, 0);
        }
      }
      float lnw[2], lnb[2], muv[2];
#pragma unroll
      for (int q = 0; q < 2; q++) {
        const int c = wave * 128 + (hh * 2 + q) * 32 + l31;
        lnw[q] = p.in[25][c]; lnb[q] = p.in[26][c]; muv[q] = mu[1024 + c];
      }
      int tgb = tg0;
#pragma unroll
      for (int r = 0; r < 16; r++) {
        if ((r & 3) == 0) asm volatile("" : "+s"(tgb));
        const int tr = (r & 3) + 8 * (r >> 2) + 4 * lh;
        const size_t tg = (size_t)tgb + tr;
        const int t = (tgb & (SEQ - 1)) + tr;
        float y[2];
#pragma unroll
        for (int q = 0; q < 2; q++) y[q] = (float)YS[tg * 512 + wave * 128 + (hh * 2 + q) * 32 + l31];
        const float mean = half_sum(y[0] + y[1], lane) * (1.f / 64.f);
        const float d0 = y[0] - mean, d1 = y[1] - mean;
        const float var = half_sum(d0 * d0 + d1 * d1, lane) * (1.f / 64.f);
        const float rs = rsqrtf(var + 64e-5f);
        const float bon = BON[tg * 8 + head];
#pragma unroll
        for (int q = 0; q < 2; q++) {
          const int nt = hh * 2 + q;
          const int c = wave * 128 + nt * 32 + l31;
          const float yn = (q == 0 ? d0 : d1) * rs * lnw[q] + lnb[q];
          const float v = psmixm(P, muv[q], tg, t, 1024 + c);
          Y[tg * DM + c] = (h16)((yn + bon * v) * accg[q][r]);
        }
        if ((r & 3) == 3) asm volatile("" ::: "memory");
      }
    }
    LDS_BARRIER();
  }
#endif
}

__device__ void run_phase(const Params& pin, int ph, char* gsm, int dry) {
  char* smem = gsm + (size_t)__builtin_amdgcn_readfirstlane(threadIdx.x >> 8) * 65536;
  Params p = pin;
  asm volatile("" : "+s"(p.ws));
  char* ws = p.ws;
  h16* wb = (h16*)(ws + OFF_WB);
  h16* HH = (h16*)(ws + OFF_HH);
  h16* BIG = (h16*)(ws + OFF_BIG);
  h16* DMb = (h16*)(ws + OFF_DM);
  const float* nw = p.in[1];
  if (ph == 0) {
    convert_weights(p, 0, (float*)smem);
    row_phase(p.in[0], nullptr, nullptr, 0.f, nw, nullptr, HH);
    return;
  }
  const int L = (ph - 1) / 12, s = (ph - 1) % 12;
  const float* nwl = nw + (size_t)L * 6 * DM;
  if (s == 0 || s == 1 || s == 3 || s == 7 || s == 9 || s == 10) {
    const h16* Ap; const h16* Bp; int K, nN, ldc, epi; void* Cp;
    if (s == 0 || s == 9) { Ap = HH; Bp = wb + (s == 0 ? WGU0 : WGU1); K = DM; nN = 22; Cp = BIG; ldc = DFF; epi = 2; }
    else if (s == 1 || s == 10) { Ap = BIG; Bp = wb + (s == 1 ? WD0 : WD1); K = DFF; nN = 4; Cp = DMb; ldc = DM; epi = 1; }
    else if (s == 3) { Ap = HH; Bp = wb + WIN; K = DM; nN = (L == 0) ? 15 : 11; Cp = BIG; ldc = (L == 0) ? EINP : OIN; epi = 1; }
    else { Ap = HH; Bp = wb + WOUT; K = DM; nN = 4; Cp = DMb; ldc = DM; epi = 1; }
    if (epi == 0) gemm_phase<0>(Ap, Bp, K, 128, nN, Cp, ldc, ldc, gsm);
    else if (epi == 1) gemm_phase<1>(Ap, Bp, K, 128, nN, Cp, ldc, ldc, gsm);
    else gemm_phase<2>(Ap, Bp, K, 128, nN, Cp, ldc, ldc, gsm);
    return;
  }
  switch (s) {
    case 2:
      row_phase(L == 0 ? p.in[0] : p.out, DMb, nwl + 1 * DM, 0.5f, nwl + 2 * DM, p.out, HH, dry);
      break;
    case 4:
      if (L == 0) even_pre(p, smem); else odd_pre(p, smem);
      break;
    case 5: {
      const int vb = __builtin_amdgcn_readfirstlane(threadIdx.x >> 8);
      for (int blk = real_bid(); blk < 256; blk += (int)gridDim.x) {
        if (L == 0) {
          if (vb == 0) scan_task<1>(p, blk, smem, dry); else scan_task<0>(p, blk, smem, dry);
        } else {
          rwkv_scan_pc(p, blk, gsm, dry);
        }
      }
      break;
    }
    case 6:
      if (L == 0) even_post(p); else odd_post(p, smem);
      break;
    case 8:
      row_phase(p.out, DMb, nwl + 3 * DM, 1.0f, nwl + 4 * DM, p.out, HH, dry);
      break;
    case 11:
      if (L == 0) {
        convert_weights(p, 1, (float*)smem);
        convert_small(p);
        row_phase(p.out, DMb, nwl + 5 * DM, 0.5f, nw + 6 * DM, p.out, HH, dry);
      } else {
        row_phase(p.out, DMb, nwl + 5 * DM, 0.5f, nullptr, p.out, nullptr, dry);
      }
      break;
  }
}

#define OFF_BAR (484 * MIB)
#define XB_TMO      128
#define XB_XCNT(j)  (256  + 64 * (j))
#define XB_XSUB(j)  (1280 + 64 * (j))
#define XB_XGEN(j)  (2304 + 64 * (j))
#define XB_TOP      3328
#define XB_TOPGEN   3392
#define XCD_BAR_WORDS 3456
#define XB_SPIN_CAP (1u << 18)
#define LAS __attribute__((address_space(3)))
__device__ __forceinline__ unsigned xb_ld(unsigned* p) { return __hip_atomic_load(p, __ATOMIC_RELAXED, __HIP_MEMORY_SCOPE_AGENT); }
__device__ __forceinline__ unsigned xb_add(unsigned* p, unsigned v) { return __hip_atomic_fetch_add(p, v, __ATOMIC_RELAXED, __HIP_MEMORY_SCOPE_AGENT); }
__device__ __forceinline__ unsigned xb_xcc_id() { return (unsigned)__builtin_amdgcn_s_getreg((3 << 11) | 20) & 0xFu; }
#define XB_SPIN(cond, bar) do { unsigned _sp = 0; while (cond) { __builtin_amdgcn_s_sleep(1); \
    if ((++_sp & 255u) == 0u) { if (xb_ld(&(bar)[XB_TMO])) break; if (_sp > XB_SPIN_CAP) { atomicAdd(&(bar)[XB_TMO], 1u); break; } } } } while (0)
struct XcdBarrier { unsigned* bar; unsigned x; volatile LAS unsigned* st; };
__device__ __forceinline__ XcdBarrier xcd_barrier_post(unsigned* bar, volatile LAS unsigned* st) {
  XcdBarrier b; b.bar = bar; b.x = xb_xcc_id(); b.st = st;
  if (threadIdx.x == 0) (void)xb_add(&bar[XB_XCNT(b.x)], 1u);
  return b;
}
__device__ __forceinline__ void xcd_barrier_complete(unsigned* bar, unsigned x, unsigned& nloc, unsigned& nx) {
  const unsigned G = gridDim.x * gridDim.y * gridDim.z;
  unsigned sum, cnt, mine, sp = 0u;
  for (;;) {
    sum = 0u; cnt = 0u; mine = 0u;
#pragma unroll
    for (unsigned j = 0; j < 16; ++j) { const unsigned c = xb_ld(&bar[XB_XCNT(j)]); sum += c; cnt += (c > 0u) ? 1u : 0u; mine = (j == x) ? c : mine; }
    if (sum == G) break;
    __builtin_amdgcn_s_sleep(1);
    if ((++sp & 255u) == 0u) { if (xb_ld(&bar[XB_TMO])) break; if (sp > XB_SPIN_CAP) { atomicAdd(&bar[XB_TMO], 1u); break; } }
  }
  nloc = mine > 0u ? mine : 1u; nx = cnt > 0u ? cnt : 1u;
}
__device__ __forceinline__ void xcd_barrier(const XcdBarrier& b) {
  asm volatile("s_waitcnt vmcnt(0)" ::: "memory");
  __syncthreads();
  if (threadIdx.x == 0) {
    unsigned* bar = b.bar;
    __builtin_amdgcn_s_waitcnt(0);
    unsigned nloc = b.st[0], nx = b.st[1];
    if (nloc == 0u) { xcd_barrier_complete(bar, b.x, nloc, nx); b.st[0] = nloc; b.st[1] = nx; }
    const unsigned old = xb_add(&bar[XB_XSUB(b.x)], 1u);
    const unsigned gen = old / nloc;
    if (old + 1u == (gen + 1u) * nloc) {
      __builtin_amdgcn_fence(__ATOMIC_RELEASE, "agent");
      asm volatile("s_waitcnt vmcnt(0)" ::: "memory");
      const unsigned og = xb_add(&bar[XB_TOP], 1u);
      const unsigned tg = og / nx;
      if (og + 1u == (tg + 1u) * nx) xb_add(&bar[XB_TOPGEN], 1u);
      else XB_SPIN(xb_ld(&bar[XB_TOPGEN]) == tg, bar);
      __builtin_amdgcn_fence(__ATOMIC_ACQUIRE, "agent");
      xb_add(&bar[XB_XGEN(b.x)], 1u);
      asm volatile("s_waitcnt vmcnt(0)" ::: "memory");
    } else {
      XB_SPIN(xb_ld(&bar[XB_XGEN(b.x)]) == gen, bar);
      __builtin_amdgcn_fence(__ATOMIC_ACQUIRE, "agent");
      asm volatile("s_waitcnt vmcnt(0)" ::: "memory");
    }
  }
  __syncthreads();
}

__global__ void __launch_bounds__(512, 2) mega_kernel(Params p, int ph0, int ph1, int dup_mask) {
  extern __shared__ __attribute__((aligned(16))) char smem[];
  __shared__ uint4 xb_words;
  cg::grid_group grid = cg::this_grid();
  if (threadIdx.x == 0) xb_words = make_uint4(0u, 0u, 0u, 0u);
  __syncthreads();
  XcdBarrier xb = xcd_barrier_post((unsigned*)(p.ws + OFF_BAR), (volatile LAS unsigned*)&xb_words);
  int rep = 0;
  for (int ph = ph0; ph < ph1;) {
    run_phase(p, ph, smem, rep);
    const int bit = (ph == 0) ? 12 : (ph - 1) % 12;
    if (((dup_mask >> bit) & 1) && rep == 0) { rep = 1; } else { rep = 0; ph++; }
    if (ph < ph1) { if (ph1 < 0) grid.sync(); else xcd_barrier(xb); }
  }
}

extern "C" void kernel_launch(void* const* d_in, const int* in_sizes, int n_in, void* d_out, int out_size, void* d_ws,
                              size_t ws_size, hipStream_t stream) {
  static int grid_blocks = 0;
  if (!grid_blocks) {
    int dev = 0, cus = 0, per_cu = 0;
    hipGetDevice(&dev);
    hipDeviceGetAttribute(&cus, hipDeviceAttributeMultiprocessorCount, dev);
    hipFuncSetAttribute((const void*)mega_kernel, hipFuncAttributeMaxDynamicSharedMemorySize, 131072);
    hipOccupancyMaxActiveBlocksPerMultiprocessor(&per_cu, mega_kernel, 512, 131072);
    if (per_cu > 1) per_cu = 1;
    if (per_cu < 1) per_cu = 1;
    grid_blocks = cus * per_cu;
  }
  Params p{};
  for (int i = 0; i < 34; i++) p.in[i] = (const float*)d_in[i];
  p.out = (float*)d_out;
  p.ws = (char*)d_ws;
  int ph0 = 0, ph1 = NPHASE, dup = DUPMASK;
  void* args[] = {&p, &ph0, &ph1, &dup};
  hipMemsetAsync((char*)d_ws + OFF_BAR, 0, XCD_BAR_WORDS * sizeof(unsigned), stream);
  hipError_t e = hipLaunchCooperativeKernel((void*)mega_kernel, dim3(grid_blocks), dim3(512), args, 131072, stream);
  if (e != hipSuccess) fprintf(stderr, "cooperative launch failed: %s (grid %d)\n", hipGetErrorString(e), grid_blocks);
}
```

```cpp
#include <hip/hip_runtime.h>
#include <hip/hip_fp16.h>
#include <hip/hip_cooperative_groups.h>
#include <cstdio>
namespace cg = cooperative_groups;

typedef _Float16 h16;
typedef h16 h16x8 __attribute__((ext_vector_type(8)));
typedef h16 h16x4 __attribute__((ext_vector_type(4)));
typedef float f32x16 __attribute__((ext_vector_type(16)));
typedef unsigned int u32x4 __attribute__((ext_vector_type(4)));
typedef float f32x4 __attribute__((ext_vector_type(4)));

#define MTOK 32768
#define SEQ 8192
#define DM 1024
#define DFF 2816
#define EIN 3608
#define EINP 3712
#define OIN 2816

#define MIB ((size_t)1 << 20)
#define OFF_WB   ((size_t)0)
#define OFF_HH   (48 * MIB)
#define OFF_BIG  (112 * MIB)
#define OFF_DM   (344 * MIB)
#define OFF_ELA  (OFF_DM)
#define OFF_GQ   (OFF_DM + 16 * MIB)
#define OFF_GK   (OFF_DM + 48 * MIB)
#define OFF_GV   (OFF_DM + 80 * MIB)
#define OFF_AB   (OFF_DM + 112 * MIB)
#define OFF_KK   (OFF_HH)
#define OFF_KKA  (OFF_HH + 32 * MIB)
#define OFF_W16  (288 * MIB)
#define OFF_KP   (320 * MIB)
#define OFF_R    (352 * MIB)
#define OFF_V    (384 * MIB)
#define OFF_LLA  (416 * MIB)
#define OFF_LB   (448 * MIB)
#define OFF_BON  (480 * MIB)
#define WGU0 0
#define WD0  5767168
#define WGU1 8650752
#define WD1  14417920
#define WIN  17301504
#define WOUT 21233664

#define SMEM_BYTES 45056
#define NPHASE 25
#define DUPMASK 0x0

struct Params {
  const float* in[34];
  float* out;
  char* ws;
};

__device__ __forceinline__ int get_tid() { int t = threadIdx.x & 255; asm volatile("" : "+v"(t)); return t; }
__device__ __forceinline__ int get_bid() { int t = blockIdx.x * 2 + __builtin_amdgcn_readfirstlane(threadIdx.x >> 8); asm volatile("" : "+s"(t)); return t; }
__device__ __forceinline__ int real_tid() { int t = threadIdx.x; asm volatile("" : "+v"(t)); return t; }
__device__ __forceinline__ int real_bid() { int t = blockIdx.x; asm volatile("" : "+s"(t)); return t; }
#define VGRID ((int)gridDim.x * 2)
__device__ __forceinline__ float sigm(float x) { return __builtin_amdgcn_rcpf(1.f + __expf(-x)); }
__device__ __forceinline__ float softplus_(float x) { return fmaxf(x, 0.f) + __logf(1.f + __expf(-fabsf(x))); }
__device__ __forceinline__ float silu_(float x) { return x * __builtin_amdgcn_rcpf(1.f + __expf(-x)); }
__device__ __forceinline__ float fast_tanh(float u) { return 1.f - 2.f * __builtin_amdgcn_rcpf(1.f + __expf(2.f * u)); }
__device__ __forceinline__ float gelu_tanh(float x) {
  float u = 0.7978845608028654f * (x + 0.044715f * x * x * x);
  return 0.5f * x * (1.f + fast_tanh(u));
}

template <int CTRL>
__device__ __forceinline__ float dpp_f(float x) {
  return __int_as_float(__builtin_amdgcn_update_dpp(0, __float_as_int(x), CTRL, 0xF, 0xF, true));
}
__device__ __forceinline__ float reduce16(float x) {
  x += dpp_f<0xB1>(x);
  x += dpp_f<0x4E>(x);
  x += dpp_f<0x141>(x);
  x += dpp_f<0x140>(x);
  return x;
}

__device__ __forceinline__ float wave_sum(float v) {
  v = reduce16(v);
  const int vi = __float_as_int(v);
  float t = __int_as_float(__builtin_amdgcn_readlane(vi, 0));
  t += __int_as_float(__builtin_amdgcn_readlane(vi, 16));
  t += __int_as_float(__builtin_amdgcn_readlane(vi, 32));
  t += __int_as_float(__builtin_amdgcn_readlane(vi, 48));
  return t;
}

#define LDS_BARRIER() do { asm volatile("s_waitcnt lgkmcnt(0)" ::: "memory"); __builtin_amdgcn_s_barrier(); asm volatile("" ::: "memory"); } while (0)

__device__ void conv_tile(const float* __restrict__ src, int K, int N, h16* __restrict__ dst, int mode, int kt, int nt,
                          float* sm) {
  const int tid = get_tid();
#pragma unroll
  for (int i = 0; i < 4; i++) {
    const int idx = tid + i * 256, r = idx >> 4, c4 = (idx & 15) * 4;
    const int n = nt * 64 + c4;
    f32x4 v = {0.f, 0.f, 0.f, 0.f};
    if (n < N) v = *(const f32x4*)(src + (size_t)(kt * 64 + r) * N + n);
#pragma unroll
    for (int e = 0; e < 4; e++) sm[r * 65 + c4 + e] = v[e];
  }
  LDS_BARRIER();
#pragma unroll
  for (int i = 0; i < 2; i++) {
    const int idx = tid + i * 256, nl = idx >> 3, kc = (idx & 7) * 8;
    const int n = nt * 64 + nl;
    const int row = (mode == 0) ? n : ((n >> 4) * 32 + (mode - 1) * 16 + (n & 15));
    h16x8 o;
#pragma unroll
    for (int j = 0; j < 8; j++) o[j] = (h16)sm[(kc + j) * 65 + nl];
    *(h16x8*)(dst + (size_t)row * K + kt * 64 + kc) = o;
  }
  LDS_BARRIER();
}

__device__ void convert_weights(const Params& p, int L, float* sm) {
  h16* wb = (h16*)(p.ws + OFF_WB);
  const int T_G = 16 * 44, T_D = 44 * 16;
  const int T_F = 2 * T_G + T_D;
  const int nin = (L == 0) ? 60 : 44;
  const int T_IN = 16 * nin, T_OUT = 256;
  const int total = 2 * T_F + T_IN + T_OUT;
  for (int j = get_bid(); j < total; j += VGRID) {
    int q = j;
    const float* src; int K, N, mode, ntn; h16* dst;
    if (q < 2 * T_F) {
      int f = q / T_F; q -= f * T_F;
      int lf = L * 2 + f;
      if (q < T_G) { src = p.in[2] + (size_t)lf * DM * DFF; K = DM; N = DFF; dst = wb + (f ? WGU1 : WGU0); mode = 1; ntn = 44; }
      else if (q < 2 * T_G) { q -= T_G; src = p.in[3] + (size_t)lf * DM * DFF; K = DM; N = DFF; dst = wb + (f ? WGU1 : WGU0); mode = 2; ntn = 44; }
      else { q -= 2 * T_G; src = p.in[4] + (size_t)lf * DFF * DM; K = DFF; N = DM; dst = wb + (f ? WD1 : WD0); mode = 0; ntn = 16; }
    } else {
      q -= 2 * T_F;
      if (q < T_IN) { src = (L == 0) ? p.in[5] : p.in[14]; K = DM; N = (L == 0) ? EIN : OIN; dst = wb + WIN; mode = 0; ntn = nin; }
      else { q -= T_IN; src = (L == 0) ? p.in[6] : p.in[15]; K = DM; N = DM; dst = wb + WOUT; mode = 0; ntn = 16; }
    }
    int kt = q / ntn, nt = q % ntn;
    conv_tile(src, K, N, dst, mode, kt, nt, sm);
  }
}

__device__ void row_phase(const float* __restrict__ xin, const h16* __restrict__ Dmat, const float* __restrict__ wpost,
                          float res, const float* __restrict__ wpre, float* __restrict__ xout, h16* __restrict__ hh, int dry = 0) {
  const int lane = get_tid() & 63;
  const int gw = get_bid() * 4 + (get_tid() >> 6);
  const int nw = VGRID * 4;
  float4 nx[4];
  h16x4 nd[4];
  if (gw < MTOK) {
#pragma unroll
    for (int i = 0; i < 4; i++) {
      { f32x4 t_ = __builtin_nontemporal_load((const f32x4*)(xin + (size_t)gw * DM + i * 256 + lane * 4)); nx[i] = make_float4(t_[0], t_[1], t_[2], t_[3]); }
      if (Dmat) nd[i] = *(const h16x4*)(Dmat + (size_t)gw * DM + i * 256 + lane * 4);
    }
  }
  for (int row = gw; row < MTOK; row += nw) {
    float4 xv[4];
    h16x4 dh[4];
#pragma unroll
    for (int i = 0; i < 4; i++) { xv[i] = nx[i]; dh[i] = nd[i]; }
    const int nrow = row + nw;
    if (nrow < MTOK) {
#pragma unroll
      for (int i = 0; i < 4; i++) {
        { f32x4 t_ = __builtin_nontemporal_load((const f32x4*)(xin + (size_t)nrow * DM + i * 256 + lane * 4)); nx[i] = make_float4(t_[0], t_[1], t_[2], t_[3]); }
        if (Dmat) nd[i] = *(const h16x4*)(Dmat + (size_t)nrow * DM + i * 256 + lane * 4);
      }
    }
    if (Dmat) {
      float4 dv[4];
      float ss = 0.f;
#pragma unroll
      for (int i = 0; i < 4; i++) {
        dv[i].x = (float)dh[i][0]; dv[i].y = (float)dh[i][1]; dv[i].z = (float)dh[i][2]; dv[i].w = (float)dh[i][3];
        ss += dv[i].x * dv[i].x + dv[i].y * dv[i].y + dv[i].z * dv[i].z + dv[i].w * dv[i].w;
      }
      ss = wave_sum(ss);
      float inv = rsqrtf(ss * (1.f / DM) + 1e-6f) * res;
#pragma unroll
      for (int i = 0; i < 4; i++) {
        float4 w = *(const float4*)(wpost + i * 256 + lane * 4);
        xv[i].x += dv[i].x * inv * w.x; xv[i].y += dv[i].y * inv * w.y;
        xv[i].z += dv[i].z * inv * w.z; xv[i].w += dv[i].w * inv * w.w;
        if (!dry) { f32x4 t_ = {xv[i].x, xv[i].y, xv[i].z, xv[i].w}; __builtin_nontemporal_store(t_, (f32x4*)(xout + (size_t)row * DM + i * 256 + lane * 4)); }
      }
    }
    if (hh) {
      float ss = 0.f;
#pragma unroll
      for (int i = 0; i < 4; i++) ss += xv[i].x * xv[i].x + xv[i].y * xv[i].y + xv[i].z * xv[i].z + xv[i].w * xv[i].w;
      ss = wave_sum(ss);
      float inv = rsqrtf(ss * (1.f / DM) + 1e-6f);
#pragma unroll
      for (int i = 0; i < 4; i++) {
        float4 w = *(const float4*)(wpre + i * 256 + lane * 4);
        h16x4 o;
        o[0] = (h16)(xv[i].x * inv * w.x); o[1] = (h16)(xv[i].y * inv * w.y);
        o[2] = (h16)(xv[i].z * inv * w.z); o[3] = (h16)(xv[i].w * inv * w.w);
        if (!dry) *(h16x4*)(hh + (size_t)row * DM + i * 256 + lane * 4) = o;
      }
    }
  }
}

typedef float f32x4v __attribute__((ext_vector_type(4)));
#define G_BM 256
#define G_BK 64
#define G_HALF 128
#define G_HT (G_HALF * G_BK)
__device__ __forceinline__ int lds_byte(int r, int c) {
  int st = (r >> 4) * 2 + (c >> 5), rr = r & 15, cc = c & 31, ob = rr * 64 + cc * 2;
  return st * 1024 + (ob ^ (((ob >> 9) & 1) << 5));
}
__device__ __forceinline__ void stage_rc(int b, int& R, int& C) {
  int st = b / 1024, sb = b % 1024, swz = sb ^ (((sb >> 9) & 1) << 5);
  R = (st >> 1) * 16 + swz / 64; C = (st & 1) * 32 + (swz % 64) / 2;
}
template <int EPI>
__device__ void gemm_phase(const h16* __restrict__ A, const h16* __restrict__ Bt, int K, int nM, int nN,
                           void* __restrict__ Cout, int ldc, int ncv, char* smem) {
  h16* shm = (h16*)smem;
#define SA(b, h) (shm + ((b) * 2 + (h)) * G_HT)
#define SB(b, h) (shm + (4 + (b) * 2 + (h)) * G_HT)
#define STAGE(P, BASE, br, kt) do { const char* _gb = (const char*)(BASE) + ((long)(br) * K + (long)(kt) * G_BK) * 2; \
    __builtin_amdgcn_global_load_lds((const unsigned*)(_gb + voff), (unsigned*)((char*)(P) + tid * 16), 16, 0, 0); \
    __builtin_amdgcn_global_load_lds((const unsigned*)(_gb + (long)K * 128 + voff), (unsigned*)((char*)(P) + tid * 16 + 8192), 16, 0, 0); } while (0)
#define LDA(dst, b, h) for (int m = 0; m < 4; ++m) for (int k = 0; k < 2; ++k) \
    dst[m][k] = *reinterpret_cast<const h16x8*>((char*)SA(b, h) + lds_byte(wr * 64 + m * 16 + fr, k * 32 + fq * 8))
#define LDB(dst, b, h) for (int n = 0; n < 2; ++n) for (int k = 0; k < 2; ++k) \
    dst[n][k] = *reinterpret_cast<const h16x8*>((char*)SB(b, h) + lds_byte(wc * 32 + n * 16 + fr, k * 32 + fq * 8))
#define MMA(ai, bj, At_, Bt_) do { __builtin_amdgcn_s_setprio(1); \
    for (int m = 0; m < 4; ++m) for (int n = 0; n < 2; ++n) for (int k = 0; k < 2; ++k) \
      acc[ai][bj][m][n] = __builtin_amdgcn_mfma_f32_16x16x32_f16(Bt_[n][k], At_[m][k], acc[ai][bj][m][n], 0, 0, 0); \
    __builtin_amdgcn_s_setprio(0); } while (0)
#define WAIT_V(n) asm volatile("s_waitcnt vmcnt(" #n ")" ::: "memory")
#define WAIT_L(n) asm volatile("s_waitcnt lgkmcnt(" #n ")" ::: "memory")
#define BAR __builtin_amdgcn_s_barrier()
#define SCHED __builtin_amdgcn_sched_barrier(0)
  const int tid = real_tid();
  const int G = gridDim.x;
  const int nwg = nM * nN;
  const int wid = tid >> 6, lane = tid & 63, wr = wid >> 2, wc = wid & 3, fr = lane & 15, fq = lane >> 4;
  const int nt = K / G_BK;
  unsigned voff;
  { int R0, C0; stage_rc(tid * 16, R0, C0); voff = (unsigned)((R0 * K + C0) * 2); }
  for (int L = real_bid(); L < nwg; L += G) {
    int wgid = L;
    { int q = nwg / 8, r = nwg % 8, xcd = wgid % 8, off = wgid / 8;
      wgid = (xcd < r ? xcd * (q + 1) : r * (q + 1) + (xcd - r) * q) + off; }
    const int nig = 4 * nN, gid = wgid / nig, fm = gid * 4, gsz = min(nM - fm, 4);
    const int pm = fm + ((wgid % nig) % gsz), pn = (wgid % nig) / gsz, brow = pm * G_BM, bcol = pn * G_BM;
    f32x4v acc[2][2][4][2];
#pragma unroll
    for (int a_ = 0; a_ < 2; a_++)
#pragma unroll
      for (int b_ = 0; b_ < 2; b_++)
#pragma unroll
        for (int m = 0; m < 4; m++)
#pragma unroll
          for (int n = 0; n < 2; n++) acc[a_][b_][m][n] = f32x4v{0.f, 0.f, 0.f, 0.f};
    h16x8 At[4][2], B0[2][2], B1[2][2];
    WAIT_V(0);
    __syncthreads();
    STAGE(SB(0, 0), Bt, bcol, 0); STAGE(SA(0, 0), A, brow, 0);
    STAGE(SB(0, 1), Bt, bcol + G_HALF, 0); STAGE(SA(0, 1), A, brow + G_HALF, 0);
    if (wr == 1) BAR;
    WAIT_V(4); BAR;
    STAGE(SB(1, 0), Bt, bcol, 1); STAGE(SA(1, 0), A, brow, 1); STAGE(SB(1, 1), Bt, bcol + G_HALF, 1);
    WAIT_V(6); BAR;
    for (int t = 0; t < nt - 2; t += 2) {
      LDB(B0, 0, 0); SCHED; LDA(At, 0, 0); STAGE(SA(1, 1), A, brow + G_HALF, t + 1);
      WAIT_L(8); BAR; WAIT_L(0); MMA(0, 0, At, B0); BAR; SCHED;
      LDB(B1, 0, 1); STAGE(SB(0, 0), Bt, bcol, t + 2);
      BAR; WAIT_L(0); MMA(0, 1, At, B1); BAR;
      LDA(At, 0, 1); STAGE(SA(0, 0), A, brow, t + 2);
      BAR; WAIT_L(0); MMA(1, 0, At, B0); BAR; SCHED;
      STAGE(SB(0, 1), Bt, bcol + G_HALF, t + 2);
      WAIT_V(6); BAR; MMA(1, 1, At, B1); BAR;
      LDB(B0, 1, 0); SCHED; LDA(At, 1, 0); STAGE(SA(0, 1), A, brow + G_HALF, t + 2);
      WAIT_L(8); BAR; WAIT_L(0); MMA(0, 0, At, B0); BAR; SCHED;
      LDB(B1, 1, 1); STAGE(SB(1, 0), Bt, bcol, t + 3);
      BAR; WAIT_L(0); MMA(0, 1, At, B1); BAR;
      LDA(At, 1, 1); STAGE(SA(1, 0), A, brow, t + 3);
      BAR; WAIT_L(0); MMA(1, 0, At, B0); BAR; SCHED;
      STAGE(SB(1, 1), Bt, bcol + G_HALF, t + 3);
      WAIT_V(6); BAR; MMA(1, 1, At, B1); BAR;
    }
    { LDB(B0, 0, 0); LDA(At, 0, 0); STAGE(SA(1, 1), A, brow + G_HALF, nt - 1);
      BAR; WAIT_L(0); MMA(0, 0, At, B0); BAR;
      LDB(B1, 0, 1); BAR; WAIT_L(0); MMA(0, 1, At, B1); BAR;
      LDA(At, 0, 1); WAIT_V(4); BAR; WAIT_L(0); MMA(1, 0, At, B0); MMA(1, 1, At, B1); BAR; }
    { LDB(B0, 1, 0); LDA(At, 1, 0); WAIT_V(2); BAR; WAIT_L(0); MMA(0, 0, At, B0); BAR;
      LDB(B1, 1, 1); WAIT_V(0); BAR; WAIT_L(0); MMA(0, 1, At, B1); BAR;
      LDA(At, 1, 1); BAR; WAIT_L(0); MMA(1, 0, At, B0); MMA(1, 1, At, B1); BAR; }
    if (wr == 0) BAR;
#pragma unroll
    for (int ai = 0; ai < 2; ++ai)
#pragma unroll
      for (int bj = 0; bj < 2; ++bj)
#pragma unroll
        for (int m = 0; m < 4; ++m) {
          const long row = brow + ai * G_HALF + wr * 64 + m * 16 + fr;
          if (EPI == 2) {
            const f32x4v g = acc[ai][bj][m][0], u = acc[ai][bj][m][1];
            const int col = (bcol >> 1) + bj * 64 + wc * 16 + fq * 4;
            h16x4 o;
#pragma unroll
            for (int j = 0; j < 4; ++j) o[j] = (h16)(silu_(g[j]) * u[j]);
            *(h16x4*)((h16*)Cout + row * ldc + col) = o;
          } else {
#pragma unroll
            for (int n = 0; n < 2; ++n) {
              const int col = bcol + bj * G_HALF + wc * 32 + n * 16 + fq * 4;
              if (EPI == 0) {
                *(f32x4v*)((float*)Cout + row * ldc + col) = acc[ai][bj][m][n];
              } else if (col < ncv) {
                h16x4 o;
#pragma unroll
                for (int j = 0; j < 4; ++j) o[j] = (h16)acc[ai][bj][m][n][j];
                *(h16x4*)((h16*)Cout + row * ldc + col) = o;
              }
            }
          }
        }
  }
#undef SA
#undef SB
}

#define TT 32
template <int MODE> struct ScanCfg;
template <> struct ScanCfg<0> { static constexpr int NF = 200, E = 2, NA = 3, VOFF = 192; };
template <> struct ScanCfg<1> { static constexpr int NF = 268, E = 4, NA = 4, VOFF = 256; };
template <> struct ScanCfg<2> { static constexpr int NF = 328, E = 2, NA = 5, VOFF = 320; };
typedef float f32x2 __attribute__((ext_vector_type(2)));

__device__ __forceinline__ float reduce32(float x) {
  x = reduce16(x);
  const unsigned xi = __float_as_uint(x);
  auto r = __builtin_amdgcn_permlane32_swap(xi, xi, false, false);
  return __uint_as_float(r[0]) + __uint_as_float(r[1]);
}

template <int MODE>
__device__ void scan_task(const Params& p, int task, char* smem, int dry) {
  constexpr int NF = ScanCfg<MODE>::NF, E = ScanCfg<MODE>::E, NA = ScanCfg<MODE>::NA, VOFF = ScanCfg<MODE>::VOFF;
  float* rec = (float*)smem;
  const int tid = get_tid(), lane = tid & 63, wave = tid >> 6;
  const int sub = (lane & 15) + ((lane >> 5) << 4), row = wave * 2 + ((lane >> 4) & 1);
  int b, h, rowbase;
  if (MODE == 2) { int bh = task >> 3; b = bh >> 3; h = bh & 7; rowbase = (task & 7) * 8; }
  else { int bh = task >> 4; b = bh >> 2; h = bh & 3; rowbase = (task & 15) * 8; }
  char* ws = p.ws;
  const size_t bS = (size_t)b * SEQ;

  const h16* src[NA];
  int dsto[NA];
  int ldm;
  const h16* srcv;
  int ldv;
  const int tokv = tid & 31;
  const int dstv = tokv * NF + VOFF;
  if (MODE == 0) {
    const int tok = tid >> 3, ch = tid & 7;
    const h16* P = (const h16*)(ws + OFF_BIG);
    src[0] = (const h16*)(ws + OFF_ELA) + (bS + tok) * 256 + h * 64 + ch * 8;
    src[1] = P + (bS + tok) * EINP + 256 + h * 64 + ch * 8;
    src[2] = P + (bS + tok) * EINP + h * 64 + ch * 8;
    for (int a = 0; a < NA; a++) dsto[a] = tok * NF + a * 64 + ch * 8;
    ldm = EINP;
    srcv = P + (bS + tokv) * EINP + 512 + h * 128 + rowbase; ldv = EINP;
  } else if (MODE == 1) {
    for (int a = 0; a < NA; a++) {
      const int idx = tid + (a & 1) * 256, tok = idx >> 4, ch = idx & 15;
      src[a] = (const h16*)(ws + (a < 2 ? OFF_GK : OFF_GQ)) + (bS + tok) * 512 + h * 128 + ch * 8;
      dsto[a] = tok * NF + (a < 2 ? 0 : 128) + ch * 8;
    }
    ldm = 512;
    srcv = (const h16*)(ws + OFF_GV) + (bS + tokv) * 512 + h * 128 + rowbase; ldv = 512;
  } else {
    const int tok = tid >> 3, ch = tid & 7;
    for (int a = 0; a < NA; a++) {
      const size_t off = a == 0 ? OFF_W16 : a == 1 ? OFF_KK : a == 2 ? OFF_KKA : a == 3 ? OFF_KP : OFF_R;
      src[a] = (const h16*)(ws + off) + (bS + tok) * 512 + h * 64 + ch * 8;
      dsto[a] = tok * NF + a * 64 + ch * 8;
    }
    ldm = 512;
    srcv = (const h16*)(ws + OFF_V) + (bS + tokv) * 512 + h * 64 + rowbase; ldv = 512;
  }
  const float* srcab = (const float*)(ws + OFF_AB) + ((bS + (tid & 31)) * 4 + h) * 2;

  h16* outp; int ldo;
  if (MODE == 0) { outp = (h16*)(ws + OFF_BIG) + 512 + h * 128 + rowbase; ldo = EINP; }
  else if (MODE == 1) { outp = (h16*)(ws + OFF_GV) + h * 128 + rowbase; ldo = 512; }
  else { outp = (h16*)(ws + OFF_V) + h * 64 + rowbase; ldo = 512; }
  outp += bS * ldo;

  float s[E];
#pragma unroll
  for (int e = 0; e < E; e++) s[e] = 0.f;

  u32x4 pre[NA];
  u32x4 prev = {0u, 0u, 0u, 0u};
  float pab0 = 0.f, pab1 = 0.f;
#pragma unroll
  for (int a = 0; a < NA; a++) pre[a] = *(const u32x4*)(src[a]);
  if (tid < 32) prev = *(const u32x4*)(srcv);
  if (MODE == 1 && tid < 32) { pab0 = srcab[0]; pab1 = srcab[1]; }

  for (int t0 = 0; t0 < SEQ; t0 += TT) {
#pragma unroll
    for (int a = 0; a < NA; a++) {
      h16x8 hv = __builtin_bit_cast(h16x8, pre[a]);
      float f[8];
#pragma unroll
      for (int j = 0; j < 8; j++) {
        float x = (float)hv[j];
        if (MODE == 0 && a == 0) x = __expf(x);
        if (MODE == 0 && a == 2) x *= 0.125f;
        if (MODE == 2 && a == 0) x = __expf(-__expf(x));
        f[j] = x;
      }
      f32x4 lo = {f[0], f[1], f[2], f[3]}, hi = {f[4], f[5], f[6], f[7]};
      *(f32x4*)(rec + dsto[a]) = lo;
      *(f32x4*)(rec + dsto[a] + 4) = hi;
    }
    if (tid < 32) {
      h16x8 hv = __builtin_bit_cast(h16x8, prev);
      f32x4 lo = {(float)hv[0], (float)hv[1], (float)hv[2], (float)hv[3]};
      f32x4 hi = {(float)hv[4], (float)hv[5], (float)hv[6], (float)hv[7]};
      *(f32x4*)(rec + dstv) = lo;
      *(f32x4*)(rec + dstv + 4) = hi;
    }
    if (MODE == 1 && tid < 32) { rec[tid * NF + 264] = pab0; rec[tid * NF + 265] = pab1; }
    LDS_BARRIER();
    if (t0 + TT < SEQ) {
      const size_t tn = (size_t)(t0 + TT);
#pragma unroll
      for (int a = 0; a < NA; a++) {
        const int ld = (MODE == 0 && a == 0) ? 256 : ldm;
        pre[a] = *(const u32x4*)(src[a] + tn * ld);
      }
      if (tid < 32) prev = *(const u32x4*)(srcv + tn * ldv);
      if (MODE == 1 && tid < 32) { pab0 = srcab[tn * 8]; pab1 = srcab[tn * 8 + 1]; }
    }
    float yk = 0.f;
#pragma unroll 1
    for (int hb = 0; hb < TT / 16; hb++) {
      float yp[16];
#pragma unroll
      for (int j = 0; j < 16; j++) {
        const float* rc = rec + (hb * 16 + j) * NF;
        float y;
        if (MODE == 0) {
          f32x2 W = *(const f32x2*)(rc + sub * 2);
          f32x2 Kv = *(const f32x2*)(rc + 64 + sub * 2);
          f32x2 R = *(const f32x2*)(rc + 128 + sub * 2);
          float v = rc[VOFF + row];
          s[0] = fmaf(v, Kv[0], s[0] * W[0]);
          s[1] = fmaf(v, Kv[1], s[1] * W[1]);
          y = s[0] * R[0] + s[1] * R[1];
        } else if (MODE == 1) {
          f32x4 Kv = *(const f32x4*)(rc + sub * 4);
          f32x4 R = *(const f32x4*)(rc + 128 + sub * 4);
          float v = rc[VOFF + row];
          f32x2 ab = *(const f32x2*)(rc + 264);
          const float al = ab[0], be = ab[1];
          float d = (s[0] * Kv[0] + s[1] * Kv[1]) + (s[2] * Kv[2] + s[3] * Kv[3]);
          d = reduce32(d);
          float c = be * (v - al * d);
#pragma unroll
          for (int e = 0; e < 4; e++) s[e] = fmaf(c, Kv[e], al * s[e]);
          y = (s[0] * R[0] + s[1] * R[1]) + (s[2] * R[2] + s[3] * R[3]);
        } else {
          f32x2 W = *(const f32x2*)(rc + sub * 2);
          f32x2 Pv = *(const f32x2*)(rc + 64 + sub * 2);
          f32x2 Av = *(const f32x2*)(rc + 128 + sub * 2);
          f32x2 Kv = *(const f32x2*)(rc + 192 + sub * 2);
          f32x2 R = *(const f32x2*)(rc + 256 + sub * 2);
          float v = rc[VOFF + row];
          float d = s[0] * Pv[0] + s[1] * Pv[1];
          d = reduce32(d);
          s[0] = fmaf(v, Kv[0], fmaf(-d, Av[0], s[0] * W[0]));
          s[1] = fmaf(v, Kv[1], fmaf(-d, Av[1], s[1] * W[1]));
          y = s[0] * R[0] + s[1] * R[1];
        }
        yp[j] = y;
      }
      {
        const bool b3 = (lane & 8) != 0, b2 = (lane & 4) != 0, b1 = (lane & 2) != 0, b0 = (lane & 1) != 0;
        float q8[8], q4[4], q2[2];
#pragma unroll
        for (int i = 0; i < 8; i++) {
          float keep = b3 ? yp[i + 8] : yp[i], send = b3 ? yp[i] : yp[i + 8];
          q8[i] = keep + dpp_f<0x140>(send);
        }
#pragma unroll
        for (int i = 0; i < 4; i++) {
          float keep = b2 ? q8[i + 4] : q8[i], send = b2 ? q8[i] : q8[i + 4];
          q4[i] = keep + dpp_f<0x141>(send);
        }
#pragma unroll
        for (int i = 0; i < 2; i++) {
          float keep = b1 ? q4[i + 2] : q4[i], send = b1 ? q4[i] : q4[i + 2];
          q2[i] = keep + dpp_f<0x4E>(send);
        }
        float keep = b0 ? q2[1] : q2[0], send = b0 ? q2[0] : q2[1];
        float q1 = keep + dpp_f<0xB1>(send);
        const unsigned qi = __float_as_uint(q1);
        auto r = __builtin_amdgcn_permlane32_swap(qi, qi, false, false);
        q1 = __uint_as_float(r[0]) + __uint_as_float(r[1]);
        yk = ((sub >> 4) == hb) ? q1 : yk;
      }
    }
    if (!dry) outp[(size_t)(t0 + sub) * ldo + row] = (h16)yk;
    LDS_BARRIER();
  }
}
#define SCAN_BARRIERS (2 * (SEQ / TT))

#define OFF_SUMA (OFF_BON + 1 * MIB)
#define OFF_SUMH (OFF_BON + 1 * MIB + 256 * 1024)
__device__ void lru_scan_task(const Params& p, int task, int dry) {
  const int tid = get_tid();
  const int half = task & 1, seg = (task >> 1) & 31, b = task >> 6;
  const int c = half * 256 + tid;
  const size_t base = ((size_t)b * SEQ + seg * 256) * 512 + c;
  h16* la = (h16*)(p.ws + OFF_LLA) + base;
  h16* bb = (h16*)(p.ws + OFF_LB) + base;
  float hs = 0.f, ap = 1.f;
  h16 na[16], nb[16];
#pragma unroll
  for (int i = 0; i < 16; i++) { na[i] = la[(size_t)i * 512]; nb[i] = bb[(size_t)i * 512]; }
  for (int t0 = 0; t0 < 256; t0 += 16) {
    h16 ca[16], cb[16];
#pragma unroll
    for (int i = 0; i < 16; i++) { ca[i] = na[i]; cb[i] = nb[i]; }
    if (t0 + 16 < 256) {
#pragma unroll
      for (int i = 0; i < 16; i++) { na[i] = la[(size_t)(t0 + 16 + i) * 512]; nb[i] = bb[(size_t)(t0 + 16 + i) * 512]; }
    }
#pragma unroll
    for (int i = 0; i < 16; i++) {
      float a = __expf((float)ca[i]);
      hs = fmaf(a, hs, (float)cb[i]);
      ap *= a;
      if (!dry) { bb[(size_t)(t0 + i) * 512] = (h16)hs;
      la[(size_t)(t0 + i) * 512] = (h16)ap; }
    }
  }
  if (!dry) { ((float*)(p.ws + OFF_SUMA))[(b * 32 + seg) * 512 + c] = ap;
  ((float*)(p.ws + OFF_SUMH))[(b * 32 + seg) * 512 + c] = hs; }
}

#define PR_NF 600
__device__ __forceinline__ float treduce16(const float (&yp)[16], int lane) {
  const bool b3 = (lane & 8) != 0, b2 = (lane & 4) != 0, b1 = (lane & 2) != 0, b0 = (lane & 1) != 0;
  float q8[8], q4[4], q2[2];
#pragma unroll
  for (int i = 0; i < 8; i++) { float keep = b3 ? yp[i + 8] : yp[i], send = b3 ? yp[i] : yp[i + 8]; q8[i] = keep + dpp_f<0x140>(send); }
#pragma unroll
  for (int i = 0; i < 4; i++) { float keep = b2 ? q8[i + 4] : q8[i], send = b2 ? q8[i] : q8[i + 4]; q4[i] = keep + dpp_f<0x141>(send); }
#pragma unroll
  for (int i = 0; i < 2; i++) { float keep = b1 ? q4[i + 2] : q4[i], send = b1 ? q4[i] : q4[i + 2]; q2[i] = keep + dpp_f<0x4E>(send); }
  float keep = b0 ? q2[1] : q2[0], send = b0 ? q2[0] : q2[1];
  float q1 = keep + dpp_f<0xB1>(send);
  const unsigned qi = __float_as_uint(q1);
  auto r = __builtin_amdgcn_permlane32_swap(qi, qi, false, false);
  return __uint_as_float(r[0]) + __uint_as_float(r[1]);
}

__device__ void lru_scan_task(const Params& p, int task, int dry);

__device__ void rwkv_scan_pc(const Params& p, int blk, char* gsm, int dry) {
  const int rtid = real_tid();
  const int vb = __builtin_amdgcn_readfirstlane(rtid >> 8), tid = rtid & 255, lane = tid & 63, wave = tid >> 6;
  float* bufs = (float*)gsm;
  const int bh = blk >> 3, b = bh >> 3, h = bh & 7, rowbase = (blk & 7) * 8;
  const size_t bS = (size_t)b * SEQ;
  char* ws = p.ws;
  if (vb == 1) {
    const int pair = tid >> 4, l15 = tid & 15, c4 = l15 * 4;
    const size_t cofs = (size_t)h * 64 + c4;
    const h16* aW = (const h16*)(ws + OFF_W16) + cofs;
    const h16* aP = (const h16*)(ws + OFF_KK) + cofs;
    const h16* aA = (const h16*)(ws + OFF_KKA) + cofs;
    const h16* aK = (const h16*)(ws + OFF_KP) + cofs;
    const h16* aR = (const h16*)(ws + OFF_R) + cofs;
    const h16* aV = (const h16*)(ws + OFF_V) + (size_t)h * 64 + rowbase;
    const int lhalf = blk & 1, lseg = (blk >> 1) & 31, lb_ = blk >> 6;
    const int lc = lhalf * 256 + tid;
    const size_t lbase = ((size_t)lb_ * SEQ + lseg * 256) * 512 + lc;
    h16* lla = (h16*)(ws + OFF_LLA) + lbase;
    h16* lbb = (h16*)(ws + OFF_LB) + lbase;
    float lhs = 0.f, lap = 1.f;
    h16x4 nw1, nw2, np1, np2, na1, na2, nk1, nk2, nr1, nr2;
    h16x8 nv1, nv2;
    {
      const size_t tok = bS + pair * 2;
      nw1 = *(const h16x4*)(aW + tok * 512); nw2 = *(const h16x4*)(aW + (tok + 1) * 512);
      np1 = *(const h16x4*)(aP + tok * 512); np2 = *(const h16x4*)(aP + (tok + 1) * 512);
      na1 = *(const h16x4*)(aA + tok * 512); na2 = *(const h16x4*)(aA + (tok + 1) * 512);
      nk1 = *(const h16x4*)(aK + tok * 512); nk2 = *(const h16x4*)(aK + (tok + 1) * 512);
      nr1 = *(const h16x4*)(aR + tok * 512); nr2 = *(const h16x4*)(aR + (tok + 1) * 512);
      if (l15 == 1) { nv1 = *(const h16x8*)(aV + tok * 512); nv2 = *(const h16x8*)(aV + (tok + 1) * 512); }
    }
#pragma unroll 1
    for (int tile = 0; tile < SEQ / 32; tile++) {
      const h16x4 hw1 = nw1, hw2 = nw2, hp1 = np1, hp2 = np2, ha1 = na1, ha2 = na2, hk1 = nk1, hk2 = nk2, hr1 = nr1, hr2 = nr2;
      const h16x8 hv1 = nv1, hv2 = nv2;
      const h16 l_a = lla[(size_t)tile * 512], l_b = lbb[(size_t)tile * 512];
      if (tile + 1 < SEQ / 32) {
        const size_t tok = bS + (size_t)(tile + 1) * 32 + pair * 2;
        nw1 = *(const h16x4*)(aW + tok * 512); nw2 = *(const h16x4*)(aW + (tok + 1) * 512);
        np1 = *(const h16x4*)(aP + tok * 512); np2 = *(const h16x4*)(aP + (tok + 1) * 512);
        na1 = *(const h16x4*)(aA + tok * 512); na2 = *(const h16x4*)(aA + (tok + 1) * 512);
        nk1 = *(const h16x4*)(aK + tok * 512); nk2 = *(const h16x4*)(aK + (tok + 1) * 512);
        nr1 = *(const h16x4*)(aR + tok * 512); nr2 = *(const h16x4*)(aR + (tok + 1) * 512);
        if (l15 == 1) { nv1 = *(const h16x8*)(aV + tok * 512); nv2 = *(const h16x8*)(aV + (tok + 1) * 512); }
      }
      f32x4 P1, P2p, R1p, R2p, W12, AW, KW, A2, K2;
      float sc[8];
#pragma unroll
      for (int e = 0; e < 8; e++) sc[e] = 0.f;
#pragma unroll
      for (int e = 0; e < 4; e++) {
        const float W1 = __expf(-__expf((float)hw1[e])), W2 = __expf(-__expf((float)hw2[e]));
        const float p1 = (float)hp1[e], p2 = (float)hp2[e], a1 = (float)ha1[e], a2 = (float)ha2[e];
        const float k1 = (float)hk1[e], k2 = (float)hk2[e], r1 = (float)hr1[e], r2 = (float)hr2[e];
        const float w12 = W1 * W2, aw = a1 * W2, kw = k1 * W2;
        P1[e] = p1; P2p[e] = W1 * p2; R1p[e] = W1 * r1; R2p[e] = w12 * r2; W12[e] = w12; AW[e] = aw; KW[e] = kw; A2[e] = a2; K2[e] = k2;
        sc[0] += a1 * p2; sc[1] += k1 * p2; sc[2] += a1 * r1; sc[3] += k1 * r1;
        sc[4] += aw * r2; sc[5] += kw * r2; sc[6] += a2 * r2; sc[7] += k2 * r2;
      }
#pragma unroll
      for (int e = 0; e < 8; e++) sc[e] = reduce16(sc[e]);
      float* rec = bufs + (tile & 1) * (16 * PR_NF) + pair * PR_NF;
      *(f32x4*)(rec + c4) = P1;        *(f32x4*)(rec + 64 + c4) = P2p;  *(f32x4*)(rec + 128 + c4) = R1p;
      *(f32x4*)(rec + 192 + c4) = R2p; *(f32x4*)(rec + 256 + c4) = W12; *(f32x4*)(rec + 320 + c4) = AW;
      *(f32x4*)(rec + 384 + c4) = KW;  *(f32x4*)(rec + 448 + c4) = A2;  *(f32x4*)(rec + 512 + c4) = K2;
      if (l15 == 0) {
        f32x4 s0 = {sc[0], sc[1], sc[2], sc[3]}, s1 = {sc[4], sc[5], sc[6], sc[7]};
        *(f32x4*)(rec + 576) = s0; *(f32x4*)(rec + 580) = s1;
      }
      if (l15 == 1) {
#pragma unroll
        for (int r = 0; r < 8; r++) { rec[584 + r] = (float)hv1[r]; rec[592 + r] = (float)hv2[r]; }
      }
      {
        const float a_ = __expf((float)l_a);
        lhs = fmaf(a_, lhs, (float)l_b);
        lap *= a_;
        if (!dry) { lbb[(size_t)tile * 512] = (h16)lhs; lla[(size_t)tile * 512] = (h16)lap; }
      }
      LDS_BARRIER();
    }
    LDS_BARRIER();
    if (!dry) {
      ((float*)(ws + OFF_SUMA))[(lb_ * 32 + lseg) * 512 + lc] = lap;
      ((float*)(ws + OFF_SUMH))[(lb_ * 32 + lseg) * 512 + lc] = lhs;
    }
  } else {
    const int sub = (lane & 15) + ((lane >> 5) << 4), row = wave * 2 + ((lane >> 4) & 1);
    const float m0 = (sub == 0) ? 1.f : 0.f;
    h16* outp = (h16*)(ws + OFF_V) + bS * 512 + (size_t)h * 64 + rowbase;
    f32x2 s = {0.f, 0.f};
    LDS_BARRIER();
#pragma unroll 1
    for (int tile = 0; tile < SEQ / 32; tile++) {
      const float* recb = bufs + (tile & 1) * (16 * PR_NF);
      float yk = 0.f;
#pragma unroll 1
      for (int hb = 0; hb < 2; hb++) {
        float yp[16];
        f32x2 nP1, nP2p, nR1p, nR2p, nW12, nAW, nKW, nA2, nK2; f32x4 nc0, nc1; float nv1, nv2;
        {
          const float* rc = recb + (hb * 8) * PR_NF;
          nP1 = *(const f32x2*)(rc + sub * 2); nP2p = *(const f32x2*)(rc + 64 + sub * 2);
          nR1p = *(const f32x2*)(rc + 128 + sub * 2); nR2p = *(const f32x2*)(rc + 192 + sub * 2);
          nW12 = *(const f32x2*)(rc + 256 + sub * 2); nAW = *(const f32x2*)(rc + 320 + sub * 2);
          nKW = *(const f32x2*)(rc + 384 + sub * 2); nA2 = *(const f32x2*)(rc + 448 + sub * 2); nK2 = *(const f32x2*)(rc + 512 + sub * 2);
          nc0 = *(const f32x4*)(rc + 576); nc1 = *(const f32x4*)(rc + 580);
          nv1 = rc[584 + row]; nv2 = rc[592 + row];
        }
#pragma unroll
        for (int jp = 0; jp < 8; jp++) {
          const f32x2 P1 = nP1, P2p = nP2p, R1p = nR1p, R2p = nR2p, W12 = nW12, AW = nAW, KW = nKW, A2 = nA2, K2 = nK2;
          const f32x4 c0 = nc0, c1 = nc1;
          const float v1 = nv1, v2 = nv2;
          if (jp + 1 < 8) {
            const float* rc = recb + (hb * 8 + jp + 1) * PR_NF;
            nP1 = *(const f32x2*)(rc + sub * 2); nP2p = *(const f32x2*)(rc + 64 + sub * 2);
            nR1p = *(const f32x2*)(rc + 128 + sub * 2); nR2p = *(const f32x2*)(rc + 192 + sub * 2);
            nW12 = *(const f32x2*)(rc + 256 + sub * 2); nAW = *(const f32x2*)(rc + 320 + sub * 2);
            nKW = *(const f32x2*)(rc + 384 + sub * 2); nA2 = *(const f32x2*)(rc + 448 + sub * 2); nK2 = *(const f32x2*)(rc + 512 + sub * 2);
            nc0 = *(const f32x4*)(rc + 576); nc1 = *(const f32x4*)(rc + 580);
            nv1 = rc[584 + row]; nv2 = rc[592 + row];
          }
          float d1 = s[0] * P1[0] + s[1] * P1[1];
          float d2 = s[0] * P2p[0] + s[1] * P2p[1];
          float y1 = s[0] * R1p[0] + s[1] * R1p[1];
          float y2 = s[0] * R2p[0] + s[1] * R2p[1];
          d1 += dpp_f<0xB1>(d1); d2 += dpp_f<0xB1>(d2);
          d1 += dpp_f<0x4E>(d1); d2 += dpp_f<0x4E>(d2);
          d1 += dpp_f<0x141>(d1); d2 += dpp_f<0x141>(d2);
          d1 += dpp_f<0x140>(d1); d2 += dpp_f<0x140>(d2);
          {
            auto r1 = __builtin_amdgcn_permlane32_swap(__float_as_uint(d1), __float_as_uint(d1), false, false);
            auto r2 = __builtin_amdgcn_permlane32_swap(__float_as_uint(d2), __float_as_uint(d2), false, false);
            d1 = __uint_as_float(r1[0]) + __uint_as_float(r1[1]);
            d2 = __uint_as_float(r2[0]) + __uint_as_float(r2[1]);
          }
          d2 = d2 - d1 * c0[0] + v1 * c0[1];
          const f32x2 base = s * W12 + (f32x2{v1, v1} * KW - f32x2{d1, d1} * AW);
          s = base + (f32x2{v2, v2} * K2 - f32x2{d2, d2} * A2);
          y1 += m0 * (v1 * c0[3] - d1 * c0[2]);
          y2 += m0 * (v1 * c1[1] - d1 * c1[0] + v2 * c1[3] - d2 * c1[2]);
          yp[2 * jp] = y1; yp[2 * jp + 1] = y2;
        }
        const float q1 = treduce16(yp, lane);
        yk = ((sub >> 4) == hb) ? q1 : yk;
      }
      if (!dry) outp[(size_t)(tile * 32 + sub) * 512 + row] = (h16)yk;
      LDS_BARRIER();
    }
  }
}

__device__ void even_pre(const Params& p, char* smem) {
  const int tid = get_tid(), lane = tid & 63, wave = tid >> 6;
  const h16* P = (const h16*)(p.ws + OFF_BIG);
  for (int blk = get_bid(); blk < MTOK / 64; blk += VGRID) {
    const int tgs = blk * 64;
    const int t0 = tgs & (SEQ - 1);
    if (wave < 3) {
      const int c0 = wave * 512 + lane * 8;
      const float* cw = p.in[10];
      float cwr[4][8];
#pragma unroll
      for (int j = 0; j < 4; j++) {
        f32x4 x0 = *(const f32x4*)(cw + j * 1536 + c0), x1 = *(const f32x4*)(cw + j * 1536 + c0 + 4);
#pragma unroll
        for (int e = 0; e < 4; e++) { cwr[j][e] = x0[e]; cwr[j][4 + e] = x1[e]; }
      }
      h16* dst = (h16*)(p.ws + (wave == 0 ? OFF_GQ : wave == 1 ? OFF_GK : OFF_GV)) + lane * 8;
      const h16* src = P + 1552 + c0;
      h16x8 xm[3];
#pragma unroll
      for (int j = 0; j < 3; j++) {
#pragma unroll
        for (int e = 0; e < 8; e++) xm[j][e] = (h16)0.f;
        if (t0 > 0) xm[j] = *(const h16x8*)(src + (size_t)(tgs - 3 + j) * EINP);
      }
      const float qs = (wave == 0) ? 0.08838834764831845f : 1.f;
#pragma unroll 1
      for (int tb = 0; tb < 64; tb += 4) {
        h16x8 xn[4];
#pragma unroll
        for (int u = 0; u < 4; u++) xn[u] = *(const h16x8*)(src + (size_t)(tgs + tb + u) * EINP);
#pragma unroll
        for (int u = 0; u < 4; u++) {
          float val[8];
          float ss = 0.f;
#pragma unroll
          for (int e = 0; e < 8; e++) {
            float v = (float)xm[0][e] * cwr[0][e] + (float)xm[1][e] * cwr[1][e] + (float)xm[2][e] * cwr[2][e] + (float)xn[u][e] * cwr[3][e];
            v = silu_(v);
            val[e] = v;
            ss += v * v;
          }
          float sc = 1.f;
          if (wave < 2) { ss = reduce16(ss); sc = rsqrtf(ss + 1e-6f) * qs; }
          h16x8 o;
#pragma unroll
          for (int e = 0; e < 8; e++) o[e] = (h16)(val[e] * sc);
          *(h16x8*)(dst + (size_t)(tgs + tb + u) * 512) = o;
          xm[0] = xm[1]; xm[1] = xm[2]; xm[2] = xn[u];
        }
      }
    } else {
      const int c4 = lane * 4;
      const float* w2 = p.in[7];
      float w2r[16][4];
#pragma unroll
      for (int j = 0; j < 16; j++) {
        f32x4 x0 = *(const f32x4*)(w2 + j * 256 + c4);
#pragma unroll
        for (int e = 0; e < 4; e++) w2r[j][e] = x0[e];
      }
      const f32x4 lb4 = *(const f32x4*)(p.in[8] + c4);
      h16* ELA = (h16*)(p.ws + OFF_ELA);
      float* AB = (float*)(p.ws + OFF_AB);
      const float alog = (lane < 4) ? p.in[11][lane] : 0.f, dtb = (lane < 4) ? p.in[12][lane] : 0.f;
#pragma unroll 2
      for (int tok = 0; tok < 64; tok++) {
        const size_t tg = (size_t)tgs + tok;
        const h16* pr = P + tg * EINP + 1536;
        h16x8 g0 = *(const h16x8*)(pr), g1 = *(const h16x8*)(pr + 8);
        float z[4] = {lb4[0], lb4[1], lb4[2], lb4[3]};
#pragma unroll
        for (int j = 0; j < 16; j++) {
          const float gj = (float)(j < 8 ? g0[j] : g1[j - 8]);
#pragma unroll
          for (int e = 0; e < 4; e++) z[e] = fmaf(gj, w2r[j][e], z[e]);
        }
        h16x4 o;
#pragma unroll
        for (int e = 0; e < 4; e++) o[e] = (h16)(-softplus_(-z[e]) * (1.f / 16.f));
        *(h16x4*)(ELA + tg * 256 + c4) = o;
        if (lane < 4) {
          float da = (float)P[tg * EINP + 3600 + lane];
          float db = (float)P[tg * EINP + 3604 + lane];
          float g = -__expf(alog) * softplus_(da + dtb);
          AB[(tg * 4 + lane) * 2 + 0] = __expf(g);
          AB[(tg * 4 + lane) * 2 + 1] = sigm(db);
        }
      }
    }
  }
}

__device__ void even_post(const Params& p) {
  const int lane = get_tid() & 63;
  const int gw = get_bid() * 4 + (get_tid() >> 6);
  const int nw = VGRID * 4;
  const int half = gw & 1, c8 = lane * 8;
  const h16* __restrict__ P = (const h16*)(p.ws + OFF_BIG);
  const h16* __restrict__ GV = (const h16*)(p.ws + OFF_GV);
  h16* __restrict__ Y = (h16*)(p.ws + OFF_HH);
  const float* nwp = (half ? p.in[13] : p.in[9]) + (c8 & 127);
  float wn[8];
#pragma unroll
  for (int e = 0; e < 8; e++) wn[e] = nwp[e];
  const int tstep = nw >> 1;
  for (int tg = gw >> 1; tg < MTOK; tg += 2 * tstep) {
    h16x8 o[2], z[2];
#pragma unroll
    for (int u = 0; u < 2; u++) {
      const int t = tg + u * tstep;
      if (t < MTOK) {
        const h16* pr = P + (size_t)t * EINP;
        o[u] = half ? *(const h16x8*)(GV + (size_t)t * 512 + c8) : *(const h16x8*)(pr + 512 + c8);
        z[u] = *(const h16x8*)(pr + (half ? 3088 : 1024) + c8);
      }
    }
#pragma unroll
    for (int u = 0; u < 2; u++) {
      const int t = tg + u * tstep;
      if (t < MTOK) {
        float of[8], ss = 0.f;
#pragma unroll
        for (int e = 0; e < 8; e++) { of[e] = (float)o[u][e]; ss += of[e] * of[e]; }
        ss = reduce16(ss);
        const float inv = rsqrtf(ss * (1.f / 128.f) + 1e-6f);
        h16x8 r;
#pragma unroll
        for (int e = 0; e < 8; e++) r[e] = (h16)(of[e] * inv * wn[e] * silu_((float)z[u][e]));
        *(h16x8*)(Y + (size_t)t * DM + half * 512 + c8) = r;
      }
    }
  }
}

__device__ __forceinline__ float psmix(const h16* __restrict__ P, const float* __restrict__ mu, size_t tg, int t, int c) {
  float cur = (float)P[tg * OIN + c];
  float prev = (t > 0) ? (float)P[(tg - 1) * OIN + c] : 0.f;
  return cur + (prev - cur) * mu[c];
}
__device__ __forceinline__ float psmixm(const h16* __restrict__ P, float m, size_t tg, int t, int c) {
  float cur = (float)P[tg * OIN + c];
  float prev = (t > 0) ? (float)P[(tg - 1) * OIN + c] : 0.f;
  return cur + (prev - cur) * m;
}
__device__ __forceinline__ void psmix8(const h16* __restrict__ P, const float* __restrict__ mu, size_t tg, int t, int c0, float* o) {
  h16x8 cur = *(const h16x8*)(P + tg * OIN + c0);
  h16x8 prv = cur;
  if (t > 0) prv = *(const h16x8*)(P + (tg - 1) * OIN + c0);
  f32x4 m0 = *(const f32x4*)(mu + c0), m1 = *(const f32x4*)(mu + c0 + 4);
#pragma unroll
  for (int j = 0; j < 8; j++) {
    float cf = (float)cur[j];
    float pf = (t > 0) ? (float)prv[j] : 0.f;
    o[j] = cf + (pf - cf) * (j < 4 ? m0[j] : m1[j - 4]);
  }
}
__device__ __forceinline__ float half_sum(float x, int lane) {
  x = reduce16(x);
  const unsigned xi = __float_as_uint(x);
  auto r = __builtin_amdgcn_permlane16_swap(xi, xi, false, false);
  return __uint_as_float(r[0]) + __uint_as_float(r[1]);
}

#define OFF_SW (483 * MIB)
#define SW_W2T 0
#define SW_A2T 32768
#define SW_WAT 65536
#define SW_WXT 98304
#define SW_G2T 131072
__device__ void convert_small(const Params& p) {
  h16* sw = (h16*)(p.ws + OFF_SW);
  for (int idx = get_bid() * 256 + get_tid(); idx < 196608; idx += VGRID * 256) {
    float v;
    if (idx < 131072) {
      const int which = idx >> 15, n = (idx >> 6) & 511, k = idx & 63;
      if (which == 0) v = p.in[18][k * 512 + n];
      else if (which == 1) v = p.in[20][k * 512 + n];
      else if (which == 2) v = p.in[29][((n >> 6) * 64 + k) * 64 + (n & 63)];
      else v = p.in[31][((n >> 6) * 64 + k) * 64 + (n & 63)];
    } else {
      const int j = idx - 131072, n = j >> 7, k = j & 127;
      v = p.in[21][k * 512 + n];
    }
    sw[idx] = (h16)v;
  }
}

#define TLD 136
__device__ void odd_pre(const Params& p, char* smem) {
  const int tid = get_tid(), lane = tid & 63, wave = tid >> 6;
  const int l31 = lane & 31, lh = lane >> 5;
  const h16* P = (const h16*)(p.ws + OFF_BIG);
  const float* mu = p.in[16];
  const h16* sw = (const h16*)(p.ws + OFF_SW);
  for (int job = get_bid(); job < 2048; job += VGRID) {
    if (job < 1024) {
#ifndef NO_RWKVPRE
      const int tg0 = job * 32, t0 = tg0 & (SEQ - 1);
      h16* AL = (h16*)smem;
#pragma unroll
      for (int i = 0; i < 2; i++) {
        const int e = tid + i * 256, tok = e >> 4, ch = e & 15;
        float o[8];
        psmix8(P, mu, (size_t)tg0 + tok, t0 + tok, 1536 + ch * 8, o);
        h16x8 hv;
#pragma unroll
        for (int j = 0; j < 8; j++) hv[j] = (h16)(ch < 8 ? fast_tanh(o[j]) : o[j]);
        *(h16x8*)(AL + tok * TLD + ch * 8) = hv;
      }
      LDS_BARRIER();
      h16* W16 = (h16*)(p.ws + OFF_W16);
      h16* KK = (h16*)(p.ws + OFF_KK);
      h16* KKA = (h16*)(p.ws + OFF_KKA);
      h16* KP = (h16*)(p.ws + OFF_KP);
      h16* RR = (h16*)(p.ws + OFF_R);
      h16* VV = (h16*)(p.ws + OFF_V);
      float* BON = (float*)(p.ws + OFF_BON);
#pragma unroll 1
      for (int hh = 0; hh < 2; hh++) {
        const int head = wave * 2 + hh;
        f32x16 accw[2], acca[2];
#pragma unroll
        for (int n = 0; n < 2; n++)
#pragma unroll
          for (int r = 0; r < 16; r++) { accw[n][r] = 0.f; acca[n][r] = 0.f; }
#pragma unroll
        for (int ks = 0; ks < 4; ks++) {
          h16x8 aw = *(const h16x8*)(AL + l31 * TLD + ks * 16 + lh * 8);
          h16x8 aa = *(const h16x8*)(AL + l31 * TLD + 64 + ks * 16 + lh * 8);
#pragma unroll
          for (int q = 0; q < 2; q++) {
            const int n = wave * 128 + (hh * 2 + q) * 32 + l31;
            h16x8 bw = *(const h16x8*)(sw + SW_W2T + n * 64 + ks * 16 + lh * 8);
            h16x8 ba = *(const h16x8*)(sw + SW_A2T + n * 64 + ks * 16 + lh * 8);
            accw[q] = __builtin_amdgcn_mfma_f32_32x32x16_f16(aw, bw, accw[q], 0, 0, 0);
            acca[q] = __builtin_amdgcn_mfma_f32_32x32x16_f16(aa, ba, acca[q], 0, 0, 0);
          }
        }
        float w0c[2], a0c[2], kkc[2], kac[2], rkc[2], mur[2], muk[2], muv[2];
#pragma unroll
        for (int q = 0; q < 2; q++) {
          const int c = wave * 128 + (hh * 2 + q) * 32 + l31;
          w0c[q] = p.in[17][c]; a0c[q] = p.in[19][c]; kkc[q] = p.in[22][c]; kac[q] = p.in[23][c]; rkc[q] = p.in[24][c];
          mur[q] = mu[c]; muk[q] = mu[512 + c]; muv[q] = mu[1024 + c];
        }
        int tgb = tg0;
#pragma unroll
        for (int r = 0; r < 16; r++) {
          if ((r & 3) == 0) asm volatile("" : "+s"(tgb));
          const int tr = (r & 3) + 8 * (r >> 2) + 4 * lh;
          const size_t tg = (size_t)tgb + tr;
          const int t = (tgb & (SEQ - 1)) + tr;
          float kr[2], av[2];
          float ssp = 0.f, bonp = 0.f;
#pragma unroll
          for (int q = 0; q < 2; q++) {
            const int nt = hh * 2 + q;
            const int c = wave * 128 + nt * 32 + l31;
            float r_ = psmixm(P, mur[q], tg, t, c);
            float k_ = psmixm(P, muk[q], tg, t, 512 + c);
            float v_ = psmixm(P, muv[q], tg, t, 1024 + c);
            float w = -softplus_(-(w0c[q] + accw[q][r])) - 0.5f;
            float a = sigm(a0c[q] + acca[q][r]);
            kr[q] = k_ * kkc[q];
            av[q] = a;
            float kp = k_ * (1.f + (a - 1.f) * kac[q]);
            ssp += kr[q] * kr[q];
            bonp += r_ * kp * rkc[q];
            W16[tg * 512 + c] = (h16)w;
            KP[tg * 512 + c] = (h16)kp;
            RR[tg * 512 + c] = (h16)r_;
            VV[tg * 512 + c] = (h16)v_;
          }
          const float ss = half_sum(ssp, lane);
          const float bon = half_sum(bonp, lane);
          const float inv = rsqrtf(ss + 1e-6f);
#pragma unroll
          for (int q = 0; q < 2; q++) {
            const int c = wave * 128 + (hh * 2 + q) * 32 + l31;
            const float kk = kr[q] * inv;
            KK[tg * 512 + c] = (h16)kk;
            KKA[tg * 512 + c] = (h16)(kk * av[q]);
          }
          if (l31 == 0) BON[tg * 8 + head] = bon;
          if ((r & 3) == 3) asm volatile("" ::: "memory");
        }
      }
      LDS_BARRIER();
#endif
    } else {
#ifndef NO_LRUPRE
      const int tg0 = (job - 1024) * 32, t0 = tg0 & (SEQ - 1);
      h16* XB = (h16*)smem + wave * (32 * TLD);
      {
        const int ch = lane & 15, tq = lane >> 4;
        const int c0 = wave * 128 + ch * 8;
        const float* cw = p.in[27];
        float cwr[4][8], cbr[8];
#pragma unroll
        for (int j = 0; j < 4; j++) {
          f32x4 x0 = *(const f32x4*)(cw + j * 512 + c0), x1 = *(const f32x4*)(cw + j * 512 + c0 + 4);
#pragma unroll
          for (int e = 0; e < 4; e++) { cwr[j][e] = x0[e]; cwr[j][4 + e] = x1[e]; }
        }
        {
          f32x4 x0 = *(const f32x4*)(p.in[28] + c0), x1 = *(const f32x4*)(p.in[28] + c0 + 4);
#pragma unroll
          for (int e = 0; e < 4; e++) { cbr[e] = x0[e]; cbr[4 + e] = x1[e]; }
        }
        h16x8 x[11];
#pragma unroll
        for (int j = 0; j < 11; j++) {
          const int tt = tq * 8 - 3 + j;
          h16x8 z;
#pragma unroll
          for (int e = 0; e < 8; e++) z[e] = (h16)0.f;
          x[j] = z;
          if (t0 + tt >= 0) x[j] = *(const h16x8*)(P + (size_t)((long)tg0 + tt) * OIN + 1792 + c0);
        }
#pragma unroll
        for (int tok = 0; tok < 8; tok++) {
          h16x8 hv;
#pragma unroll
          for (int e = 0; e < 8; e++) {
            float xb = cbr[e] + (float)x[tok][e] * cwr[0][e] + (float)x[tok + 1][e] * cwr[1][e] +
                       (float)x[tok + 2][e] * cwr[2][e] + (float)x[tok + 3][e] * cwr[3][e];
            hv[e] = (h16)xb;
          }
          *(h16x8*)(XB + (tq * 8 + tok) * TLD + ch * 8) = hv;
        }
      }
      LDS_BARRIER();
      h16* LLA = (h16*)(p.ws + OFF_LLA);
      h16* LB = (h16*)(p.ws + OFF_LB);
#pragma unroll 1
      for (int blk = 0; blk < 2; blk++) {
        f32x16 accr[2], acci[2];
#pragma unroll
        for (int n = 0; n < 2; n++)
#pragma unroll
          for (int r = 0; r < 16; r++) { accr[n][r] = 0.f; acci[n][r] = 0.f; }
#pragma unroll
        for (int ks = 0; ks < 4; ks++) {
          h16x8 a = *(const h16x8*)(XB + l31 * TLD + blk * 64 + ks * 16 + lh * 8);
#pragma unroll
          for (int q = 0; q < 2; q++) {
            const int n = wave * 128 + (blk * 2 + q) * 32 + l31;
            h16x8 br, bi;
#pragma unroll
            for (int j = 0; j < 8; j++) {
              br[j] = (h16)p.in[29][((n >> 6) * 64 + ks * 16 + lh * 8 + j) * 64 + (n & 63)];
              bi[j] = (h16)p.in[31][((n >> 6) * 64 + ks * 16 + lh * 8 + j) * 64 + (n & 63)];
            }
            accr[q] = __builtin_amdgcn_mfma_f32_32x32x16_f16(a, br, accr[q], 0, 0, 0);
            acci[q] = __builtin_amdgcn_mfma_f32_32x32x16_f16(a, bi, acci[q], 0, 0, 0);
          }
        }
#pragma unroll
        for (int q = 0; q < 2; q++) {
          const int nt = blk * 2 + q;
          const int c = wave * 128 + nt * 32 + l31;
          const float bac = p.in[30][c], bxc = p.in[32][c];
          const float spl = softplus_(-p.in[33][c]);
          int tgb = tg0;
#pragma unroll
          for (int r = 0; r < 16; r++) {
            if ((r & 7) == 0) asm volatile("" : "+s"(tgb));
            const int tr = (r & 3) + 8 * (r >> 2) + 4 * lh;
            const size_t tg = (size_t)tgb + tr;
            float gr = sigm(accr[q][r] + bac);
            float gi = sigm(acci[q][r] + bxc);
            float la = -8.f * gr * spl;
            float mult = __builtin_amdgcn_sqrtf(fmaxf(1.f - __expf(2.f * la), 0.f));
            float xbv = (float)XB[tr * TLD + nt * 32 + l31];
            LLA[tg * 512 + c] = (h16)la;
            LB[tg * 512 + c] = (h16)(mult * gi * xbv);
            if ((r & 7) == 7) asm volatile("" ::: "memory");
          }
        }
      }
      LDS_BARRIER();
#endif
    }
  }
}

__device__ void odd_post(const Params& p, char* smem) {
  const int tid = get_tid(), lane = tid & 63, wave = tid >> 6;
  const int l31 = lane & 31, lh = lane >> 5;
  const h16* P = (const h16*)(p.ws + OFF_BIG);
  const float* mu = p.in[16];
  const h16* G2T = (const h16*)(p.ws + OFF_SW) + SW_G2T;
  const h16* YS = (const h16*)(p.ws + OFF_V);
  const h16* HL = (const h16*)(p.ws + OFF_LB);
  const h16* CA = (const h16*)(p.ws + OFF_LLA);
  const float* BON = (const float*)(p.ws + OFF_BON);
  h16* Y = (h16*)(p.ws + OFF_HH);
  h16* SG = (h16*)smem;
#ifndef NO_POST
  for (int job = get_bid(); job < 1024; job += VGRID) {
    const int tg0 = job * 32, t0 = tg0 & (SEQ - 1);
#pragma unroll
    for (int i = 0; i < 2; i++) {
      const int e = tid + i * 256, tok = e >> 4, ch = e & 15;
      float o[8];
      psmix8(P, mu, (size_t)tg0 + tok, t0 + tok, 1664 + ch * 8, o);
      h16x8 hv;
#pragma unroll
      for (int j = 0; j < 8; j++) hv[j] = (h16)sigm(o[j]);
      *(h16x8*)(SG + tok * TLD + ch * 8) = hv;
    }
    LDS_BARRIER();
    {
      const int c8 = lane * 8, tq = wave;
      float hin[8];
#pragma unroll
      for (int e = 0; e < 8; e++) hin[e] = 0.f;
      const int bq = tg0 >> 13, seg = t0 >> 8;
      const float* SA = (const float*)(p.ws + OFF_SUMA) + (size_t)bq * 32 * 512 + c8;
      const float* SH = (const float*)(p.ws + OFF_SUMH) + (size_t)bq * 32 * 512 + c8;
      for (int sq = 0; sq < seg; sq++) {
        const f32x4 a0 = *(const f32x4*)(SA + sq * 512), a1 = *(const f32x4*)(SA + sq * 512 + 4);
        const f32x4 h0 = *(const f32x4*)(SH + sq * 512), h1 = *(const f32x4*)(SH + sq * 512 + 4);
#pragma unroll
        for (int e = 0; e < 4; e++) { hin[e] = fmaf(a0[e], hin[e], h0[e]); hin[4 + e] = fmaf(a1[e], hin[4 + e], h1[e]); }
      }
#pragma unroll 2
      for (int tk = 0; tk < 8; tk++) {
        const size_t tg = (size_t)tg0 + tq * 8 + tk;
        const h16x8 hl = *(const h16x8*)(HL + tg * 512 + c8);
        const h16x8 ca = *(const h16x8*)(CA + tg * 512 + c8);
        const h16x8 ly = *(const h16x8*)(P + tg * OIN + 2304 + c8);
        h16x8 o;
#pragma unroll
        for (int e = 0; e < 8; e++) o[e] = (h16)(((float)hl[e] + (float)ca[e] * hin[e]) * gelu_tanh((float)ly[e]));
        *(h16x8*)(Y + tg * DM + 512 + c8) = o;
      }
    }
#pragma unroll 1
    for (int hh = 0; hh < 2; hh++) {
      const int head = wave * 2 + hh;
      f32x16 accg[2];
#pragma unroll
      for (int n = 0; n < 2; n++)
#pragma unroll
        for (int r = 0; r < 16; r++) accg[n][r] = 0.f;
#pragma unroll
      for (int ks = 0; ks < 8; ks++) {
        h16x8 a = *(const h16x8*)(SG + l31 * TLD + ks * 16 + lh * 8);
#pragma unroll
        for (int q = 0; q < 2; q++) {
          const int n = wave * 128 + (hh * 2 + q) * 32 + l31;
          h16x8 bg = *(const h16x8*)(G2T + n * 128 + ks * 16 + lh * 8);
          accg[q] = __builtin_amdgcn_mfma_f32_32x32x16_f16(a, bg, accg[q], 0, 0, 0);
        }
      }
      float lnw[2], lnb[2], muv[2];
#pragma unroll
      for (int q = 0; q < 2; q++) {
        const int c = wave * 128 + (hh * 2 + q) * 32 + l31;
        lnw[q] = p.in[25][c]; lnb[q] = p.in[26][c]; muv[q] = mu[1024 + c];
      }
      int tgb = tg0;
#pragma unroll
      for (int r = 0; r < 16; r++) {
        if ((r & 3) == 0) asm volatile("" : "+s"(tgb));
        const int tr = (r & 3) + 8 * (r >> 2) + 4 * lh;
        const size_t tg = (size_t)tgb + tr;
        const int t = (tgb & (SEQ - 1)) + tr;
        float y[2];
#pragma unroll
        for (int q = 0; q < 2; q++) y[q] = (float)YS[tg * 512 + wave * 128 + (hh * 2 + q) * 32 + l31];
        const float mean = half_sum(y[0] + y[1], lane) * (1.f / 64.f);
        const float d0 = y[0] - mean, d1 = y[1] - mean;
        const float var = half_sum(d0 * d0 + d1 * d1, lane) * (1.f / 64.f);
        const float rs = rsqrtf(var + 64e-5f);
        const float bon = BON[tg * 8 + head];
#pragma unroll
        for (int q = 0; q < 2; q++) {
          const int nt = hh * 2 + q;
          const int c = wave * 128 + nt * 32 + l31;
          const float yn = (q == 0 ? d0 : d1) * rs * lnw[q] + lnb[q];
          const float v = psmixm(P, muv[q], tg, t, 1024 + c);
          Y[tg * DM + c] = (h16)((yn + bon * v) * accg[q][r]);
        }
        if ((r & 3) == 3) asm volatile("" ::: "memory");
      }
    }
    LDS_BARRIER();
  }
#endif
}

__device__ void run_phase(const Params& pin, int ph, char* gsm, int dry) {
  char* smem = gsm + (size_t)__builtin_amdgcn_readfirstlane(threadIdx.x >> 8) * 65536;
  Params p = pin;
  asm volatile("" : "+s"(p.ws));
  char* ws = p.ws;
  h16* wb = (h16*)(ws + OFF_WB);
  h16* HH = (h16*)(ws + OFF_HH);
  h16* BIG = (h16*)(ws + OFF_BIG);
  h16* DMb = (h16*)(ws + OFF_DM);
  const float* nw = p.in[1];
  if (ph == 0) {
    convert_weights(p, 0, (float*)smem);
    row_phase(p.in[0], nullptr, nullptr, 0.f, nw, nullptr, HH);
    return;
  }
  const int L = (ph - 1) / 12, s = (ph - 1) % 12;
  const float* nwl = nw + (size_t)L * 6 * DM;
  if (s == 0 || s == 1 || s == 3 || s == 7 || s == 9 || s == 10) {
    const h16* Ap; const h16* Bp; int K, nN, ldc, epi; void* Cp;
    if (s == 0 || s == 9) { Ap = HH; Bp = wb + (s == 0 ? WGU0 : WGU1); K = DM; nN = 22; Cp = BIG; ldc = DFF; epi = 2; }
    else if (s == 1 || s == 10) { Ap = BIG; Bp = wb + (s == 1 ? WD0 : WD1); K = DFF; nN = 4; Cp = DMb; ldc = DM; epi = 1; }
    else if (s == 3) { Ap = HH; Bp = wb + WIN; K = DM; nN = (L == 0) ? 15 : 11; Cp = BIG; ldc = (L == 0) ? EINP : OIN; epi = 1; }
    else { Ap = HH; Bp = wb + WOUT; K = DM; nN = 4; Cp = DMb; ldc = DM; epi = 1; }
    if (epi == 0) gemm_phase<0>(Ap, Bp, K, 128, nN, Cp, ldc, ldc, gsm);
    else if (epi == 1) gemm_phase<1>(Ap, Bp, K, 128, nN, Cp, ldc, ldc, gsm);
    else gemm_phase<2>(Ap, Bp, K, 128, nN, Cp, ldc, ldc, gsm);
    return;
  }
  switch (s) {
    case 2:
      row_phase(L == 0 ? p.in[0] : p.out, DMb, nwl + 1 * DM, 0.5f, nwl + 2 * DM, p.out, HH, dry);
      break;
    case 4:
      if (L == 0) even_pre(p, smem); else odd_pre(p, smem);
      break;
    case 5: {
      const int vb = __builtin_amdgcn_readfirstlane(threadIdx.x >> 8);
      for (int blk = real_bid(); blk < 256; blk += (int)gridDim.x) {
        if (L == 0) {
          if (vb == 0) scan_task<1>(p, blk, smem, dry); else scan_task<0>(p, blk, smem, dry);
        } else {
          rwkv_scan_pc(p, blk, gsm, dry);
        }
      }
      break;
    }
    case 6:
      if (L == 0) even_post(p); else odd_post(p, smem);
      break;
    case 8:
      row_phase(p.out, DMb, nwl + 3 * DM, 1.0f, nwl + 4 * DM, p.out, HH, dry);
      break;
    case 11:
      if (L == 0) {
        convert_weights(p, 1, (float*)smem);
        convert_small(p);
        row_phase(p.out, DMb, nwl + 5 * DM, 0.5f, nw + 6 * DM, p.out, HH, dry);
      } else {
        row_phase(p.out, DMb, nwl + 5 * DM, 0.5f, nullptr, p.out, nullptr, dry);
      }
      break;
  }
}

#define OFF_BAR (484 * MIB)
#define XB_TMO      128
#define XB_XCNT(j)  (256  + 64 * (j))
#define XB_XSUB(j)  (1280 + 64 * (j))
#define XB_XGEN(j)  (2304 + 64 * (j))
#define XB_TOP      3328
#define XB_TOPGEN   3392
#define XCD_BAR_WORDS 3456
#define XB_SPIN_CAP (1u << 18)
#define LAS __attribute__((address_space(3)))
__device__ __forceinline__ unsigned xb_ld(unsigned* p) { return __hip_atomic_load(p, __ATOMIC_RELAXED, __HIP_MEMORY_SCOPE_AGENT); }
__device__ __forceinline__ unsigned xb_add(unsigned* p, unsigned v) { return __hip_atomic_fetch_add(p, v, __ATOMIC_RELAXED, __HIP_MEMORY_SCOPE_AGENT); }
__device__ __forceinline__ unsigned xb_xcc_id() { return (unsigned)__builtin_amdgcn_s_getreg((3 << 11) | 20) & 0xFu; }
#define XB_SPIN(cond, bar) do { unsigned _sp = 0; while (cond) { __builtin_amdgcn_s_sleep(1); \
    if ((++_sp & 255u) == 0u) { if (xb_ld(&(bar)[XB_TMO])) break; if (_sp > XB_SPIN_CAP) { atomicAdd(&(bar)[XB_TMO], 1u); break; } } } } while (0)
struct XcdBarrier { unsigned* bar; unsigned x; volatile LAS unsigned* st; };
__device__ __forceinline__ XcdBarrier xcd_barrier_post(unsigned* bar, volatile LAS unsigned* st) {
  XcdBarrier b; b.bar = bar; b.x = xb_xcc_id(); b.st = st;
  if (threadIdx.x == 0) (void)xb_add(&bar[XB_XCNT(b.x)], 1u);
  return b;
}
__device__ __forceinline__ void xcd_barrier_complete(unsigned* bar, unsigned x, unsigned& nloc, unsigned& nx) {
  const unsigned G = gridDim.x * gridDim.y * gridDim.z;
  unsigned sum, cnt, mine, sp = 0u;
  for (;;) {
    sum = 0u; cnt = 0u; mine = 0u;
#pragma unroll
    for (unsigned j = 0; j < 16; ++j) { const unsigned c = xb_ld(&bar[XB_XCNT(j)]); sum += c; cnt += (c > 0u) ? 1u : 0u; mine = (j == x) ? c : mine; }
    if (sum == G) break;
    __builtin_amdgcn_s_sleep(1);
    if ((++sp & 255u) == 0u) { if (xb_ld(&bar[XB_TMO])) break; if (sp > XB_SPIN_CAP) { atomicAdd(&bar[XB_TMO], 1u); break; } }
  }
  nloc = mine > 0u ? mine : 1u; nx = cnt > 0u ? cnt : 1u;
}
__device__ __forceinline__ void xcd_barrier(const XcdBarrier& b) {
  asm volatile("s_waitcnt vmcnt(0)" ::: "memory");
  __syncthreads();
  if (threadIdx.x == 0) {
    unsigned* bar = b.bar;
    __builtin_amdgcn_s_waitcnt(0);
    unsigned nloc = b.st[0], nx = b.st[1];
    if (nloc == 0u) { xcd_barrier_complete(bar, b.x, nloc, nx); b.st[0] = nloc; b.st[1] = nx; }
    const unsigned old = xb_add(&bar[XB_XSUB(b.x)], 1u);
    const unsigned gen = old / nloc;
    if (old + 1u == (gen + 1u) * nloc) {
      __builtin_amdgcn_fence(__ATOMIC_RELEASE, "agent");
      asm volatile("s_waitcnt vmcnt(0)" ::: "memory");
      const unsigned og = xb_add(&bar[XB_TOP], 1u);
      const unsigned tg = og / nx;
      if (og + 1u == (tg + 1u) * nx) xb_add(&bar[XB_TOPGEN], 1u);
      else XB_SPIN(xb_ld(&bar[XB_TOPGEN]) == tg, bar);
      __builtin_amdgcn_fence(__ATOMIC_ACQUIRE, "agent");
      xb_add(&bar[XB_XGEN(b.x)], 1u);
      asm volatile("s_waitcnt vmcnt(0)" ::: "memory");
    } else {
      XB_SPIN(xb_ld(&bar[XB_XGEN(b.x)]) == gen, bar);
      __builtin_amdgcn_fence(__ATOMIC_ACQUIRE, "agent");
      asm volatile("s_waitcnt vmcnt(0)" ::: "memory");
    }
  }
  __syncthreads();
}

__global__ void __launch_bounds__(512, 2) mega_kernel(Params p, int ph0, int ph1, int dup_mask) {
  extern __shared__ __attribute__((aligned(16))) char smem[];
  __shared__ uint4 xb_words;
  cg::grid_group grid = cg::this_grid();
  if (threadIdx.x == 0) xb_words = make_uint4(0u, 0u, 0u, 0u);
  __syncthreads();
  XcdBarrier xb = xcd_barrier_post((unsigned*)(p.ws + OFF_BAR), (volatile LAS unsigned*)&xb_words);
  int rep = 0;
  for (int ph = ph0; ph < ph1;) {
    run_phase(p, ph, smem, rep);
    const int bit = (ph == 0) ? 12 : (ph - 1) % 12;
    if (((dup_mask >> bit) & 1) && rep == 0) { rep = 1; } else { rep = 0; ph++; }
    if (ph < ph1) { if (ph1 < 0) grid.sync(); else xcd_barrier(xb); }
  }
}

extern "C" void kernel_launch(void* const* d_in, const int* in_sizes, int n_in, void* d_out, int out_size, void* d_ws,
                              size_t ws_size, hipStream_t stream) {
  static int grid_blocks = 0;
  if (!grid_blocks) {
    int dev = 0, cus = 0, per_cu = 0;
    hipGetDevice(&dev);
    hipDeviceGetAttribute(&cus, hipDeviceAttributeMultiprocessorCount, dev);
    hipFuncSetAttribute((const void*)mega_kernel, hipFuncAttributeMaxDynamicSharedMemorySize, 131072);
    hipOccupancyMaxActiveBlocksPerMultiprocessor(&per_cu, mega_kernel, 512, 131072);
    if (per_cu > 1) per_cu = 1;
    if (per_cu < 1) per_cu = 1;
    grid_blocks = cus * per_cu;
  }
  Params p{};
  for (int i = 0; i < 34; i++) p.in[i] = (const float*)d_in[i];
  p.out = (float*)d_out;
  p.ws = (char*)d_ws;
  int ph0 = 0, ph1 = NPHASE, dup = DUPMASK;
  void* args[] = {&p, &ph0, &ph1, &dup};
  hipMemsetAsync((char*)d_ws + OFF_BAR, 0, XCD_BAR_WORDS * sizeof(unsigned), stream);
  hipError_t e = hipLaunchCooperativeKernel((void*)mega_kernel, dim3(grid_blocks), dim3(512), args, 131072, stream);
  if (e != hipSuccess) fprintf(stderr, "cooperative launch failed: %s (grid %d)\n", hipGetErrorString(e), grid_blocks);
}
```

```cpp
#include <hip/hip_runtime.h>
#include <hip/hip_fp16.h>
#include <hip/hip_cooperative_groups.h>
#include <cstdio>
namespace cg = cooperative_groups;

typedef _Float16 h16;
typedef h16 h16x8 __attribute__((ext_vector_type(8)));
typedef h16 h16x4 __attribute__((ext_vector_type(4)));
typedef float f32x16 __attribute__((ext_vector_type(16)));
typedef unsigned int u32x4 __attribute__((ext_vector_type(4)));
typedef float f32x4 __attribute__((ext_vector_type(4)));

#define MTOK 32768
#define SEQ 8192
#define DM 1024
#define DFF 2816
#define EIN 3608
#define EINP 3712
#define OIN 2816

#define MIB ((size_t)1 << 20)
#define OFF_WB   ((size_t)0)
#define OFF_HH   (48 * MIB)
#define OFF_BIG  (112 * MIB)
#define OFF_DM   (344 * MIB)
#define OFF_ELA  (OFF_DM)
#define OFF_GQ   (OFF_DM + 16 * MIB)
#define OFF_GK   (OFF_DM + 48 * MIB)
#define OFF_GV   (OFF_DM + 80 * MIB)
#define OFF_AB   (OFF_DM + 112 * MIB)
#define OFF_KK   (OFF_HH)
#define OFF_KKA  (OFF_HH + 32 * MIB)
#define OFF_W16  (288 * MIB)
#define OFF_KP   (320 * MIB)
#define OFF_R    (352 * MIB)
#define OFF_V    (384 * MIB)
#define OFF_LLA  (416 * MIB)
#define OFF_LB   (448 * MIB)
#define OFF_BON  (480 * MIB)
#define WGU0 0
#define WD0  5767168
#define WGU1 8650752
#define WD1  14417920
#define WIN  17301504
#define WOUT 21233664

#define SMEM_BYTES 45056
#define NPHASE 25
#define DUPMASK 0x0

struct Params {
  const float* in[34];
  float* out;
  char* ws;
};

__device__ __forceinline__ int get_tid() { int t = threadIdx.x & 255; asm volatile("" : "+v"(t)); return t; }
__device__ __forceinline__ int get_bid() { int t = blockIdx.x * 2 + __builtin_amdgcn_readfirstlane(threadIdx.x >> 8); asm volatile("" : "+s"(t)); return t; }
__device__ __forceinline__ int real_tid() { int t = threadIdx.x; asm volatile("" : "+v"(t)); return t; }
__device__ __forceinline__ int real_bid() { int t = blockIdx.x; asm volatile("" : "+s"(t)); return t; }
#define VGRID ((int)gridDim.x * 2)
__device__ __forceinline__ float sigm(float x) { return __builtin_amdgcn_rcpf(1.f + __expf(-x)); }
__device__ __forceinline__ float softplus_(float x) { return fmaxf(x, 0.f) + __logf(1.f + __expf(-fabsf(x))); }
__device__ __forceinline__ float silu_(float x) { return x * __builtin_amdgcn_rcpf(1.f + __expf(-x)); }
__device__ __forceinline__ float fast_tanh(float u) { return 1.f - 2.f * __builtin_amdgcn_rcpf(1.f + __expf(2.f * u)); }
__device__ __forceinline__ float gelu_tanh(float x) {
  float u = 0.7978845608028654f * (x + 0.044715f * x * x * x);
  return 0.5f * x * (1.f + fast_tanh(u));
}

template <int CTRL>
__device__ __forceinline__ float dpp_f(float x) {
  return __int_as_float(__builtin_amdgcn_update_dpp(0, __float_as_int(x), CTRL, 0xF, 0xF, true));
}
__device__ __forceinline__ float reduce16(float x) {
  x += dpp_f<0xB1>(x);
  x += dpp_f<0x4E>(x);
  x += dpp_f<0x141>(x);
  x += dpp_f<0x140>(x);
  return x;
}

__device__ __forceinline__ float wave_sum(float v) {
  v = reduce16(v);
  const int vi = __float_as_int(v);
  float t = __int_as_float(__builtin_amdgcn_readlane(vi, 0));
  t += __int_as_float(__builtin_amdgcn_readlane(vi, 16));
  t += __int_as_float(__builtin_amdgcn_readlane(vi, 32));
  t += __int_as_float(__builtin_amdgcn_readlane(vi, 48));
  return t;
}

#define LDS_BARRIER() do { asm volatile("s_waitcnt lgkmcnt(0)" ::: "memory"); __builtin_amdgcn_s_barrier(); asm volatile("" ::: "memory"); } while (0)

__device__ void conv_tile(const float* __restrict__ src, int K, int N, h16* __restrict__ dst, int mode, int kt, int nt,
                          float* sm) {
  const int tid = get_tid();
#pragma unroll
  for (int i = 0; i < 4; i++) {
    const int idx = tid + i * 256, r = idx >> 4, c4 = (idx & 15) * 4;
    const int n = nt * 64 + c4;
    f32x4 v = {0.f, 0.f, 0.f, 0.f};
    if (n < N) v = __builtin_nontemporal_load((const f32x4*)(src + (size_t)(kt * 64 + r) * N + n));
#pragma unroll
    for (int e = 0; e < 4; e++) sm[r * 65 + c4 + e] = v[e];
  }
  LDS_BARRIER();
#pragma unroll
  for (int i = 0; i < 2; i++) {
    const int idx = tid + i * 256, nl = idx >> 3, kc = (idx & 7) * 8;
    const int n = nt * 64 + nl;
    const int row = (mode == 0) ? n : ((n >> 4) * 32 + (mode - 1) * 16 + (n & 15));
    h16x8 o;
#pragma unroll
    for (int j = 0; j < 8; j++) o[j] = (h16)sm[(kc + j) * 65 + nl];
    *(h16x8*)(dst + (size_t)row * K + kt * 64 + kc) = o;
  }
  LDS_BARRIER();
}

__device__ void convert_weights(const Params& p, int L, float* sm) {
  h16* wb = (h16*)(p.ws + OFF_WB);
  const int T_G = 16 * 44, T_D = 44 * 16;
  const int T_F = 2 * T_G + T_D;
  const int nin = (L == 0) ? 60 : 44;
  const int T_IN = 16 * nin, T_OUT = 256;
  const int total = 2 * T_F + T_IN + T_OUT;
  for (int j = get_bid(); j < total; j += VGRID) {
    int q = j;
    const float* src; int K, N, mode, ntn; h16* dst;
    if (q < 2 * T_F) {
      int f = q / T_F; q -= f * T_F;
      int lf = L * 2 + f;
      if (q < T_G) { src = p.in[2] + (size_t)lf * DM * DFF; K = DM; N = DFF; dst = wb + (f ? WGU1 : WGU0); mode = 1; ntn = 44; }
      else if (q < 2 * T_G) { q -= T_G; src = p.in[3] + (size_t)lf * DM * DFF; K = DM; N = DFF; dst = wb + (f ? WGU1 : WGU0); mode = 2; ntn = 44; }
      else { q -= 2 * T_G; src = p.in[4] + (size_t)lf * DFF * DM; K = DFF; N = DM; dst = wb + (f ? WD1 : WD0); mode = 0; ntn = 16; }
    } else {
      q -= 2 * T_F;
      if (q < T_IN) { src = (L == 0) ? p.in[5] : p.in[14]; K = DM; N = (L == 0) ? EIN : OIN; dst = wb + WIN; mode = 0; ntn = nin; }
      else { q -= T_IN; src = (L == 0) ? p.in[6] : p.in[15]; K = DM; N = DM; dst = wb + WOUT; mode = 0; ntn = 16; }
    }
    int kt = q / ntn, nt = q % ntn;
    conv_tile(src, K, N, dst, mode, kt, nt, sm);
  }
}

__device__ void row_phase(const float* __restrict__ xin, const h16* __restrict__ Dmat, const float* __restrict__ wpost,
                          float res, const float* __restrict__ wpre, float* __restrict__ xout, h16* __restrict__ hh, int dry = 0) {
  const int lane = get_tid() & 63;
  const int gw = get_bid() * 4 + (get_tid() >> 6);
  const int nw = VGRID * 4;
  float4 nx[4];
  h16x4 nd[4];
  if (gw < MTOK) {
#pragma unroll
    for (int i = 0; i < 4; i++) {
      { f32x4 t_ = __builtin_nontemporal_load((const f32x4*)(xin + (size_t)gw * DM + i * 256 + lane * 4)); nx[i] = make_float4(t_[0], t_[1], t_[2], t_[3]); }
      if (Dmat) nd[i] = __builtin_nontemporal_load((const h16x4*)(Dmat + (size_t)gw * DM + i * 256 + lane * 4));
    }
  }
  for (int row = gw; row < MTOK; row += nw) {
    float4 xv[4];
    h16x4 dh[4];
#pragma unroll
    for (int i = 0; i < 4; i++) { xv[i] = nx[i]; dh[i] = nd[i]; }
    const int nrow = row + nw;
    if (nrow < MTOK) {
#pragma unroll
      for (int i = 0; i < 4; i++) {
        { f32x4 t_ = __builtin_nontemporal_load((const f32x4*)(xin + (size_t)nrow * DM + i * 256 + lane * 4)); nx[i] = make_float4(t_[0], t_[1], t_[2], t_[3]); }
        if (Dmat) nd[i] = __builtin_nontemporal_load((const h16x4*)(Dmat + (size_t)nrow * DM + i * 256 + lane * 4));
      }
    }
    if (Dmat) {
      float4 dv[4];
      float ss = 0.f;
#pragma unroll
      for (int i = 0; i < 4; i++) {
        dv[i].x = (float)dh[i][0]; dv[i].y = (float)dh[i][1]; dv[i].z = (float)dh[i][2]; dv[i].w = (float)dh[i][3];
        ss += dv[i].x * dv[i].x + dv[i].y * dv[i].y + dv[i].z * dv[i].z + dv[i].w * dv[i].w;
      }
      ss = wave_sum(ss);
      float inv = rsqrtf(ss * (1.f / DM) + 1e-6f) * res;
#pragma unroll
      for (int i = 0; i < 4; i++) {
        float4 w = *(const float4*)(wpost + i * 256 + lane * 4);
        xv[i].x += dv[i].x * inv * w.x; xv[i].y += dv[i].y * inv * w.y;
        xv[i].z += dv[i].z * inv * w.z; xv[i].w += dv[i].w * inv * w.w;
        if (!dry) { f32x4 t_ = {xv[i].x, xv[i].y, xv[i].z, xv[i].w}; __builtin_nontemporal_store(t_, (f32x4*)(xout + (size_t)row * DM + i * 256 + lane * 4)); }
      }
    }
    if (hh) {
      float ss = 0.f;
#pragma unroll
      for (int i = 0; i < 4; i++) ss += xv[i].x * xv[i].x + xv[i].y * xv[i].y + xv[i].z * xv[i].z + xv[i].w * xv[i].w;
      ss = wave_sum(ss);
      float inv = rsqrtf(ss * (1.f / DM) + 1e-6f);
#pragma unroll
      for (int i = 0; i < 4; i++) {
        float4 w = *(const float4*)(wpre + i * 256 + lane * 4);
        h16x4 o;
        o[0] = (h16)(xv[i].x * inv * w.x); o[1] = (h16)(xv[i].y * inv * w.y);
        o[2] = (h16)(xv[i].z * inv * w.z); o[3] = (h16)(xv[i].w * inv * w.w);
        if (!dry) *(h16x4*)(hh + (size_t)row * DM + i * 256 + lane * 4) = o;
      }
    }
  }
}

typedef float f32x4v __attribute__((ext_vector_type(4)));
#define G_BM 256
#define G_BK 64
#define G_HALF 128
#define G_HT (G_HALF * G_BK)
__device__ __forceinline__ int lds_byte(int r, int c) {
  int st = (r >> 4) * 2 + (c >> 5), rr = r & 15, cc = c & 31, ob = rr * 64 + cc * 2;
  return st * 1024 + (ob ^ (((ob >> 9) & 1) << 5));
}
__device__ __forceinline__ void stage_rc(int b, int& R, int& C) {
  int st = b / 1024, sb = b % 1024, swz = sb ^ (((sb >> 9) & 1) << 5);
  R = (st >> 1) * 16 + swz / 64; C = (st & 1) * 32 + (swz % 64) / 2;
}
template <int EPI>
__device__ void gemm_phase(const h16* __restrict__ A, const h16* __restrict__ Bt, int K, int nM, int nN,
                           void* __restrict__ Cout, int ldc, int ncv, char* smem) {
  h16* shm = (h16*)smem;
#define SA(b, h) (shm + ((b) * 2 + (h)) * G_HT)
#define SB(b, h) (shm + (4 + (b) * 2 + (h)) * G_HT)
#define STAGE(P, BASE, br, kt) do { const char* _gb = (const char*)(BASE) + ((long)(br) * K + (long)(kt) * G_BK) * 2; \
    __builtin_amdgcn_global_load_lds((const unsigned*)(_gb + voff), (unsigned*)((char*)(P) + tid * 16), 16, 0, 0); \
    __builtin_amdgcn_global_load_lds((const unsigned*)(_gb + (long)K * 128 + voff), (unsigned*)((char*)(P) + tid * 16 + 8192), 16, 0, 0); } while (0)
#define LDA(dst, b, h) for (int m = 0; m < 4; ++m) for (int k = 0; k < 2; ++k) \
    dst[m][k] = *reinterpret_cast<const h16x8*>((char*)SA(b, h) + lds_byte(wr * 64 + m * 16 + fr, k * 32 + fq * 8))
#define LDB(dst, b, h) for (int n = 0; n < 2; ++n) for (int k = 0; k < 2; ++k) \
    dst[n][k] = *reinterpret_cast<const h16x8*>((char*)SB(b, h) + lds_byte(wc * 32 + n * 16 + fr, k * 32 + fq * 8))
#define MMA(ai, bj, At_, Bt_) do { __builtin_amdgcn_s_setprio(1); \
    for (int m = 0; m < 4; ++m) for (int n = 0; n < 2; ++n) for (int k = 0; k < 2; ++k) \
      acc[ai][bj][m][n] = __builtin_amdgcn_mfma_f32_16x16x32_f16(Bt_[n][k], At_[m][k], acc[ai][bj][m][n], 0, 0, 0); \
    __builtin_amdgcn_s_setprio(0); } while (0)
#define WAIT_V(n) asm volatile("s_waitcnt vmcnt(" #n ")" ::: "memory")
#define WAIT_L(n) asm volatile("s_waitcnt lgkmcnt(" #n ")" ::: "memory")
#define BAR __builtin_amdgcn_s_barrier()
#define SCHED __builtin_amdgcn_sched_barrier(0)
  const int tid = real_tid();
  const int G = gridDim.x;
  const int nwg = nM * nN;
  const int wid = tid >> 6, lane = tid & 63, wr = wid >> 2, wc = wid & 3, fr = lane & 15, fq = lane >> 4;
  const int nt = K / G_BK;
  unsigned voff;
  { int R0, C0; stage_rc(tid * 16, R0, C0); voff = (unsigned)((R0 * K + C0) * 2); }
  for (int L = real_bid(); L < nwg; L += G) {
    int wgid = L;
    { int q = nwg / 8, r = nwg % 8, xcd = wgid % 8, off = wgid / 8;
      wgid = (xcd < r ? xcd * (q + 1) : r * (q + 1) + (xcd - r) * q) + off; }
    const int nig = 4 * nN, gid = wgid / nig, fm = gid * 4, gsz = min(nM - fm, 4);
    const int pm = fm + ((wgid % nig) % gsz), pn = (wgid % nig) / gsz, brow = pm * G_BM, bcol = pn * G_BM;
    f32x4v acc[2][2][4][2];
#pragma unroll
    for (int a_ = 0; a_ < 2; a_++)
#pragma unroll
      for (int b_ = 0; b_ < 2; b_++)
#pragma unroll
        for (int m = 0; m < 4; m++)
#pragma unroll
          for (int n = 0; n < 2; n++) acc[a_][b_][m][n] = f32x4v{0.f, 0.f, 0.f, 0.f};
    h16x8 At[4][2], B0[2][2], B1[2][2];
    WAIT_V(0);
    __syncthreads();
    STAGE(SB(0, 0), Bt, bcol, 0); STAGE(SA(0, 0), A, brow, 0);
    STAGE(SB(0, 1), Bt, bcol + G_HALF, 0); STAGE(SA(0, 1), A, brow + G_HALF, 0);
    if (wr == 1) BAR;
    WAIT_V(4); BAR;
    STAGE(SB(1, 0), Bt, bcol, 1); STAGE(SA(1, 0), A, brow, 1); STAGE(SB(1, 1), Bt, bcol + G_HALF, 1);
    WAIT_V(6); BAR;
    for (int t = 0; t < nt - 2; t += 2) {
      LDB(B0, 0, 0); SCHED; LDA(At, 0, 0); STAGE(SA(1, 1), A, brow + G_HALF, t + 1);
      WAIT_L(8); BAR; WAIT_L(0); MMA(0, 0, At, B0); BAR; SCHED;
      LDB(B1, 0, 1); STAGE(SB(0, 0), Bt, bcol, t + 2);
      BAR; WAIT_L(0); MMA(0, 1, At, B1); BAR;
      LDA(At, 0, 1); STAGE(SA(0, 0), A, brow, t + 2);
      BAR; WAIT_L(0); MMA(1, 0, At, B0); BAR; SCHED;
      STAGE(SB(0, 1), Bt, bcol + G_HALF, t + 2);
      WAIT_V(6); BAR; MMA(1, 1, At, B1); BAR;
      LDB(B0, 1, 0); SCHED; LDA(At, 1, 0); STAGE(SA(0, 1), A, brow + G_HALF, t + 2);
      WAIT_L(8); BAR; WAIT_L(0); MMA(0, 0, At, B0); BAR; SCHED;
      LDB(B1, 1, 1); STAGE(SB(1, 0), Bt, bcol, t + 3);
      BAR; WAIT_L(0); MMA(0, 1, At, B1); BAR;
      LDA(At, 1, 1); STAGE(SA(1, 0), A, brow, t + 3);
      BAR; WAIT_L(0); MMA(1, 0, At, B0); BAR; SCHED;
      STAGE(SB(1, 1), Bt, bcol + G_HALF, t + 3);
      WAIT_V(6); BAR; MMA(1, 1, At, B1); BAR;
    }
    { LDB(B0, 0, 0); LDA(At, 0, 0); STAGE(SA(1, 1), A, brow + G_HALF, nt - 1);
      BAR; WAIT_L(0); MMA(0, 0, At, B0); BAR;
      LDB(B1, 0, 1); BAR; WAIT_L(0); MMA(0, 1, At, B1); BAR;
      LDA(At, 0, 1); WAIT_V(4); BAR; WAIT_L(0); MMA(1, 0, At, B0); MMA(1, 1, At, B1); BAR; }
    { LDB(B0, 1, 0); LDA(At, 1, 0); WAIT_V(2); BAR; WAIT_L(0); MMA(0, 0, At, B0); BAR;
      LDB(B1, 1, 1); WAIT_V(0); BAR; WAIT_L(0); MMA(0, 1, At, B1); BAR;
      LDA(At, 1, 1); BAR; WAIT_L(0); MMA(1, 0, At, B0); MMA(1, 1, At, B1); BAR; }
    if (wr == 0) BAR;
#pragma unroll
    for (int ai = 0; ai < 2; ++ai)
#pragma unroll
      for (int bj = 0; bj < 2; ++bj)
#pragma unroll
        for (int m = 0; m < 4; ++m) {
          const long row = brow + ai * G_HALF + wr * 64 + m * 16 + fr;
          if (EPI == 2) {
            const f32x4v g = acc[ai][bj][m][0], u = acc[ai][bj][m][1];
            const int col = (bcol >> 1) + bj * 64 + wc * 16 + fq * 4;
            h16x4 o;
#pragma unroll
            for (int j = 0; j < 4; ++j) o[j] = (h16)(silu_(g[j]) * u[j]);
            *(h16x4*)((h16*)Cout + row * ldc + col) = o;
          } else {
#pragma unroll
            for (int n = 0; n < 2; ++n) {
              const int col = bcol + bj * G_HALF + wc * 32 + n * 16 + fq * 4;
              if (EPI == 0) {
                *(f32x4v*)((float*)Cout + row * ldc + col) = acc[ai][bj][m][n];
              } else if (col < ncv) {
                h16x4 o;
#pragma unroll
                for (int j = 0; j < 4; ++j) o[j] = (h16)acc[ai][bj][m][n][j];
                *(h16x4*)((h16*)Cout + row * ldc + col) = o;
              }
            }
          }
        }
  }
#undef SA
#undef SB
}

#define TT 32
template <int MODE> struct ScanCfg;
template <> struct ScanCfg<0> { static constexpr int NF = 200, E = 2, NA = 3, VOFF = 192; };
template <> struct ScanCfg<1> { static constexpr int NF = 268, E = 4, NA = 4, VOFF = 256; };
template <> struct ScanCfg<2> { static constexpr int NF = 328, E = 2, NA = 5, VOFF = 320; };
typedef float f32x2 __attribute__((ext_vector_type(2)));

__device__ __forceinline__ float reduce32(float x) {
  x = reduce16(x);
  const unsigned xi = __float_as_uint(x);
  auto r = __builtin_amdgcn_permlane32_swap(xi, xi, false, false);
  return __uint_as_float(r[0]) + __uint_as_float(r[1]);
}

template <int MODE>
__device__ void scan_task(const Params& p, int task, char* smem, int dry) {
  constexpr int NF = ScanCfg<MODE>::NF, E = ScanCfg<MODE>::E, NA = ScanCfg<MODE>::NA, VOFF = ScanCfg<MODE>::VOFF;
  float* rec = (float*)smem;
  const int tid = get_tid(), lane = tid & 63, wave = tid >> 6;
  const int sub = (lane & 15) + ((lane >> 5) << 4), row = wave * 2 + ((lane >> 4) & 1);
  int b, h, rowbase;
  if (MODE == 2) { int bh = task >> 3; b = bh >> 3; h = bh & 7; rowbase = (task & 7) * 8; }
  else { int bh = task >> 4; b = bh >> 2; h = bh & 3; rowbase = (task & 15) * 8; }
  char* ws = p.ws;
  const size_t bS = (size_t)b * SEQ;

  const h16* src[NA];
  int dsto[NA];
  int ldm;
  const h16* srcv;
  int ldv;
  const int tokv = tid & 31;
  const int dstv = tokv * NF + VOFF;
  if (MODE == 0) {
    const int tok = tid >> 3, ch = tid & 7;
    const h16* P = (const h16*)(ws + OFF_BIG);
    src[0] = (const h16*)(ws + OFF_ELA) + (bS + tok) * 256 + h * 64 + ch * 8;
    src[1] = P + (bS + tok) * EINP + 256 + h * 64 + ch * 8;
    src[2] = P + (bS + tok) * EINP + h * 64 + ch * 8;
    for (int a = 0; a < NA; a++) dsto[a] = tok * NF + a * 64 + ch * 8;
    ldm = EINP;
    srcv = P + (bS + tokv) * EINP + 512 + h * 128 + rowbase; ldv = EINP;
  } else if (MODE == 1) {
    for (int a = 0; a < NA; a++) {
      const int idx = tid + (a & 1) * 256, tok = idx >> 4, ch = idx & 15;
      src[a] = (const h16*)(ws + (a < 2 ? OFF_GK : OFF_GQ)) + (bS + tok) * 512 + h * 128 + ch * 8;
      dsto[a] = tok * NF + (a < 2 ? 0 : 128) + ch * 8;
    }
    ldm = 512;
    srcv = (const h16*)(ws + OFF_GV) + (bS + tokv) * 512 + h * 128 + rowbase; ldv = 512;
  } else {
    const int tok = tid >> 3, ch = tid & 7;
    for (int a = 0; a < NA; a++) {
      const size_t off = a == 0 ? OFF_W16 : a == 1 ? OFF_KK : a == 2 ? OFF_KKA : a == 3 ? OFF_KP : OFF_R;
      src[a] = (const h16*)(ws + off) + (bS + tok) * 512 + h * 64 + ch * 8;
      dsto[a] = tok * NF + a * 64 + ch * 8;
    }
    ldm = 512;
    srcv = (const h16*)(ws + OFF_V) + (bS + tokv) * 512 + h * 64 + rowbase; ldv = 512;
  }
  const float* srcab = (const float*)(ws + OFF_AB) + ((bS + (tid & 31)) * 4 + h) * 2;

  h16* outp; int ldo;
  if (MODE == 0) { outp = (h16*)(ws + OFF_BIG) + 512 + h * 128 + rowbase; ldo = EINP; }
  else if (MODE == 1) { outp = (h16*)(ws + OFF_GV) + h * 128 + rowbase; ldo = 512; }
  else { outp = (h16*)(ws + OFF_V) + h * 64 + rowbase; ldo = 512; }
  outp += bS * ldo;

  float s[E];
#pragma unroll
  for (int e = 0; e < E; e++) s[e] = 0.f;

  u32x4 pre[NA];
  u32x4 prev = {0u, 0u, 0u, 0u};
  float pab0 = 0.f, pab1 = 0.f;
#pragma unroll
  for (int a = 0; a < NA; a++) pre[a] = *(const u32x4*)(src[a]);
  if (tid < 32) prev = *(const u32x4*)(srcv);
  if (MODE == 1 && tid < 32) { pab0 = srcab[0]; pab1 = srcab[1]; }

  for (int t0 = 0; t0 < SEQ; t0 += TT) {
#pragma unroll
    for (int a = 0; a < NA; a++) {
      h16x8 hv = __builtin_bit_cast(h16x8, pre[a]);
      float f[8];
#pragma unroll
      for (int j = 0; j < 8; j++) {
        float x = (float)hv[j];
        if (MODE == 0 && a == 0) x = __expf(x);
        if (MODE == 0 && a == 2) x *= 0.125f;
        if (MODE == 2 && a == 0) x = __expf(-__expf(x));
        f[j] = x;
      }
      f32x4 lo = {f[0], f[1], f[2], f[3]}, hi = {f[4], f[5], f[6], f[7]};
      *(f32x4*)(rec + dsto[a]) = lo;
      *(f32x4*)(rec + dsto[a] + 4) = hi;
    }
    if (tid < 32) {
      h16x8 hv = __builtin_bit_cast(h16x8, prev);
      f32x4 lo = {(float)hv[0], (float)hv[1], (float)hv[2], (float)hv[3]};
      f32x4 hi = {(float)hv[4], (float)hv[5], (float)hv[6], (float)hv[7]};
      *(f32x4*)(rec + dstv) = lo;
      *(f32x4*)(rec + dstv + 4) = hi;
    }
    if (MODE == 1 && tid < 32) { rec[tid * NF + 264] = pab0; rec[tid * NF + 265] = pab1; }
    LDS_BARRIER();
    if (t0 + TT < SEQ) {
      const size_t tn = (size_t)(t0 + TT);
#pragma unroll
      for (int a = 0; a < NA; a++) {
        const int ld = (MODE == 0 && a == 0) ? 256 : ldm;
        pre[a] = *(const u32x4*)(src[a] + tn * ld);
      }
      if (tid < 32) prev = *(const u32x4*)(srcv + tn * ldv);
      if (MODE == 1 && tid < 32) { pab0 = srcab[tn * 8]; pab1 = srcab[tn * 8 + 1]; }
    }
    float yk = 0.f;
#pragma unroll 1
    for (int hb = 0; hb < TT / 16; hb++) {
      float yp[16];
#pragma unroll
      for (int j = 0; j < 16; j++) {
        const float* rc = rec + (hb * 16 + j) * NF;
        float y;
        if (MODE == 0) {
          f32x2 W = *(const f32x2*)(rc + sub * 2);
          f32x2 Kv = *(const f32x2*)(rc + 64 + sub * 2);
          f32x2 R = *(const f32x2*)(rc + 128 + sub * 2);
          float v = rc[VOFF + row];
          s[0] = fmaf(v, Kv[0], s[0] * W[0]);
          s[1] = fmaf(v, Kv[1], s[1] * W[1]);
          y = s[0] * R[0] + s[1] * R[1];
        } else if (MODE == 1) {
          f32x4 Kv = *(const f32x4*)(rc + sub * 4);
          f32x4 R = *(const f32x4*)(rc + 128 + sub * 4);
          float v = rc[VOFF + row];
          f32x2 ab = *(const f32x2*)(rc + 264);
          const float al = ab[0], be = ab[1];
          float d = (s[0] * Kv[0] + s[1] * Kv[1]) + (s[2] * Kv[2] + s[3] * Kv[3]);
          d = reduce32(d);
          float c = be * (v - al * d);
#pragma unroll
          for (int e = 0; e < 4; e++) s[e] = fmaf(c, Kv[e], al * s[e]);
          y = (s[0] * R[0] + s[1] * R[1]) + (s[2] * R[2] + s[3] * R[3]);
        } else {
          f32x2 W = *(const f32x2*)(rc + sub * 2);
          f32x2 Pv = *(const f32x2*)(rc + 64 + sub * 2);
          f32x2 Av = *(const f32x2*)(rc + 128 + sub * 2);
          f32x2 Kv = *(const f32x2*)(rc + 192 + sub * 2);
          f32x2 R = *(const f32x2*)(rc + 256 + sub * 2);
          float v = rc[VOFF + row];
          float d = s[0] * Pv[0] + s[1] * Pv[1];
          d = reduce32(d);
          s[0] = fmaf(v, Kv[0], fmaf(-d, Av[0], s[0] * W[0]));
          s[1] = fmaf(v, Kv[1], fmaf(-d, Av[1], s[1] * W[1]));
          y = s[0] * R[0] + s[1] * R[1];
        }
        yp[j] = y;
      }
      {
        const bool b3 = (lane & 8) != 0, b2 = (lane & 4) != 0, b1 = (lane & 2) != 0, b0 = (lane & 1) != 0;
        float q8[8], q4[4], q2[2];
#pragma unroll
        for (int i = 0; i < 8; i++) {
          float keep = b3 ? yp[i + 8] : yp[i], send = b3 ? yp[i] : yp[i + 8];
          q8[i] = keep + dpp_f<0x140>(send);
        }
#pragma unroll
        for (int i = 0; i < 4; i++) {
          float keep = b2 ? q8[i + 4] : q8[i], send = b2 ? q8[i] : q8[i + 4];
          q4[i] = keep + dpp_f<0x141>(send);
        }
#pragma unroll
        for (int i = 0; i < 2; i++) {
          float keep = b1 ? q4[i + 2] : q4[i], send = b1 ? q4[i] : q4[i + 2];
          q2[i] = keep + dpp_f<0x4E>(send);
        }
        float keep = b0 ? q2[1] : q2[0], send = b0 ? q2[0] : q2[1];
        float q1 = keep + dpp_f<0xB1>(send);
        const unsigned qi = __float_as_uint(q1);
        auto r = __builtin_amdgcn_permlane32_swap(qi, qi, false, false);
        q1 = __uint_as_float(r[0]) + __uint_as_float(r[1]);
        yk = ((sub >> 4) == hb) ? q1 : yk;
      }
    }
    if (!dry) outp[(size_t)(t0 + sub) * ldo + row] = (h16)yk;
    LDS_BARRIER();
  }
}
#define SCAN_BARRIERS (2 * (SEQ / TT))

#define OFF_SUMA (OFF_BON + 1 * MIB)
#define OFF_SUMH (OFF_BON + 1 * MIB + 256 * 1024)
__device__ void lru_scan_task(const Params& p, int task, int dry) {
  const int tid = get_tid();
  const int half = task & 1, seg = (task >> 1) & 31, b = task >> 6;
  const int c = half * 256 + tid;
  const size_t base = ((size_t)b * SEQ + seg * 256) * 512 + c;
  h16* la = (h16*)(p.ws + OFF_LLA) + base;
  h16* bb = (h16*)(p.ws + OFF_LB) + base;
  float hs = 0.f, ap = 1.f;
  h16 na[16], nb[16];
#pragma unroll
  for (int i = 0; i < 16; i++) { na[i] = la[(size_t)i * 512]; nb[i] = bb[(size_t)i * 512]; }
  for (int t0 = 0; t0 < 256; t0 += 16) {
    h16 ca[16], cb[16];
#pragma unroll
    for (int i = 0; i < 16; i++) { ca[i] = na[i]; cb[i] = nb[i]; }
    if (t0 + 16 < 256) {
#pragma unroll
      for (int i = 0; i < 16; i++) { na[i] = la[(size_t)(t0 + 16 + i) * 512]; nb[i] = bb[(size_t)(t0 + 16 + i) * 512]; }
    }
#pragma unroll
    for (int i = 0; i < 16; i++) {
      float a = __expf((float)ca[i]);
      hs = fmaf(a, hs, (float)cb[i]);
      ap *= a;
      if (!dry) { bb[(size_t)(t0 + i) * 512] = (h16)hs;
      la[(size_t)(t0 + i) * 512] = (h16)ap; }
    }
  }
  if (!dry) { ((float*)(p.ws + OFF_SUMA))[(b * 32 + seg) * 512 + c] = ap;
  ((float*)(p.ws + OFF_SUMH))[(b * 32 + seg) * 512 + c] = hs; }
}

#define PR_NF 600
__device__ __forceinline__ float treduce16(const float (&yp)[16], int lane) {
  const bool b3 = (lane & 8) != 0, b2 = (lane & 4) != 0, b1 = (lane & 2) != 0, b0 = (lane & 1) != 0;
  float q8[8], q4[4], q2[2];
#pragma unroll
  for (int i = 0; i < 8; i++) { float keep = b3 ? yp[i + 8] : yp[i], send = b3 ? yp[i] : yp[i + 8]; q8[i] = keep + dpp_f<0x140>(send); }
#pragma unroll
  for (int i = 0; i < 4; i++) { float keep = b2 ? q8[i + 4] : q8[i], send = b2 ? q8[i] : q8[i + 4]; q4[i] = keep + dpp_f<0x141>(send); }
#pragma unroll
  for (int i = 0; i < 2; i++) { float keep = b1 ? q4[i + 2] : q4[i], send = b1 ? q4[i] : q4[i + 2]; q2[i] = keep + dpp_f<0x4E>(send); }
  float keep = b0 ? q2[1] : q2[0], send = b0 ? q2[0] : q2[1];
  float q1 = keep + dpp_f<0xB1>(send);
  const unsigned qi = __float_as_uint(q1);
  auto r = __builtin_amdgcn_permlane32_swap(qi, qi, false, false);
  return __uint_as_float(r[0]) + __uint_as_float(r[1]);
}

__device__ void lru_scan_task(const Params& p, int task, int dry);

__device__ void rwkv_scan_pc(const Params& p, int blk, char* gsm, int dry) {
  const int rtid = real_tid();
  const int vb = __builtin_amdgcn_readfirstlane(rtid >> 8), tid = rtid & 255, lane = tid & 63, wave = tid >> 6;
  float* bufs = (float*)gsm;
  const int bh = blk >> 3, b = bh >> 3, h = bh & 7, rowbase = (blk & 7) * 8;
  const size_t bS = (size_t)b * SEQ;
  char* ws = p.ws;
  if (vb == 1) {
    const int pair = tid >> 4, l15 = tid & 15, c4 = l15 * 4;
    const size_t cofs = (size_t)h * 64 + c4;
    const h16* aW = (const h16*)(ws + OFF_W16) + cofs;
    const h16* aP = (const h16*)(ws + OFF_KK) + cofs;
    const h16* aA = (const h16*)(ws + OFF_KKA) + cofs;
    const h16* aK = (const h16*)(ws + OFF_KP) + cofs;
    const h16* aR = (const h16*)(ws + OFF_R) + cofs;
    const h16* aV = (const h16*)(ws + OFF_V) + (size_t)h * 64 + rowbase;
    const int lhalf = blk & 1, lseg = (blk >> 1) & 31, lb_ = blk >> 6;
    const int lc = lhalf * 256 + tid;
    const size_t lbase = ((size_t)lb_ * SEQ + lseg * 256) * 512 + lc;
    h16* lla = (h16*)(ws + OFF_LLA) + lbase;
    h16* lbb = (h16*)(ws + OFF_LB) + lbase;
    float lhs = 0.f, lap = 1.f;
    h16x4 nw1, nw2, np1, np2, na1, na2, nk1, nk2, nr1, nr2;
    h16x8 nv1, nv2;
    {
      const size_t tok = bS + pair * 2;
      nw1 = *(const h16x4*)(aW + tok * 512); nw2 = *(const h16x4*)(aW + (tok + 1) * 512);
      np1 = *(const h16x4*)(aP + tok * 512); np2 = *(const h16x4*)(aP + (tok + 1) * 512);
      na1 = *(const h16x4*)(aA + tok * 512); na2 = *(const h16x4*)(aA + (tok + 1) * 512);
      nk1 = *(const h16x4*)(aK + tok * 512); nk2 = *(const h16x4*)(aK + (tok + 1) * 512);
      nr1 = *(const h16x4*)(aR + tok * 512); nr2 = *(const h16x4*)(aR + (tok + 1) * 512);
      if (l15 == 1) { nv1 = *(const h16x8*)(aV + tok * 512); nv2 = *(const h16x8*)(aV + (tok + 1) * 512); }
    }
#pragma unroll 1
    for (int tile = 0; tile < SEQ / 32; tile++) {
      const h16x4 hw1 = nw1, hw2 = nw2, hp1 = np1, hp2 = np2, ha1 = na1, ha2 = na2, hk1 = nk1, hk2 = nk2, hr1 = nr1, hr2 = nr2;
      const h16x8 hv1 = nv1, hv2 = nv2;
      const h16 l_a = lla[(size_t)tile * 512], l_b = lbb[(size_t)tile * 512];
      if (tile + 1 < SEQ / 32) {
        const size_t tok = bS + (size_t)(tile + 1) * 32 + pair * 2;
        nw1 = *(const h16x4*)(aW + tok * 512); nw2 = *(const h16x4*)(aW + (tok + 1) * 512);
        np1 = *(const h16x4*)(aP + tok * 512); np2 = *(const h16x4*)(aP + (tok + 1) * 512);
        na1 = *(const h16x4*)(aA + tok * 512); na2 = *(const h16x4*)(aA + (tok + 1) * 512);
        nk1 = *(const h16x4*)(aK + tok * 512); nk2 = *(const h16x4*)(aK + (tok + 1) * 512);
        nr1 = *(const h16x4*)(aR + tok * 512); nr2 = *(const h16x4*)(aR + (tok + 1) * 512);
        if (l15 == 1) { nv1 = *(const h16x8*)(aV + tok * 512); nv2 = *(const h16x8*)(aV + (tok + 1) * 512); }
      }
      f32x4 P1, P2p, R1p, R2p, W12, AW, KW, A2, K2;
      float sc[8];
#pragma unroll
      for (int e = 0; e < 8; e++) sc[e] = 0.f;
#pragma unroll
      for (int e = 0; e < 4; e++) {
        const float W1 = __expf(-__expf((float)hw1[e])), W2 = __expf(-__expf((float)hw2[e]));
        const float p1 = (float)hp1[e], p2 = (float)hp2[e], a1 = (float)ha1[e], a2 = (float)ha2[e];
        const float k1 = (float)hk1[e], k2 = (float)hk2[e], r1 = (float)hr1[e], r2 = (float)hr2[e];
        const float w12 = W1 * W2, aw = a1 * W2, kw = k1 * W2;
        P1[e] = p1; P2p[e] = W1 * p2; R1p[e] = W1 * r1; R2p[e] = w12 * r2; W12[e] = w12; AW[e] = aw; KW[e] = kw; A2[e] = a2; K2[e] = k2;
        sc[0] += a1 * p2; sc[1] += k1 * p2; sc[2] += a1 * r1; sc[3] += k1 * r1;
        sc[4] += aw * r2; sc[5] += kw * r2; sc[6] += a2 * r2; sc[7] += k2 * r2;
      }
#pragma unroll
      for (int e = 0; e < 8; e++) sc[e] = reduce16(sc[e]);
      float* rec = bufs + (tile & 1) * (16 * PR_NF) + pair * PR_NF;
      *(f32x4*)(rec + c4) = P1;        *(f32x4*)(rec + 64 + c4) = P2p;  *(f32x4*)(rec + 128 + c4) = R1p;
      *(f32x4*)(rec + 192 + c4) = R2p; *(f32x4*)(rec + 256 + c4) = W12; *(f32x4*)(rec + 320 + c4) = AW;
      *(f32x4*)(rec + 384 + c4) = KW;  *(f32x4*)(rec + 448 + c4) = A2;  *(f32x4*)(rec + 512 + c4) = K2;
      if (l15 == 0) {
        f32x4 s0 = {sc[0], sc[1], sc[2], sc[3]}, s1 = {sc[4], sc[5], sc[6], sc[7]};
        *(f32x4*)(rec + 576) = s0; *(f32x4*)(rec + 580) = s1;
      }
      if (l15 == 1) {
#pragma unroll
        for (int r = 0; r < 8; r++) { rec[584 + r] = (float)hv1[r]; rec[592 + r] = (float)hv2[r]; }
      }
      {
        const float a_ = __expf((float)l_a);
        lhs = fmaf(a_, lhs, (float)l_b);
        lap *= a_;
        if (!dry) { lbb[(size_t)tile * 512] = (h16)lhs; lla[(size_t)tile * 512] = (h16)lap; }
      }
      LDS_BARRIER();
    }
    LDS_BARRIER();
    if (!dry) {
      ((float*)(ws + OFF_SUMA))[(lb_ * 32 + lseg) * 512 + lc] = lap;
      ((float*)(ws + OFF_SUMH))[(lb_ * 32 + lseg) * 512 + lc] = lhs;
    }
  } else {
    const int sub = (lane & 15) + ((lane >> 5) << 4), row = wave * 2 + ((lane >> 4) & 1);
    const float m0 = (sub == 0) ? 1.f : 0.f;
    h16* outp = (h16*)(ws + OFF_V) + bS * 512 + (size_t)h * 64 + rowbase;
    f32x2 s = {0.f, 0.f};
    LDS_BARRIER();
#pragma unroll 1
    for (int tile = 0; tile < SEQ / 32; tile++) {
      const float* recb = bufs + (tile & 1) * (16 * PR_NF);
      float yk = 0.f;
#pragma unroll 1
      for (int hb = 0; hb < 2; hb++) {
        float yp[16];
        f32x2 nP1, nP2p, nR1p, nR2p, nW12, nAW, nKW, nA2, nK2; f32x4 nc0, nc1; float nv1, nv2;
        {
          const float* rc = recb + (hb * 8) * PR_NF;
          nP1 = *(const f32x2*)(rc + sub * 2); nP2p = *(const f32x2*)(rc + 64 + sub * 2);
          nR1p = *(const f32x2*)(rc + 128 + sub * 2); nR2p = *(const f32x2*)(rc + 192 + sub * 2);
          nW12 = *(const f32x2*)(rc + 256 + sub * 2); nAW = *(const f32x2*)(rc + 320 + sub * 2);
          nKW = *(const f32x2*)(rc + 384 + sub * 2); nA2 = *(const f32x2*)(rc + 448 + sub * 2); nK2 = *(const f32x2*)(rc + 512 + sub * 2);
          nc0 = *(const f32x4*)(rc + 576); nc1 = *(const f32x4*)(rc + 580);
          nv1 = rc[584 + row]; nv2 = rc[592 + row];
        }
#pragma unroll
        for (int jp = 0; jp < 8; jp++) {
          const f32x2 P1 = nP1, P2p = nP2p, R1p = nR1p, R2p = nR2p, W12 = nW12, AW = nAW, KW = nKW, A2 = nA2, K2 = nK2;
          const f32x4 c0 = nc0, c1 = nc1;
          const float v1 = nv1, v2 = nv2;
          if (jp + 1 < 8) {
            const float* rc = recb + (hb * 8 + jp + 1) * PR_NF;
            nP1 = *(const f32x2*)(rc + sub * 2); nP2p = *(const f32x2*)(rc + 64 + sub * 2);
            nR1p = *(const f32x2*)(rc + 128 + sub * 2); nR2p = *(const f32x2*)(rc + 192 + sub * 2);
            nW12 = *(const f32x2*)(rc + 256 + sub * 2); nAW = *(const f32x2*)(rc + 320 + sub * 2);
            nKW = *(const f32x2*)(rc + 384 + sub * 2); nA2 = *(const f32x2*)(rc + 448 + sub * 2); nK2 = *(const f32x2*)(rc + 512 + sub * 2);
            nc0 = *(const f32x4*)(rc + 576); nc1 = *(const f32x4*)(rc + 580);
            nv1 = rc[584 + row]; nv2 = rc[592 + row];
          }
          float d1 = s[0] * P1[0] + s[1] * P1[1];
          float d2 = s[0] * P2p[0] + s[1] * P2p[1];
          float y1 = s[0] * R1p[0] + s[1] * R1p[1];
          float y2 = s[0] * R2p[0] + s[1] * R2p[1];
          d1 += dpp_f<0xB1>(d1); d2 += dpp_f<0xB1>(d2);
          d1 += dpp_f<0x4E>(d1); d2 += dpp_f<0x4E>(d2);
          d1 += dpp_f<0x141>(d1); d2 += dpp_f<0x141>(d2);
          d1 += dpp_f<0x140>(d1); d2 += dpp_f<0x140>(d2);
          {
            auto r1 = __builtin_amdgcn_permlane32_swap(__float_as_uint(d1), __float_as_uint(d1), false, false);
            auto r2 = __builtin_amdgcn_permlane32_swap(__float_as_uint(d2), __float_as_uint(d2), false, false);
            d1 = __uint_as_float(r1[0]) + __uint_as_float(r1[1]);
            d2 = __uint_as_float(r2[0]) + __uint_as_float(r2[1]);
          }
          d2 = d2 - d1 * c0[0] + v1 * c0[1];
          const f32x2 base = s * W12 + (f32x2{v1, v1} * KW - f32x2{d1, d1} * AW);
          s = base + (f32x2{v2, v2} * K2 - f32x2{d2, d2} * A2);
          y1 += m0 * (v1 * c0[3] - d1 * c0[2]);
          y2 += m0 * (v1 * c1[1] - d1 * c1[0] + v2 * c1[3] - d2 * c1[2]);
          yp[2 * jp] = y1; yp[2 * jp + 1] = y2;
        }
        const float q1 = treduce16(yp, lane);
        yk = ((sub >> 4) == hb) ? q1 : yk;
      }
      if (!dry) outp[(size_t)(tile * 32 + sub) * 512 + row] = (h16)yk;
      LDS_BARRIER();
    }
  }
}

__device__ void even_pre(const Params& p, char* smem) {
  const int tid = get_tid(), lane = tid & 63, wave = tid >> 6;
  const h16* P = (const h16*)(p.ws + OFF_BIG);
  for (int blk = get_bid(); blk < MTOK / 64; blk += VGRID) {
    const int tgs = blk * 64;
    const int t0 = tgs & (SEQ - 1);
    if (wave < 3) {
      const int c0 = wave * 512 + lane * 8;
      const float* cw = p.in[10];
      float cwr[4][8];
#pragma unroll
      for (int j = 0; j < 4; j++) {
        f32x4 x0 = *(const f32x4*)(cw + j * 1536 + c0), x1 = *(const f32x4*)(cw + j * 1536 + c0 + 4);
#pragma unroll
        for (int e = 0; e < 4; e++) { cwr[j][e] = x0[e]; cwr[j][4 + e] = x1[e]; }
      }
      h16* dst = (h16*)(p.ws + (wave == 0 ? OFF_GQ : wave == 1 ? OFF_GK : OFF_GV)) + lane * 8;
      const h16* src = P + 1552 + c0;
      h16x8 xm[3];
#pragma unroll
      for (int j = 0; j < 3; j++) {
#pragma unroll
        for (int e = 0; e < 8; e++) xm[j][e] = (h16)0.f;
        if (t0 > 0) xm[j] = *(const h16x8*)(src + (size_t)(tgs - 3 + j) * EINP);
      }
      const float qs = (wave == 0) ? 0.08838834764831845f : 1.f;
#pragma unroll 1
      for (int tb = 0; tb < 64; tb += 4) {
        h16x8 xn[4];
#pragma unroll
        for (int u = 0; u < 4; u++) xn[u] = *(const h16x8*)(src + (size_t)(tgs + tb + u) * EINP);
#pragma unroll
        for (int u = 0; u < 4; u++) {
          float val[8];
          float ss = 0.f;
#pragma unroll
          for (int e = 0; e < 8; e++) {
            float v = (float)xm[0][e] * cwr[0][e] + (float)xm[1][e] * cwr[1][e] + (float)xm[2][e] * cwr[2][e] + (float)xn[u][e] * cwr[3][e];
            v = silu_(v);
            val[e] = v;
            ss += v * v;
          }
          float sc = 1.f;
          if (wave < 2) { ss = reduce16(ss); sc = rsqrtf(ss + 1e-6f) * qs; }
          h16x8 o;
#pragma unroll
          for (int e = 0; e < 8; e++) o[e] = (h16)(val[e] * sc);
          *(h16x8*)(dst + (size_t)(tgs + tb + u) * 512) = o;
          xm[0] = xm[1]; xm[1] = xm[2]; xm[2] = xn[u];
        }
      }
    } else {
      const int c4 = lane * 4;
      const float* w2 = p.in[7];
      float w2r[16][4];
#pragma unroll
      for (int j = 0; j < 16; j++) {
        f32x4 x0 = *(const f32x4*)(w2 + j * 256 + c4);
#pragma unroll
        for (int e = 0; e < 4; e++) w2r[j][e] = x0[e];
      }
      const f32x4 lb4 = *(const f32x4*)(p.in[8] + c4);
      h16* ELA = (h16*)(p.ws + OFF_ELA);
      float* AB = (float*)(p.ws + OFF_AB);
      const float alog = (lane < 4) ? p.in[11][lane] : 0.f, dtb = (lane < 4) ? p.in[12][lane] : 0.f;
#pragma unroll 2
      for (int tok = 0; tok < 64; tok++) {
        const size_t tg = (size_t)tgs + tok;
        const h16* pr = P + tg * EINP + 1536;
        h16x8 g0 = *(const h16x8*)(pr), g1 = *(const h16x8*)(pr + 8);
        float z[4] = {lb4[0], lb4[1], lb4[2], lb4[3]};
#pragma unroll
        for (int j = 0; j < 16; j++) {
          const float gj = (float)(j < 8 ? g0[j] : g1[j - 8]);
#pragma unroll
          for (int e = 0; e < 4; e++) z[e] = fmaf(gj, w2r[j][e], z[e]);
        }
        h16x4 o;
#pragma unroll
        for (int e = 0; e < 4; e++) o[e] = (h16)(-softplus_(-z[e]) * (1.f / 16.f));
        *(h16x4*)(ELA + tg * 256 + c4) = o;
        if (lane < 4) {
          float da = (float)P[tg * EINP + 3600 + lane];
          float db = (float)P[tg * EINP + 3604 + lane];
          float g = -__expf(alog) * softplus_(da + dtb);
          AB[(tg * 4 + lane) * 2 + 0] = __expf(g);
          AB[(tg * 4 + lane) * 2 + 1] = sigm(db);
        }
      }
    }
  }
}

__device__ void even_post(const Params& p) {
  const int lane = get_tid() & 63;
  const int gw = get_bid() * 4 + (get_tid() >> 6);
  const int nw = VGRID * 4;
  const int half = gw & 1, c8 = lane * 8;
  const h16* __restrict__ P = (const h16*)(p.ws + OFF_BIG);
  const h16* __restrict__ GV = (const h16*)(p.ws + OFF_GV);
  h16* __restrict__ Y = (h16*)(p.ws + OFF_HH);
  const float* nwp = (half ? p.in[13] : p.in[9]) + (c8 & 127);
  float wn[8];
#pragma unroll
  for (int e = 0; e < 8; e++) wn[e] = nwp[e];
  const int tstep = nw >> 1;
  for (int tg = gw >> 1; tg < MTOK; tg += 2 * tstep) {
    h16x8 o[2], z[2];
#pragma unroll
    for (int u = 0; u < 2; u++) {
      const int t = tg + u * tstep;
      if (t < MTOK) {
        const h16* pr = P + (size_t)t * EINP;
        o[u] = half ? *(const h16x8*)(GV + (size_t)t * 512 + c8) : *(const h16x8*)(pr + 512 + c8);
        z[u] = *(const h16x8*)(pr + (half ? 3088 : 1024) + c8);
      }
    }
#pragma unroll
    for (int u = 0; u < 2; u++) {
      const int t = tg + u * tstep;
      if (t < MTOK) {
        float of[8], ss = 0.f;
#pragma unroll
        for (int e = 0; e < 8; e++) { of[e] = (float)o[u][e]; ss += of[e] * of[e]; }
        ss = reduce16(ss);
        const float inv = rsqrtf(ss * (1.f / 128.f) + 1e-6f);
        h16x8 r;
#pragma unroll
        for (int e = 0; e < 8; e++) r[e] = (h16)(of[e] * inv * wn[e] * silu_((float)z[u][e]));
        *(h16x8*)(Y + (size_t)t * DM + half * 512 + c8) = r;
      }
    }
  }
}

__device__ __forceinline__ float psmix(const h16* __restrict__ P, const float* __restrict__ mu, size_t tg, int t, int c) {
  float cur = (float)P[tg * OIN + c];
  float prev = (t > 0) ? (float)P[(tg - 1) * OIN + c] : 0.f;
  return cur + (prev - cur) * mu[c];
}
__device__ __forceinline__ float psmixm(const h16* __restrict__ P, float m, size_t tg, int t, int c) {
  float cur = (float)P[tg * OIN + c];
  float prev = (t > 0) ? (float)P[(tg - 1) * OIN + c] : 0.f;
  return cur + (prev - cur) * m;
}
__device__ __forceinline__ void psmix8(const h16* __restrict__ P, const float* __restrict__ mu, size_t tg, int t, int c0, float* o) {
  h16x8 cur = *(const h16x8*)(P + tg * OIN + c0);
  h16x8 prv = cur;
  if (t > 0) prv = *(const h16x8*)(P + (tg - 1) * OIN + c0);
  f32x4 m0 = *(const f32x4*)(mu + c0), m1 = *(const f32x4*)(mu + c0 + 4);
#pragma unroll
  for (int j = 0; j < 8; j++) {
    float cf = (float)cur[j];
    float pf = (t > 0) ? (float)prv[j] : 0.f;
    o[j] = cf + (pf - cf) * (j < 4 ? m0[j] : m1[j - 4]);
  }
}
__device__ __forceinline__ float half_sum(float x, int lane) {
  x = reduce16(x);
  const unsigned xi = __float_as_uint(x);
  auto r = __builtin_amdgcn_permlane16_swap(xi, xi, false, false);
  return __uint_as_float(r[0]) + __uint_as_float(r[1]);
}

#define OFF_SW (483 * MIB)
#define SW_W2T 0
#define SW_A2T 32768
#define SW_WAT 65536
#define SW_WXT 98304
#define SW_G2T 131072
__device__ void convert_small(const Params& p) {
  h16* sw = (h16*)(p.ws + OFF_SW);
  for (int idx = get_bid() * 256 + get_tid(); idx < 196608; idx += VGRID * 256) {
    float v;
    if (idx < 131072) {
      const int which = idx >> 15, n = (idx >> 6) & 511, k = idx & 63;
      if (which == 0) v = p.in[18][k * 512 + n];
      else if (which == 1) v = p.in[20][k * 512 + n];
      else if (which == 2) v = p.in[29][((n >> 6) * 64 + k) * 64 + (n & 63)];
      else v = p.in[31][((n >> 6) * 64 + k) * 64 + (n & 63)];
    } else {
      const int j = idx - 131072, n = j >> 7, k = j & 127;
      v = p.in[21][k * 512 + n];
    }
    sw[idx] = (h16)v;
  }
}

#define TLD 136
__device__ void odd_pre(const Params& p, char* smem) {
  const int tid = get_tid(), lane = tid & 63, wave = tid >> 6;
  const int l31 = lane & 31, lh = lane >> 5;
  const h16* P = (const h16*)(p.ws + OFF_BIG);
  const float* mu = p.in[16];
  const h16* sw = (const h16*)(p.ws + OFF_SW);
  for (int job = get_bid(); job < 2048; job += VGRID) {
    if (job < 1024) {
#ifndef NO_RWKVPRE
      const int tg0 = job * 32, t0 = tg0 & (SEQ - 1);
      h16* AL = (h16*)smem;
#pragma unroll
      for (int i = 0; i < 2; i++) {
        const int e = tid + i * 256, tok = e >> 4, ch = e & 15;
        float o[8];
        psmix8(P, mu, (size_t)tg0 + tok, t0 + tok, 1536 + ch * 8, o);
        h16x8 hv;
#pragma unroll
        for (int j = 0; j < 8; j++) hv[j] = (h16)(ch < 8 ? fast_tanh(o[j]) : o[j]);
        *(h16x8*)(AL + tok * TLD + ch * 8) = hv;
      }
      LDS_BARRIER();
      h16* W16 = (h16*)(p.ws + OFF_W16);
      h16* KK = (h16*)(p.ws + OFF_KK);
      h16* KKA = (h16*)(p.ws + OFF_KKA);
      h16* KP = (h16*)(p.ws + OFF_KP);
      h16* RR = (h16*)(p.ws + OFF_R);
      h16* VV = (h16*)(p.ws + OFF_V);
      float* BON = (float*)(p.ws + OFF_BON);
#pragma unroll 1
      for (int hh = 0; hh < 2; hh++) {
        const int head = wave * 2 + hh;
        f32x16 accw[2], acca[2];
#pragma unroll
        for (int n = 0; n < 2; n++)
#pragma unroll
          for (int r = 0; r < 16; r++) { accw[n][r] = 0.f; acca[n][r] = 0.f; }
#pragma unroll
        for (int ks = 0; ks < 4; ks++) {
          h16x8 aw = *(const h16x8*)(AL + l31 * TLD + ks * 16 + lh * 8);
          h16x8 aa = *(const h16x8*)(AL + l31 * TLD + 64 + ks * 16 + lh * 8);
#pragma unroll
          for (int q = 0; q < 2; q++) {
            const int n = wave * 128 + (hh * 2 + q) * 32 + l31;
            h16x8 bw = *(const h16x8*)(sw + SW_W2T + n * 64 + ks * 16 + lh * 8);
            h16x8 ba = *(const h16x8*)(sw + SW_A2T + n * 64 + ks * 16 + lh * 8);
            accw[q] = __builtin_amdgcn_mfma_f32_32x32x16_f16(aw, bw, accw[q], 0, 0, 0);
            acca[q] = __builtin_amdgcn_mfma_f32_32x32x16_f16(aa, ba, acca[q], 0, 0, 0);
          }
        }
        float w0c[2], a0c[2], kkc[2], kac[2], rkc[2], mur[2], muk[2], muv[2];
#pragma unroll
        for (int q = 0; q < 2; q++) {
          const int c = wave * 128 + (hh * 2 + q) * 32 + l31;
          w0c[q] = p.in[17][c]; a0c[q] = p.in[19][c]; kkc[q] = p.in[22][c]; kac[q] = p.in[23][c]; rkc[q] = p.in[24][c];
          mur[q] = mu[c]; muk[q] = mu[512 + c]; muv[q] = mu[1024 + c];
        }
        int tgb = tg0;
#pragma unroll
        for (int r = 0; r < 16; r++) {
          if ((r & 3) == 0) asm volatile("" : "+s"(tgb));
          const int tr = (r & 3) + 8 * (r >> 2) + 4 * lh;
          const size_t tg = (size_t)tgb + tr;
          const int t = (tgb & (SEQ - 1)) + tr;
          float kr[2], av[2];
          float ssp = 0.f, bonp = 0.f;
#pragma unroll
          for (int q = 0; q < 2; q++) {
            const int nt = hh * 2 + q;
            const int c = wave * 128 + nt * 32 + l31;
            float r_ = psmixm(P, mur[q], tg, t, c);
            float k_ = psmixm(P, muk[q], tg, t, 512 + c);
            float v_ = psmixm(P, muv[q], tg, t, 1024 + c);
            float w = -softplus_(-(w0c[q] + accw[q][r])) - 0.5f;
            float a = sigm(a0c[q] + acca[q][r]);
            kr[q] = k_ * kkc[q];
            av[q] = a;
            float kp = k_ * (1.f + (a - 1.f) * kac[q]);
            ssp += kr[q] * kr[q];
            bonp += r_ * kp * rkc[q];
            W16[tg * 512 + c] = (h16)w;
            KP[tg * 512 + c] = (h16)kp;
            RR[tg * 512 + c] = (h16)r_;
            VV[tg * 512 + c] = (h16)v_;
          }
          const float ss = half_sum(ssp, lane);
          const float bon = half_sum(bonp, lane);
          const float inv = rsqrtf(ss + 1e-6f);
#pragma unroll
          for (int q = 0; q < 2; q++) {
            const int c = wave * 128 + (hh * 2 + q) * 32 + l31;
            const float kk = kr[q] * inv;
            KK[tg * 512 + c] = (h16)kk;
            KKA[tg * 512 + c] = (h16)(kk * av[q]);
          }
          if (l31 == 0) BON[tg * 8 + head] = bon;
          if ((r & 3) == 3) asm volatile("" ::: "memory");
        }
      }
      LDS_BARRIER();
#endif
    } else {
#ifndef NO_LRUPRE
      const int tg0 = (job - 1024) * 32, t0 = tg0 & (SEQ - 1);
      h16* XB = (h16*)smem + wave * (32 * TLD);
      {
        const int ch = lane & 15, tq = lane >> 4;
        const int c0 = wave * 128 + ch * 8;
        const float* cw = p.in[27];
        float cwr[4][8], cbr[8];
#pragma unroll
        for (int j = 0; j < 4; j++) {
          f32x4 x0 = *(const f32x4*)(cw + j * 512 + c0), x1 = *(const f32x4*)(cw + j * 512 + c0 + 4);
#pragma unroll
          for (int e = 0; e < 4; e++) { cwr[j][e] = x0[e]; cwr[j][4 + e] = x1[e]; }
        }
        {
          f32x4 x0 = *(const f32x4*)(p.in[28] + c0), x1 = *(const f32x4*)(p.in[28] + c0 + 4);
#pragma unroll
          for (int e = 0; e < 4; e++) { cbr[e] = x0[e]; cbr[4 + e] = x1[e]; }
        }
        h16x8 x[11];
#pragma unroll
        for (int j = 0; j < 11; j++) {
          const int tt = tq * 8 - 3 + j;
          h16x8 z;
#pragma unroll
          for (int e = 0; e < 8; e++) z[e] = (h16)0.f;
          x[j] = z;
          if (t0 + tt >= 0) x[j] = *(const h16x8*)(P + (size_t)((long)tg0 + tt) * OIN + 1792 + c0);
        }
#pragma unroll
        for (int tok = 0; tok < 8; tok++) {
          h16x8 hv;
#pragma unroll
          for (int e = 0; e < 8; e++) {
            float xb = cbr[e] + (float)x[tok][e] * cwr[0][e] + (float)x[tok + 1][e] * cwr[1][e] +
                       (float)x[tok + 2][e] * cwr[2][e] + (float)x[tok + 3][e] * cwr[3][e];
            hv[e] = (h16)xb;
          }
          *(h16x8*)(XB + (tq * 8 + tok) * TLD + ch * 8) = hv;
        }
      }
      LDS_BARRIER();
      h16* LLA = (h16*)(p.ws + OFF_LLA);
      h16* LB = (h16*)(p.ws + OFF_LB);
#pragma unroll 1
      for (int blk = 0; blk < 2; blk++) {
        f32x16 accr[2], acci[2];
#pragma unroll
        for (int n = 0; n < 2; n++)
#pragma unroll
          for (int r = 0; r < 16; r++) { accr[n][r] = 0.f; acci[n][r] = 0.f; }
#pragma unroll
        for (int ks = 0; ks < 4; ks++) {
          h16x8 a = *(const h16x8*)(XB + l31 * TLD + blk * 64 + ks * 16 + lh * 8);
#pragma unroll
          for (int q = 0; q < 2; q++) {
            const int n = wave * 128 + (blk * 2 + q) * 32 + l31;
            h16x8 br, bi;
#pragma unroll
            for (int j = 0; j < 8; j++) {
              br[j] = (h16)p.in[29][((n >> 6) * 64 + ks * 16 + lh * 8 + j) * 64 + (n & 63)];
              bi[j] = (h16)p.in[31][((n >> 6) * 64 + ks * 16 + lh * 8 + j) * 64 + (n & 63)];
            }
            accr[q] = __builtin_amdgcn_mfma_f32_32x32x16_f16(a, br, accr[q], 0, 0, 0);
            acci[q] = __builtin_amdgcn_mfma_f32_32x32x16_f16(a, bi, acci[q], 0, 0, 0);
          }
        }
#pragma unroll
        for (int q = 0; q < 2; q++) {
          const int nt = blk * 2 + q;
          const int c = wave * 128 + nt * 32 + l31;
          const float bac = p.in[30][c], bxc = p.in[32][c];
          const float spl = softplus_(-p.in[33][c]);
          int tgb = tg0;
#pragma unroll
          for (int r = 0; r < 16; r++) {
            if ((r & 7) == 0) asm volatile("" : "+s"(tgb));
            const int tr = (r & 3) + 8 * (r >> 2) + 4 * lh;
            const size_t tg = (size_t)tgb + tr;
            float gr = sigm(accr[q][r] + bac);
            float gi = sigm(acci[q][r] + bxc);
            float la = -8.f * gr * spl;
            float mult = __builtin_amdgcn_sqrtf(fmaxf(1.f - __expf(2.f * la), 0.f));
            float xbv = (float)XB[tr * TLD + nt * 32 + l31];
            LLA[tg * 512 + c] = (h16)la;
            LB[tg * 512 + c] = (h16)(mult * gi * xbv);
            if ((r & 7) == 7) asm volatile("" ::: "memory");
          }
        }
      }
      LDS_BARRIER();
#endif
    }
  }
}

__device__ void odd_post(const Params& p, char* smem) {
  const int tid = get_tid(), lane = tid & 63, wave = tid >> 6;
  const int l31 = lane & 31, lh = lane >> 5;
  const h16* P = (const h16*)(p.ws + OFF_BIG);
  const float* mu = p.in[16];
  const h16* G2T = (const h16*)(p.ws + OFF_SW) + SW_G2T;
  const h16* YS = (const h16*)(p.ws + OFF_V);
  const h16* HL = (const h16*)(p.ws + OFF_LB);
  const h16* CA = (const h16*)(p.ws + OFF_LLA);
  const float* BON = (const float*)(p.ws + OFF_BON);
  h16* Y = (h16*)(p.ws + OFF_HH);
  h16* SG = (h16*)smem;
#ifndef NO_POST
  for (int job = get_bid(); job < 1024; job += VGRID) {
    const int tg0 = job * 32, t0 = tg0 & (SEQ - 1);
#pragma unroll
    for (int i = 0; i < 2; i++) {
      const int e = tid + i * 256, tok = e >> 4, ch = e & 15;
      float o[8];
      psmix8(P, mu, (size_t)tg0 + tok, t0 + tok, 1664 + ch * 8, o);
      h16x8 hv;
#pragma unroll
      for (int j = 0; j < 8; j++) hv[j] = (h16)sigm(o[j]);
      *(h16x8*)(SG + tok * TLD + ch * 8) = hv;
    }
    LDS_BARRIER();
    {
      const int c8 = lane * 8, tq = wave;
      float hin[8];
#pragma unroll
      for (int e = 0; e < 8; e++) hin[e] = 0.f;
      const int bq = tg0 >> 13, seg = t0 >> 8;
      const float* SA = (const float*)(p.ws + OFF_SUMA) + (size_t)bq * 32 * 512 + c8;
      const float* SH = (const float*)(p.ws + OFF_SUMH) + (size_t)bq * 32 * 512 + c8;
      for (int sq = 0; sq < seg; sq++) {
        const f32x4 a0 = *(const f32x4*)(SA + sq * 512), a1 = *(const f32x4*)(SA + sq * 512 + 4);
        const f32x4 h0 = *(const f32x4*)(SH + sq * 512), h1 = *(const f32x4*)(SH + sq * 512 + 4);
#pragma unroll
        for (int e = 0; e < 4; e++) { hin[e] = fmaf(a0[e], hin[e], h0[e]); hin[4 + e] = fmaf(a1[e], hin[4 + e], h1[e]); }
      }
#pragma unroll 2
      for (int tk = 0; tk < 8; tk++) {
        const size_t tg = (size_t)tg0 + tq * 8 + tk;
        const h16x8 hl = *(const h16x8*)(HL + tg * 512 + c8);
        const h16x8 ca = *(const h16x8*)(CA + tg * 512 + c8);
        const h16x8 ly = *(const h16x8*)(P + tg * OIN + 2304 + c8);
        h16x8 o;
#pragma unroll
        for (int e = 0; e < 8; e++) o[e] = (h16)(((float)hl[e] + (float)ca[e] * hin[e]) * gelu_tanh((float)ly[e]));
        *(h16x8*)(Y + tg * DM + 512 + c8) = o;
      }
    }
#pragma unroll 1
    for (int hh = 0; hh < 2; hh++) {
      const int head = wave * 2 + hh;
      f32x16 accg[2];
#pragma unroll
      for (int n = 0; n < 2; n++)
#pragma unroll
        for (int r = 0; r < 16; r++) accg[n][r] = 0.f;
#pragma unroll
      for (int ks = 0; ks < 8; ks++) {
        h16x8 a = *(const h16x8*)(SG + l31 * TLD + ks * 16 + lh * 8);
#pragma unroll
        for (int q = 0; q < 2; q++) {
          const int n = wave * 128 + (hh * 2 + q) * 32 + l31;
          h16x8 bg = *(const h16x8*)(G2T + n * 128 + ks * 16 + lh * 8);
          accg[q] = __builtin_amdgcn_mfma_f32_32x32x16_f16(a, bg, accg[q], 0, 0, 0);
        }
      }
      float lnw[2], lnb[2], muv[2];
#pragma unroll
      for (int q = 0; q < 2; q++) {
        const int c = wave * 128 + (hh * 2 + q) * 32 + l31;
        lnw[q] = p.in[25][c]; lnb[q] = p.in[26][c]; muv[q] = mu[1024 + c];
      }
      int tgb = tg0;
#pragma unroll
      for (int r = 0; r < 16; r++) {
        if ((r & 3) == 0) asm volatile("" : "+s"(tgb));
        const int tr = (r & 3) + 8 * (r >> 2) + 4 * lh;
        const size_t tg = (size_t)tgb + tr;
        const int t = (tgb & (SEQ - 1)) + tr;
        float y[2];
#pragma unroll
        for (int q = 0; q < 2; q++) y[q] = (float)YS[tg * 512 + wave * 128 + (hh * 2 + q) * 32 + l31];
        const float mean = half_sum(y[0] + y[1], lane) * (1.f / 64.f);
        const float d0 = y[0] - mean, d1 = y[1] - mean;
        const float var = half_sum(d0 * d0 + d1 * d1, lane) * (1.f / 64.f);
        const float rs = rsqrtf(var + 64e-5f);
        const float bon = BON[tg * 8 + head];
#pragma unroll
        for (int q = 0; q < 2; q++) {
          const int nt = hh * 2 + q;
          const int c = wave * 128 + nt * 32 + l31;
          const float yn = (q == 0 ? d0 : d1) * rs * lnw[q] + lnb[q];
          const float v = psmixm(P, muv[q], tg, t, 1024 + c);
          Y[tg * DM + c] = (h16)((yn + bon * v) * accg[q][r]);
        }
        if ((r & 3) == 3) asm volatile("" ::: "memory");
      }
    }
    LDS_BARRIER();
  }
#endif
}

__device__ void run_phase(const Params& pin, int ph, char* gsm, int dry) {
  char* smem = gsm + (size_t)__builtin_amdgcn_readfirstlane(threadIdx.x >> 8) * 65536;
  Params p = pin;
  asm volatile("" : "+s"(p.ws));
  char* ws = p.ws;
  h16* wb = (h16*)(ws + OFF_WB);
  h16* HH = (h16*)(ws + OFF_HH);
  h16* BIG = (h16*)(ws + OFF_BIG);
  h16* DMb = (h16*)(ws + OFF_DM);
  const float* nw = p.in[1];
  if (ph == 0) {
    convert_weights(p, 0, (float*)smem);
    row_phase(p.in[0], nullptr, nullptr, 0.f, nw, nullptr, HH);
    return;
  }
  const int L = (ph - 1) / 12, s = (ph - 1) % 12;
  const float* nwl = nw + (size_t)L * 6 * DM;
  if (s == 0 || s == 1 || s == 3 || s == 7 || s == 9 || s == 10) {
    const h16* Ap; const h16* Bp; int K, nN, ldc, epi; void* Cp;
    if (s == 0 || s == 9) { Ap = HH; Bp = wb + (s == 0 ? WGU0 : WGU1); K = DM; nN = 22; Cp = BIG; ldc = DFF; epi = 2; }
    else if (s == 1 || s == 10) { Ap = BIG; Bp = wb + (s == 1 ? WD0 : WD1); K = DFF; nN = 4; Cp = DMb; ldc = DM; epi = 1; }
    else if (s == 3) { Ap = HH; Bp = wb + WIN; K = DM; nN = (L == 0) ? 15 : 11; Cp = BIG; ldc = (L == 0) ? EINP : OIN; epi = 1; }
    else { Ap = HH; Bp = wb + WOUT; K = DM; nN = 4; Cp = DMb; ldc = DM; epi = 1; }
    if (epi == 0) gemm_phase<0>(Ap, Bp, K, 128, nN, Cp, ldc, ldc, gsm);
    else if (epi == 1) gemm_phase<1>(Ap, Bp, K, 128, nN, Cp, ldc, ldc, gsm);
    else gemm_phase<2>(Ap, Bp, K, 128, nN, Cp, ldc, ldc, gsm);
    return;
  }
  switch (s) {
    case 2:
      row_phase(L == 0 ? p.in[0] : p.out, DMb, nwl + 1 * DM, 0.5f, nwl + 2 * DM, p.out, HH, dry);
      break;
    case 4:
      if (L == 0) even_pre(p, smem); else odd_pre(p, smem);
      break;
    case 5: {
      const int vb = __builtin_amdgcn_readfirstlane(threadIdx.x >> 8);
      for (int blk = real_bid(); blk < 256; blk += (int)gridDim.x) {
        if (L == 0) {
          if (vb == 0) scan_task<1>(p, blk, smem, dry); else scan_task<0>(p, blk, smem, dry);
        } else {
          rwkv_scan_pc(p, blk, gsm, dry);
        }
      }
      break;
    }
    case 6:
      if (L == 0) even_post(p); else odd_post(p, smem);
      break;
    case 8:
      row_phase(p.out, DMb, nwl + 3 * DM, 1.0f, nwl + 4 * DM, p.out, HH, dry);
      break;
    case 11:
      if (L == 0) {
        convert_weights(p, 1, (float*)smem);
        convert_small(p);
        row_phase(p.out, DMb, nwl + 5 * DM, 0.5f, nw + 6 * DM, p.out, HH, dry);
      } else {
        row_phase(p.out, DMb, nwl + 5 * DM, 0.5f, nullptr, p.out, nullptr, dry);
      }
      break;
  }
}

#define OFF_BAR (484 * MIB)
#define XB_TMO      128
#define XB_XCNT(j)  (256  + 64 * (j))
#define XB_XSUB(j)  (1280 + 64 * (j))
#define XB_XGEN(j)  (2304 + 64 * (j))
#define XB_TOP      3328
#define XB_TOPGEN   3392
#define XCD_BAR_WORDS 3456
#define XB_SPIN_CAP (1u << 18)
#define LAS __attribute__((address_space(3)))
__device__ __forceinline__ unsigned xb_ld(unsigned* p) { return __hip_atomic_load(p, __ATOMIC_RELAXED, __HIP_MEMORY_SCOPE_AGENT); }
__device__ __forceinline__ unsigned xb_add(unsigned* p, unsigned v) { return __hip_atomic_fetch_add(p, v, __ATOMIC_RELAXED, __HIP_MEMORY_SCOPE_AGENT); }
__device__ __forceinline__ unsigned xb_xcc_id() { return (unsigned)__builtin_amdgcn_s_getreg((3 << 11) | 20) & 0xFu; }
#define XB_SPIN(cond, bar) do { unsigned _sp = 0; while (cond) { __builtin_amdgcn_s_sleep(1); \
    if ((++_sp & 255u) == 0u) { if (xb_ld(&(bar)[XB_TMO])) break; if (_sp > XB_SPIN_CAP) { atomicAdd(&(bar)[XB_TMO], 1u); break; } } } } while (0)
struct XcdBarrier { unsigned* bar; unsigned x; volatile LAS unsigned* st; };
__device__ __forceinline__ XcdBarrier xcd_barrier_post(unsigned* bar, volatile LAS unsigned* st) {
  XcdBarrier b; b.bar = bar; b.x = xb_xcc_id(); b.st = st;
  if (threadIdx.x == 0) (void)xb_add(&bar[XB_XCNT(b.x)], 1u);
  return b;
}
__device__ __forceinline__ void xcd_barrier_complete(unsigned* bar, unsigned x, unsigned& nloc, unsigned& nx) {
  const unsigned G = gridDim.x * gridDim.y * gridDim.z;
  unsigned sum, cnt, mine, sp = 0u;
  for (;;) {
    sum = 0u; cnt = 0u; mine = 0u;
#pragma unroll
    for (unsigned j = 0; j < 16; ++j) { const unsigned c = xb_ld(&bar[XB_XCNT(j)]); sum += c; cnt += (c > 0u) ? 1u : 0u; mine = (j == x) ? c : mine; }
    if (sum == G) break;
    __builtin_amdgcn_s_sleep(1);
    if ((++sp & 255u) == 0u) { if (xb_ld(&bar[XB_TMO])) break; if (sp > XB_SPIN_CAP) { atomicAdd(&bar[XB_TMO], 1u); break; } }
  }
  nloc = mine > 0u ? mine : 1u; nx = cnt > 0u ? cnt : 1u;
}
__device__ __forceinline__ void xcd_barrier(const XcdBarrier& b) {
  asm volatile("s_waitcnt vmcnt(0)" ::: "memory");
  __syncthreads();
  if (threadIdx.x == 0) {
    unsigned* bar = b.bar;
    __builtin_amdgcn_s_waitcnt(0);
    unsigned nloc = b.st[0], nx = b.st[1];
    if (nloc == 0u) { xcd_barrier_complete(bar, b.x, nloc, nx); b.st[0] = nloc; b.st[1] = nx; }
    const unsigned old = xb_add(&bar[XB_XSUB(b.x)], 1u);
    const unsigned gen = old / nloc;
    if (old + 1u == (gen + 1u) * nloc) {
      __builtin_amdgcn_fence(__ATOMIC_RELEASE, "agent");
      asm volatile("s_waitcnt vmcnt(0)" ::: "memory");
      const unsigned og = xb_add(&bar[XB_TOP], 1u);
      const unsigned tg = og / nx;
      if (og + 1u == (tg + 1u) * nx) xb_add(&bar[XB_TOPGEN], 1u);
      else XB_SPIN(xb_ld(&bar[XB_TOPGEN]) == tg, bar);
      __builtin_amdgcn_fence(__ATOMIC_ACQUIRE, "agent");
      xb_add(&bar[XB_XGEN(b.x)], 1u);
      asm volatile("s_waitcnt vmcnt(0)" ::: "memory");
    } else {
      XB_SPIN(xb_ld(&bar[XB_XGEN(b.x)]) == gen, bar);
      __builtin_amdgcn_fence(__ATOMIC_ACQUIRE, "agent");
      asm volatile("s_waitcnt vmcnt(0)" ::: "memory");
    }
  }
  __syncthreads();
}

__global__ void __launch_bounds__(512, 2) mega_kernel(Params p, int ph0, int ph1, int dup_mask) {
  extern __shared__ __attribute__((aligned(16))) char smem[];
  __shared__ uint4 xb_words;
  cg::grid_group grid = cg::this_grid();
  if (threadIdx.x == 0) xb_words = make_uint4(0u, 0u, 0u, 0u);
  __syncthreads();
  XcdBarrier xb = xcd_barrier_post((unsigned*)(p.ws + OFF_BAR), (volatile LAS unsigned*)&xb_words);
  int rep = 0;
  for (int ph = ph0; ph < ph1;) {
    run_phase(p, ph, smem, rep);
    const int bit = (ph == 0) ? 12 : (ph - 1) % 12;
    if (((dup_mask >> bit) & 1) && rep == 0) { rep = 1; } else { rep = 0; ph++; }
    if (ph < ph1) { if (ph1 < 0) grid.sync(); else xcd_barrier(xb); }
  }
}

extern "C" void kernel_launch(void* const* d_in, const int* in_sizes, int n_in, void* d_out, int out_size, void* d_ws,
                              size_t ws_size, hipStream_t stream) {
  static int grid_blocks = 0;
  if (!grid_blocks) {
    int dev = 0, cus = 0, per_cu = 0;
    hipGetDevice(&dev);
    hipDeviceGetAttribute(&cus, hipDeviceAttributeMultiprocessorCount, dev);
    hipFuncSetAttribute((const void*)mega_kernel, hipFuncAttributeMaxDynamicSharedMemorySize, 131072);
    hipOccupancyMaxActiveBlocksPerMultiprocessor(&per_cu, mega_kernel, 512, 131072);
    if (per_cu > 1) per_cu = 1;
    if (per_cu < 1) per_cu = 1;
    grid_blocks = cus * per_cu;
  }
  Params p{};
  for (int i = 0; i < 34; i++) p.in[i] = (const float*)d_in[i];
  p.out = (float*)d_out;
  p.ws = (char*)d_ws;
  int ph0 = 0, ph1 = NPHASE, dup = DUPMASK;
  void* args[] = {&p, &ph0, &ph1, &dup};
  hipMemsetAsync((char*)d_ws + OFF_BAR, 0, XCD_BAR_WORDS * sizeof(unsigned), stream);
  hipError_t e = hipLaunchCooperativeKernel((void*)mega_kernel, dim3(grid_blocks), dim3(512), args, 131072, stream);
  if (e != hipSuccess) fprintf(stderr, "cooperative launch failed: %s (grid %d)\n", hipGetErrorString(e), grid_blocks);
}
```

```cpp
#include <hip/hip_runtime.h>
#include <hip/hip_fp16.h>
#include <hip/hip_cooperative_groups.h>
#include <cstdio>
namespace cg = cooperative_groups;

typedef _Float16 h16;
typedef h16 h16x8 __attribute__((ext_vector_type(8)));
typedef h16 h16x4 __attribute__((ext_vector_type(4)));
typedef float f32x16 __attribute__((ext_vector_type(16)));
typedef unsigned int u32x4 __attribute__((ext_vector_type(4)));
typedef float f32x4 __attribute__((ext_vector_type(4)));

#define MTOK 32768
#define SEQ 8192
#define DM 1024
#define DFF 2816
#define EIN 3608
#define EINP 3712
#define OIN 2816

#define MIB ((size_t)1 << 20)
#define OFF_WB   ((size_t)0)
#define OFF_HH   (48 * MIB)
#define OFF_BIG  (112 * MIB)
#define OFF_DM   (344 * MIB)
#define OFF_ELA  (OFF_DM)
#define OFF_GQ   (OFF_DM + 16 * MIB)
#define OFF_GK   (OFF_DM + 48 * MIB)
#define OFF_GV   (OFF_DM + 80 * MIB)
#define OFF_AB   (OFF_DM + 112 * MIB)
#define OFF_KK   (OFF_HH)
#define OFF_KKA  (OFF_HH + 32 * MIB)
#define OFF_W16  (288 * MIB)
#define OFF_KP   (320 * MIB)
#define OFF_R    (352 * MIB)
#define OFF_V    (384 * MIB)
#define OFF_LLA  (416 * MIB)
#define OFF_LB   (448 * MIB)
#define OFF_BON  (480 * MIB)
#define WGU0 0
#define WD0  5767168
#define WGU1 8650752
#define WD1  14417920
#define WIN  17301504
#define WOUT 21233664

#define SMEM_BYTES 45056
#define NPHASE 25
#define DUPMASK 0x0

struct Params {
  const float* in[34];
  float* out;
  char* ws;
};

__device__ __forceinline__ int get_tid() { int t = threadIdx.x & 255; asm volatile("" : "+v"(t)); return t; }
__device__ __forceinline__ int get_bid() { int t = blockIdx.x * 2 + __builtin_amdgcn_readfirstlane(threadIdx.x >> 8); asm volatile("" : "+s"(t)); return t; }
__device__ __forceinline__ int real_tid() { int t = threadIdx.x; asm volatile("" : "+v"(t)); return t; }
__device__ __forceinline__ int real_bid() { int t = blockIdx.x; asm volatile("" : "+s"(t)); return t; }
#define VGRID ((int)gridDim.x * 2)
__device__ __forceinline__ float sigm(float x) { return __builtin_amdgcn_rcpf(1.f + __expf(-x)); }
__device__ __forceinline__ float softplus_(float x) { return fmaxf(x, 0.f) + __logf(1.f + __expf(-fabsf(x))); }
__device__ __forceinline__ float silu_(float x) { return x * __builtin_amdgcn_rcpf(1.f + __expf(-x)); }
__device__ __forceinline__ float fast_tanh(float u) { return 1.f - 2.f * __builtin_amdgcn_rcpf(1.f + __expf(2.f * u)); }
__device__ __forceinline__ float gelu_tanh(float x) {
  float u = 0.7978845608028654f * (x + 0.044715f * x * x * x);
  return 0.5f * x * (1.f + fast_tanh(u));
}

template <int CTRL>
__device__ __forceinline__ float dpp_f(float x) {
  return __int_as_float(__builtin_amdgcn_update_dpp(0, __float_as_int(x), CTRL, 0xF, 0xF, true));
}
__device__ __forceinline__ float reduce16(float x) {
  x += dpp_f<0xB1>(x);
  x += dpp_f<0x4E>(x);
  x += dpp_f<0x141>(x);
  x += dpp_f<0x140>(x);
  return x;
}

__device__ __forceinline__ float wave_sum(float v) {
  v = reduce16(v);
  const int vi = __float_as_int(v);
  float t = __int_as_float(__builtin_amdgcn_readlane(vi, 0));
  t += __int_as_float(__builtin_amdgcn_readlane(vi, 16));
  t += __int_as_float(__builtin_amdgcn_readlane(vi, 32));
  t += __int_as_float(__builtin_amdgcn_readlane(vi, 48));
  return t;
}

#define LDS_BARRIER() do { asm volatile("s_waitcnt lgkmcnt(0)" ::: "memory"); __builtin_amdgcn_s_barrier(); asm volatile("" ::: "memory"); } while (0)

__device__ void conv_tile(const float* __restrict__ src, int K, int N, h16* __restrict__ dst, int mode, int kt, int nt,
                          float* sm) {
  const int tid = get_tid();
#pragma unroll
  for (int i = 0; i < 4; i++) {
    const int idx = tid + i * 256, r = idx >> 4, c4 = (idx & 15) * 4;
    const int n = nt * 64 + c4;
    f32x4 v = {0.f, 0.f, 0.f, 0.f};
    if (n < N) v = __builtin_nontemporal_load((const f32x4*)(src + (size_t)(kt * 64 + r) * N + n));
#pragma unroll
    for (int e = 0; e < 4; e++) sm[r * 65 + c4 + e] = v[e];
  }
  LDS_BARRIER();
#pragma unroll
  for (int i = 0; i < 2; i++) {
    const int idx = tid + i * 256, nl = idx >> 3, kc = (idx & 7) * 8;
    const int n = nt * 64 + nl;
    const int row = (mode == 0) ? n : ((n >> 4) * 32 + (mode - 1) * 16 + (n & 15));
    h16x8 o;
#pragma unroll
    for (int j = 0; j < 8; j++) o[j] = (h16)sm[(kc + j) * 65 + nl];
    *(h16x8*)(dst + (size_t)row * K + kt * 64 + kc) = o;
  }
  LDS_BARRIER();
}

__device__ void convert_weights(const Params& p, int L, float* sm) {
  h16* wb = (h16*)(p.ws + OFF_WB);
  const int T_G = 16 * 44, T_D = 44 * 16;
  const int T_F = 2 * T_G + T_D;
  const int nin = (L == 0) ? 60 : 44;
  const int T_IN = 16 * nin, T_OUT = 256;
  const int total = 2 * T_F + T_IN + T_OUT;
  for (int j = get_bid(); j < total; j += VGRID) {
    int q = j;
    const float* src; int K, N, mode, ntn; h16* dst;
    if (q < 2 * T_F) {
      int f = q / T_F; q -= f * T_F;
      int lf = L * 2 + f;
      if (q < T_G) { src = p.in[2] + (size_t)lf * DM * DFF; K = DM; N = DFF; dst = wb + (f ? WGU1 : WGU0); mode = 1; ntn = 44; }
      else if (q < 2 * T_G) { q -= T_G; src = p.in[3] + (size_t)lf * DM * DFF; K = DM; N = DFF; dst = wb + (f ? WGU1 : WGU0); mode = 2; ntn = 44; }
      else { q -= 2 * T_G; src = p.in[4] + (size_t)lf * DFF * DM; K = DFF; N = DM; dst = wb + (f ? WD1 : WD0); mode = 0; ntn = 16; }
    } else {
      q -= 2 * T_F;
      if (q < T_IN) { src = (L == 0) ? p.in[5] : p.in[14]; K = DM; N = (L == 0) ? EIN : OIN; dst = wb + WIN; mode = 0; ntn = nin; }
      else { q -= T_IN; src = (L == 0) ? p.in[6] : p.in[15]; K = DM; N = DM; dst = wb + WOUT; mode = 0; ntn = 16; }
    }
    int kt = q / ntn, nt = q % ntn;
    conv_tile(src, K, N, dst, mode, kt, nt, sm);
  }
}

__device__ void row_phase(const float* __restrict__ xin, const h16* __restrict__ Dmat, const float* __restrict__ wpost,
                          float res, const float* __restrict__ wpre, float* __restrict__ xout, h16* __restrict__ hh, int dry = 0) {
  const int lane = get_tid() & 63;
  const int gw = get_bid() * 4 + (get_tid() >> 6);
  const int nw = VGRID * 4;
  float4 nx[4];
  h16x4 nd[4];
  if (gw < MTOK) {
#pragma unroll
    for (int i = 0; i < 4; i++) {
      { f32x4 t_ = __builtin_nontemporal_load((const f32x4*)(xin + (size_t)gw * DM + i * 256 + lane * 4)); nx[i] = make_float4(t_[0], t_[1], t_[2], t_[3]); }
      if (Dmat) nd[i] = __builtin_nontemporal_load((const h16x4*)(Dmat + (size_t)gw * DM + i * 256 + lane * 4));
    }
  }
  for (int row = gw; row < MTOK; row += nw) {
    float4 xv[4];
    h16x4 dh[4];
#pragma unroll
    for (int i = 0; i < 4; i++) { xv[i] = nx[i]; dh[i] = nd[i]; }
    const int nrow = row + nw;
    if (nrow < MTOK) {
#pragma unroll
      for (int i = 0; i < 4; i++) {
        { f32x4 t_ = __builtin_nontemporal_load((const f32x4*)(xin + (size_t)nrow * DM + i * 256 + lane * 4)); nx[i] = make_float4(t_[0], t_[1], t_[2], t_[3]); }
        if (Dmat) nd[i] = __builtin_nontemporal_load((const h16x4*)(Dmat + (size_t)nrow * DM + i * 256 + lane * 4));
      }
    }
    if (Dmat) {
      float4 dv[4];
      float ss = 0.f;
#pragma unroll
      for (int i = 0; i < 4; i++) {
        dv[i].x = (float)dh[i][0]; dv[i].y = (float)dh[i][1]; dv[i].z = (float)dh[i][2]; dv[i].w = (float)dh[i][3];
        ss += dv[i].x * dv[i].x + dv[i].y * dv[i].y + dv[i].z * dv[i].z + dv[i].w * dv[i].w;
      }
      ss = wave_sum(ss);
      float inv = rsqrtf(ss * (1.f / DM) + 1e-6f) * res;
#pragma unroll
      for (int i = 0; i < 4; i++) {
        float4 w = *(const float4*)(wpost + i * 256 + lane * 4);
        xv[i].x += dv[i].x * inv * w.x; xv[i].y += dv[i].y * inv * w.y;
        xv[i].z += dv[i].z * inv * w.z; xv[i].w += dv[i].w * inv * w.w;
        if (!dry) { f32x4 t_ = {xv[i].x, xv[i].y, xv[i].z, xv[i].w}; __builtin_nontemporal_store(t_, (f32x4*)(xout + (size_t)row * DM + i * 256 + lane * 4)); }
      }
    }
    if (hh) {
      float ss = 0.f;
#pragma unroll
      for (int i = 0; i < 4; i++) ss += xv[i].x * xv[i].x + xv[i].y * xv[i].y + xv[i].z * xv[i].z + xv[i].w * xv[i].w;
      ss = wave_sum(ss);
      float inv = rsqrtf(ss * (1.f / DM) + 1e-6f);
#pragma unroll
      for (int i = 0; i < 4; i++) {
        float4 w = *(const float4*)(wpre + i * 256 + lane * 4);
        h16x4 o;
        o[0] = (h16)(xv[i].x * inv * w.x); o[1] = (h16)(xv[i].y * inv * w.y);
        o[2] = (h16)(xv[i].z * inv * w.z); o[3] = (h16)(xv[i].w * inv * w.w);
        if (!dry) *(h16x4*)(hh + (size_t)row * DM + i * 256 + lane * 4) = o;
      }
    }
  }
}

typedef float f32x4v __attribute__((ext_vector_type(4)));
#define G_BM 256
#define G_BK 64
#define G_HALF 128
#define G_HT (G_HALF * G_BK)
__device__ __forceinline__ int lds_byte(int r, int c) {
  int st = (r >> 4) * 2 + (c >> 5), rr = r & 15, cc = c & 31, ob = rr * 64 + cc * 2;
  return st * 1024 + (ob ^ (((ob >> 9) & 1) << 5));
}
__device__ __forceinline__ void stage_rc(int b, int& R, int& C) {
  int st = b / 1024, sb = b % 1024, swz = sb ^ (((sb >> 9) & 1) << 5);
  R = (st >> 1) * 16 + swz / 64; C = (st & 1) * 32 + (swz % 64) / 2;
}
template <int EPI>
__device__ void gemm_phase(const h16* __restrict__ A, const h16* __restrict__ Bt, int K, int nM, int nN,
                           void* __restrict__ Cout, int ldc, int ncv, char* smem) {
  h16* shm = (h16*)smem;
#define SA(b, h) (shm + ((b) * 2 + (h)) * G_HT)
#define SB(b, h) (shm + (4 + (b) * 2 + (h)) * G_HT)
#define STAGE(P, BASE, br, kt) do { const char* _gb = (const char*)(BASE) + ((long)(br) * K + (long)(kt) * G_BK) * 2; \
    __builtin_amdgcn_global_load_lds((const unsigned*)(_gb + voff), (unsigned*)((char*)(P) + tid * 16), 16, 0, 0); \
    __builtin_amdgcn_global_load_lds((const unsigned*)(_gb + (long)K * 128 + voff), (unsigned*)((char*)(P) + tid * 16 + 8192), 16, 0, 0); } while (0)
#define LDA(dst, b, h) for (int m = 0; m < 4; ++m) for (int k = 0; k < 2; ++k) \
    dst[m][k] = *reinterpret_cast<const h16x8*>((char*)SA(b, h) + lds_byte(wr * 64 + m * 16 + fr, k * 32 + fq * 8))
#define LDB(dst, b, h) for (int n = 0; n < 2; ++n) for (int k = 0; k < 2; ++k) \
    dst[n][k] = *reinterpret_cast<const h16x8*>((char*)SB(b, h) + lds_byte(wc * 32 + n * 16 + fr, k * 32 + fq * 8))
#define MMA(ai, bj, At_, Bt_) do { __builtin_amdgcn_s_setprio(1); \
    for (int m = 0; m < 4; ++m) for (int n = 0; n < 2; ++n) for (int k = 0; k < 2; ++k) \
      acc[ai][bj][m][n] = __builtin_amdgcn_mfma_f32_16x16x32_f16(Bt_[n][k], At_[m][k], acc[ai][bj][m][n], 0, 0, 0); \
    __builtin_amdgcn_s_setprio(0); } while (0)
#define WAIT_V(n) asm volatile("s_waitcnt vmcnt(" #n ")" ::: "memory")
#define WAIT_L(n) asm volatile("s_waitcnt lgkmcnt(" #n ")" ::: "memory")
#define BAR __builtin_amdgcn_s_barrier()
#define SCHED __builtin_amdgcn_sched_barrier(0)
  const int tid = real_tid();
  const int G = gridDim.x;
  const int nwg = nM * nN;
  const int wid = tid >> 6, lane = tid & 63, wr = wid >> 2, wc = wid & 3, fr = lane & 15, fq = lane >> 4;
  const int nt = K / G_BK;
  unsigned voff;
  { int R0, C0; stage_rc(tid * 16, R0, C0); voff = (unsigned)((R0 * K + C0) * 2); }
  for (int L = real_bid(); L < nwg; L += G) {
    int wgid = L;
    { int q = nwg / 8, r = nwg % 8, xcd = wgid % 8, off = wgid / 8;
      wgid = (xcd < r ? xcd * (q + 1) : r * (q + 1) + (xcd - r) * q) + off; }
    const int nig = 4 * nN, gid = wgid / nig, fm = gid * 4, gsz = min(nM - fm, 4);
    const int pm = fm + ((wgid % nig) % gsz), pn = (wgid % nig) / gsz, brow = pm * G_BM, bcol = pn * G_BM;
    f32x4v acc[2][2][4][2];
#pragma unroll
    for (int a_ = 0; a_ < 2; a_++)
#pragma unroll
      for (int b_ = 0; b_ < 2; b_++)
#pragma unroll
        for (int m = 0; m < 4; m++)
#pragma unroll
          for (int n = 0; n < 2; n++) acc[a_][b_][m][n] = f32x4v{0.f, 0.f, 0.f, 0.f};
    h16x8 At[4][2], B0[2][2], B1[2][2];
    WAIT_V(0);
    __syncthreads();
    STAGE(SB(0, 0), Bt, bcol, 0); STAGE(SA(0, 0), A, brow, 0);
    STAGE(SB(0, 1), Bt, bcol + G_HALF, 0); STAGE(SA(0, 1), A, brow + G_HALF, 0);
    if (wr == 1) BAR;
    WAIT_V(4); BAR;
    STAGE(SB(1, 0), Bt, bcol, 1); STAGE(SA(1, 0), A, brow, 1); STAGE(SB(1, 1), Bt, bcol + G_HALF, 1);
    WAIT_V(6); BAR;
    for (int t = 0; t < nt - 2; t += 2) {
      LDB(B0, 0, 0); SCHED; LDA(At, 0, 0); STAGE(SA(1, 1), A, brow + G_HALF, t + 1);
      WAIT_L(8); BAR; WAIT_L(0); MMA(0, 0, At, B0); BAR; SCHED;
      LDB(B1, 0, 1); STAGE(SB(0, 0), Bt, bcol, t + 2);
      BAR; WAIT_L(0); MMA(0, 1, At, B1); BAR;
      LDA(At, 0, 1); STAGE(SA(0, 0), A, brow, t + 2);
      BAR; WAIT_L(0); MMA(1, 0, At, B0); BAR; SCHED;
      STAGE(SB(0, 1), Bt, bcol + G_HALF, t + 2);
      WAIT_V(6); BAR; MMA(1, 1, At, B1); BAR;
      LDB(B0, 1, 0); SCHED; LDA(At, 1, 0); STAGE(SA(0, 1), A, brow + G_HALF, t + 2);
      WAIT_L(8); BAR; WAIT_L(0); MMA(0, 0, At, B0); BAR; SCHED;
      LDB(B1, 1, 1); STAGE(SB(1, 0), Bt, bcol, t + 3);
      BAR; WAIT_L(0); MMA(0, 1, At, B1); BAR;
      LDA(At, 1, 1); STAGE(SA(1, 0), A, brow, t + 3);
      BAR; WAIT_L(0); MMA(1, 0, At, B0); BAR; SCHED;
      STAGE(SB(1, 1), Bt, bcol + G_HALF, t + 3);
      WAIT_V(6); BAR; MMA(1, 1, At, B1); BAR;
    }
    { LDB(B0, 0, 0); LDA(At, 0, 0); STAGE(SA(1, 1), A, brow + G_HALF, nt - 1);
      BAR; WAIT_L(0); MMA(0, 0, At, B0); BAR;
      LDB(B1, 0, 1); BAR; WAIT_L(0); MMA(0, 1, At, B1); BAR;
      LDA(At, 0, 1); WAIT_V(4); BAR; WAIT_L(0); MMA(1, 0, At, B0); MMA(1, 1, At, B1); BAR; }
    { LDB(B0, 1, 0); LDA(At, 1, 0); WAIT_V(2); BAR; WAIT_L(0); MMA(0, 0, At, B0); BAR;
      LDB(B1, 1, 1); WAIT_V(0); BAR; WAIT_L(0); MMA(0, 1, At, B1); BAR;
      LDA(At, 1, 1); BAR; WAIT_L(0); MMA(1, 0, At, B0); MMA(1, 1, At, B1); BAR; }
    if (wr == 0) BAR;
#pragma unroll
    for (int ai = 0; ai < 2; ++ai)
#pragma unroll
      for (int bj = 0; bj < 2; ++bj)
#pragma unroll
        for (int m = 0; m < 4; ++m) {
          const long row = brow + ai * G_HALF + wr * 64 + m * 16 + fr;
          if (EPI == 2) {
            const f32x4v g = acc[ai][bj][m][0], u = acc[ai][bj][m][1];
            const int col = (bcol >> 1) + bj * 64 + wc * 16 + fq * 4;
            h16x4 o;
#pragma unroll
            for (int j = 0; j < 4; ++j) o[j] = (h16)(silu_(g[j]) * u[j]);
            *(h16x4*)((h16*)Cout + row * ldc + col) = o;
          } else {
#pragma unroll
            for (int n = 0; n < 2; ++n) {
              const int col = bcol + bj * G_HALF + wc * 32 + n * 16 + fq * 4;
              if (EPI == 0) {
                *(f32x4v*)((float*)Cout + row * ldc + col) = acc[ai][bj][m][n];
              } else if (col < ncv) {
                h16x4 o;
#pragma unroll
                for (int j = 0; j < 4; ++j) o[j] = (h16)acc[ai][bj][m][n][j];
                *(h16x4*)((h16*)Cout + row * ldc + col) = o;
              }
            }
          }
        }
  }
#undef SA
#undef SB
}

#define TT 32
template <int MODE> struct ScanCfg;
template <> struct ScanCfg<0> { static constexpr int NF = 200, E = 2, NA = 3, VOFF = 192; };
template <> struct ScanCfg<1> { static constexpr int NF = 268, E = 4, NA = 4, VOFF = 256; };
template <> struct ScanCfg<2> { static constexpr int NF = 328, E = 2, NA = 5, VOFF = 320; };
typedef float f32x2 __attribute__((ext_vector_type(2)));

__device__ __forceinline__ float reduce32(float x) {
  x = reduce16(x);
  const unsigned xi = __float_as_uint(x);
  auto r = __builtin_amdgcn_permlane32_swap(xi, xi, false, false);
  return __uint_as_float(r[0]) + __uint_as_float(r[1]);
}

template <int MODE>
__device__ void scan_task(const Params& p, int task, char* smem, int dry) {
  constexpr int NF = ScanCfg<MODE>::NF, E = ScanCfg<MODE>::E, NA = ScanCfg<MODE>::NA, VOFF = ScanCfg<MODE>::VOFF;
  float* rec = (float*)smem;
  const int tid = get_tid(), lane = tid & 63, wave = tid >> 6;
  const int sub = (lane & 15) + ((lane >> 5) << 4), row = wave * 2 + ((lane >> 4) & 1);
  int b, h, rowbase;
  if (MODE == 2) { int bh = task >> 3; b = bh >> 3; h = bh & 7; rowbase = (task & 7) * 8; }
  else { int bh = task >> 4; b = bh >> 2; h = bh & 3; rowbase = (task & 15) * 8; }
  char* ws = p.ws;
  const size_t bS = (size_t)b * SEQ;

  const h16* src[NA];
  int dsto[NA];
  int ldm;
  const h16* srcv;
  int ldv;
  const int tokv = tid & 31;
  const int dstv = tokv * NF + VOFF;
  if (MODE == 0) {
    const int tok = tid >> 3, ch = tid & 7;
    const h16* P = (const h16*)(ws + OFF_BIG);
    src[0] = (const h16*)(ws + OFF_ELA) + (bS + tok) * 256 + h * 64 + ch * 8;
    src[1] = P + (bS + tok) * EINP + 256 + h * 64 + ch * 8;
    src[2] = P + (bS + tok) * EINP + h * 64 + ch * 8;
    for (int a = 0; a < NA; a++) dsto[a] = tok * NF + a * 64 + ch * 8;
    ldm = EINP;
    srcv = P + (bS + tokv) * EINP + 512 + h * 128 + rowbase; ldv = EINP;
  } else if (MODE == 1) {
    for (int a = 0; a < NA; a++) {
      const int idx = tid + (a & 1) * 256, tok = idx >> 4, ch = idx & 15;
      src[a] = (const h16*)(ws + (a < 2 ? OFF_GK : OFF_GQ)) + (bS + tok) * 512 + h * 128 + ch * 8;
      dsto[a] = tok * NF + (a < 2 ? 0 : 128) + ch * 8;
    }
    ldm = 512;
    srcv = (const h16*)(ws + OFF_GV) + (bS + tokv) * 512 + h * 128 + rowbase; ldv = 512;
  } else {
    const int tok = tid >> 3, ch = tid & 7;
    for (int a = 0; a < NA; a++) {
      const size_t off = a == 0 ? OFF_W16 : a == 1 ? OFF_KK : a == 2 ? OFF_KKA : a == 3 ? OFF_KP : OFF_R;
      src[a] = (const h16*)(ws + off) + (bS + tok) * 512 + h * 64 + ch * 8;
      dsto[a] = tok * NF + a * 64 + ch * 8;
    }
    ldm = 512;
    srcv = (const h16*)(ws + OFF_V) + (bS + tokv) * 512 + h * 64 + rowbase; ldv = 512;
  }
  const float* srcab = (const float*)(ws + OFF_AB) + ((bS + (tid & 31)) * 4 + h) * 2;

  h16* outp; int ldo;
  if (MODE == 0) { outp = (h16*)(ws + OFF_BIG) + 512 + h * 128 + rowbase; ldo = EINP; }
  else if (MODE == 1) { outp = (h16*)(ws + OFF_GV) + h * 128 + rowbase; ldo = 512; }
  else { outp = (h16*)(ws + OFF_V) + h * 64 + rowbase; ldo = 512; }
  outp += bS * ldo;

  float s[E];
#pragma unroll
  for (int e = 0; e < E; e++) s[e] = 0.f;

  u32x4 pre[NA];
  u32x4 prev = {0u, 0u, 0u, 0u};
  float pab0 = 0.f, pab1 = 0.f;
#pragma unroll
  for (int a = 0; a < NA; a++) pre[a] = *(const u32x4*)(src[a]);
  if (tid < 32) prev = *(const u32x4*)(srcv);
  if (MODE == 1 && tid < 32) { pab0 = srcab[0]; pab1 = srcab[1]; }

  for (int t0 = 0; t0 < SEQ; t0 += TT) {
#pragma unroll
    for (int a = 0; a < NA; a++) {
      h16x8 hv = __builtin_bit_cast(h16x8, pre[a]);
      float f[8];
#pragma unroll
      for (int j = 0; j < 8; j++) {
        float x = (float)hv[j];
        if (MODE == 0 && a == 0) x = __expf(x);
        if (MODE == 0 && a == 2) x *= 0.125f;
        if (MODE == 2 && a == 0) x = __expf(-__expf(x));
        f[j] = x;
      }
      f32x4 lo = {f[0], f[1], f[2], f[3]}, hi = {f[4], f[5], f[6], f[7]};
      *(f32x4*)(rec + dsto[a]) = lo;
      *(f32x4*)(rec + dsto[a] + 4) = hi;
    }
    if (tid < 32) {
      h16x8 hv = __builtin_bit_cast(h16x8, prev);
      f32x4 lo = {(float)hv[0], (float)hv[1], (float)hv[2], (float)hv[3]};
      f32x4 hi = {(float)hv[4], (float)hv[5], (float)hv[6], (float)hv[7]};
      *(f32x4*)(rec + dstv) = lo;
      *(f32x4*)(rec + dstv + 4) = hi;
    }
    if (MODE == 1 && tid < 32) { rec[tid * NF + 264] = pab0; rec[tid * NF + 265] = pab1; }
    LDS_BARRIER();
    if (t0 + TT < SEQ) {
      const size_t tn = (size_t)(t0 + TT);
#pragma unroll
      for (int a = 0; a < NA; a++) {
        const int ld = (MODE == 0 && a == 0) ? 256 : ldm;
        pre[a] = *(const u32x4*)(src[a] + tn * ld);
      }
      if (tid < 32) prev = *(const u32x4*)(srcv + tn * ldv);
      if (MODE == 1 && tid < 32) { pab0 = srcab[tn * 8]; pab1 = srcab[tn * 8 + 1]; }
    }
    float yk = 0.f;
#pragma unroll 1
    for (int hb = 0; hb < TT / 16; hb++) {
      float yp[16];
#pragma unroll
      for (int j = 0; j < 16; j++) {
        const float* rc = rec + (hb * 16 + j) * NF;
        float y;
        if (MODE == 0) {
          f32x2 W = *(const f32x2*)(rc + sub * 2);
          f32x2 Kv = *(const f32x2*)(rc + 64 + sub * 2);
          f32x2 R = *(const f32x2*)(rc + 128 + sub * 2);
          float v = rc[VOFF + row];
          s[0] = fmaf(v, Kv[0], s[0] * W[0]);
          s[1] = fmaf(v, Kv[1], s[1] * W[1]);
          y = s[0] * R[0] + s[1] * R[1];
        } else if (MODE == 1) {
          f32x4 Kv = *(const f32x4*)(rc + sub * 4);
          f32x4 R = *(const f32x4*)(rc + 128 + sub * 4);
          float v = rc[VOFF + row];
          f32x2 ab = *(const f32x2*)(rc + 264);
          const float al = ab[0], be = ab[1];
          float d = (s[0] * Kv[0] + s[1] * Kv[1]) + (s[2] * Kv[2] + s[3] * Kv[3]);
          d = reduce32(d);
          float c = be * (v - al * d);
#pragma unroll
          for (int e = 0; e < 4; e++) s[e] = fmaf(c, Kv[e], al * s[e]);
          y = (s[0] * R[0] + s[1] * R[1]) + (s[2] * R[2] + s[3] * R[3]);
        } else {
          f32x2 W = *(const f32x2*)(rc + sub * 2);
          f32x2 Pv = *(const f32x2*)(rc + 64 + sub * 2);
          f32x2 Av = *(const f32x2*)(rc + 128 + sub * 2);
          f32x2 Kv = *(const f32x2*)(rc + 192 + sub * 2);
          f32x2 R = *(const f32x2*)(rc + 256 + sub * 2);
          float v = rc[VOFF + row];
          float d = s[0] * Pv[0] + s[1] * Pv[1];
          d = reduce32(d);
          s[0] = fmaf(v, Kv[0], fmaf(-d, Av[0], s[0] * W[0]));
          s[1] = fmaf(v, Kv[1], fmaf(-d, Av[1], s[1] * W[1]));
          y = s[0] * R[0] + s[1] * R[1];
        }
        yp[j] = y;
      }
      {
        const bool b3 = (lane & 8) != 0, b2 = (lane & 4) != 0, b1 = (lane & 2) != 0, b0 = (lane & 1) != 0;
        float q8[8], q4[4], q2[2];
#pragma unroll
        for (int i = 0; i < 8; i++) {
          float keep = b3 ? yp[i + 8] : yp[i], send = b3 ? yp[i] : yp[i + 8];
          q8[i] = keep + dpp_f<0x140>(send);
        }
#pragma unroll
        for (int i = 0; i < 4; i++) {
          float keep = b2 ? q8[i + 4] : q8[i], send = b2 ? q8[i] : q8[i + 4];
          q4[i] = keep + dpp_f<0x141>(send);
        }
#pragma unroll
        for (int i = 0; i < 2; i++) {
          float keep = b1 ? q4[i + 2] : q4[i], send = b1 ? q4[i] : q4[i + 2];
          q2[i] = keep + dpp_f<0x4E>(send);
        }
        float keep = b0 ? q2[1] : q2[0], send = b0 ? q2[0] : q2[1];
        float q1 = keep + dpp_f<0xB1>(send);
        const unsigned qi = __float_as_uint(q1);
        auto r = __builtin_amdgcn_permlane32_swap(qi, qi, false, false);
        q1 = __uint_as_float(r[0]) + __uint_as_float(r[1]);
        yk = ((sub >> 4) == hb) ? q1 : yk;
      }
    }
    if (!dry) outp[(size_t)(t0 + sub) * ldo + row] = (h16)yk;
    LDS_BARRIER();
  }
}
#define SCAN_BARRIERS (2 * (SEQ / TT))

#define OFF_SUMA (OFF_BON + 1 * MIB)
#define OFF_SUMH (OFF_BON + 1 * MIB + 256 * 1024)
__device__ void lru_scan_task(const Params& p, int task, int dry) {
  const int tid = get_tid();
  const int half = task & 1, seg = (task >> 1) & 31, b = task >> 6;
  const int c = half * 256 + tid;
  const size_t base = ((size_t)b * SEQ + seg * 256) * 512 + c;
  h16* la = (h16*)(p.ws + OFF_LLA) + base;
  h16* bb = (h16*)(p.ws + OFF_LB) + base;
  float hs = 0.f, ap = 1.f;
  h16 na[16], nb[16];
#pragma unroll
  for (int i = 0; i < 16; i++) { na[i] = la[(size_t)i * 512]; nb[i] = bb[(size_t)i * 512]; }
  for (int t0 = 0; t0 < 256; t0 += 16) {
    h16 ca[16], cb[16];
#pragma unroll
    for (int i = 0; i < 16; i++) { ca[i] = na[i]; cb[i] = nb[i]; }
    if (t0 + 16 < 256) {
#pragma unroll
      for (int i = 0; i < 16; i++) { na[i] = la[(size_t)(t0 + 16 + i) * 512]; nb[i] = bb[(size_t)(t0 + 16 + i) * 512]; }
    }
#pragma unroll
    for (int i = 0; i < 16; i++) {
      float a = __expf((float)ca[i]);
      hs = fmaf(a, hs, (float)cb[i]);
      ap *= a;
      if (!dry) { bb[(size_t)(t0 + i) * 512] = (h16)hs;
      la[(size_t)(t0 + i) * 512] = (h16)ap; }
    }
  }
  if (!dry) { ((float*)(p.ws + OFF_SUMA))[(b * 32 + seg) * 512 + c] = ap;
  ((float*)(p.ws + OFF_SUMH))[(b * 32 + seg) * 512 + c] = hs; }
}

#define PR_NF 600
__device__ __forceinline__ float treduce16(const float (&yp)[16], int lane) {
  const bool b3 = (lane & 8) != 0, b2 = (lane & 4) != 0, b1 = (lane & 2) != 0, b0 = (lane & 1) != 0;
  float q8[8], q4[4], q2[2];
#pragma unroll
  for (int i = 0; i < 8; i++) { float keep = b3 ? yp[i + 8] : yp[i], send = b3 ? yp[i] : yp[i + 8]; q8[i] = keep + dpp_f<0x140>(send); }
#pragma unroll
  for (int i = 0; i < 4; i++) { float keep = b2 ? q8[i + 4] : q8[i], send = b2 ? q8[i] : q8[i + 4]; q4[i] = keep + dpp_f<0x141>(send); }
#pragma unroll
  for (int i = 0; i < 2; i++) { float keep = b1 ? q4[i + 2] : q4[i], send = b1 ? q4[i] : q4[i + 2]; q2[i] = keep + dpp_f<0x4E>(send); }
  float keep = b0 ? q2[1] : q2[0], send = b0 ? q2[0] : q2[1];
  float q1 = keep + dpp_f<0xB1>(send);
  const unsigned qi = __float_as_uint(q1);
  auto r = __builtin_amdgcn_permlane32_swap(qi, qi, false, false);
  return __uint_as_float(r[0]) + __uint_as_float(r[1]);
}

__device__ void lru_scan_task(const Params& p, int task, int dry);

__device__ void rwkv_scan_pc(const Params& p, int blk, char* gsm, int dry) {
  const int rtid = real_tid();
  const int vb = __builtin_amdgcn_readfirstlane(rtid >> 8), tid = rtid & 255, lane = tid & 63, wave = tid >> 6;
  float* bufs = (float*)gsm;
  const int tsk_ = ((blk & 7) * 4 + ((blk >> 3) >> 3)) * 8 + ((blk >> 3) & 7);
  const int bh = tsk_ >> 3, b = bh >> 3, h = bh & 7, rowbase = (tsk_ & 7) * 8;
  const size_t bS = (size_t)b * SEQ;
  char* ws = p.ws;
  if (vb == 1) {
    const int pair = tid >> 4, l15 = tid & 15, c4 = l15 * 4;
    const size_t cofs = (size_t)h * 64 + c4;
    const h16* aW = (const h16*)(ws + OFF_W16) + cofs;
    const h16* aP = (const h16*)(ws + OFF_KK) + cofs;
    const h16* aA = (const h16*)(ws + OFF_KKA) + cofs;
    const h16* aK = (const h16*)(ws + OFF_KP) + cofs;
    const h16* aR = (const h16*)(ws + OFF_R) + cofs;
    const h16* aV = (const h16*)(ws + OFF_V) + (size_t)h * 64 + rowbase;
    const int lhalf = blk & 1, lseg = (blk >> 1) & 31, lb_ = blk >> 6;
    const int lc = lhalf * 256 + tid;
    const size_t lbase = ((size_t)lb_ * SEQ + lseg * 256) * 512 + lc;
    h16* lla = (h16*)(ws + OFF_LLA) + lbase;
    h16* lbb = (h16*)(ws + OFF_LB) + lbase;
    float lhs = 0.f, lap = 1.f;
    h16x4 nw1, nw2, np1, np2, na1, na2, nk1, nk2, nr1, nr2;
    h16x8 nv1, nv2;
    {
      const size_t tok = bS + pair * 2;
      nw1 = *(const h16x4*)(aW + tok * 512); nw2 = *(const h16x4*)(aW + (tok + 1) * 512);
      np1 = *(const h16x4*)(aP + tok * 512); np2 = *(const h16x4*)(aP + (tok + 1) * 512);
      na1 = *(const h16x4*)(aA + tok * 512); na2 = *(const h16x4*)(aA + (tok + 1) * 512);
      nk1 = *(const h16x4*)(aK + tok * 512); nk2 = *(const h16x4*)(aK + (tok + 1) * 512);
      nr1 = *(const h16x4*)(aR + tok * 512); nr2 = *(const h16x4*)(aR + (tok + 1) * 512);
      if (l15 == 1) { nv1 = *(const h16x8*)(aV + tok * 512); nv2 = *(const h16x8*)(aV + (tok + 1) * 512); }
    }
#pragma unroll 1
    for (int tile = 0; tile < SEQ / 32; tile++) {
      const h16x4 hw1 = nw1, hw2 = nw2, hp1 = np1, hp2 = np2, ha1 = na1, ha2 = na2, hk1 = nk1, hk2 = nk2, hr1 = nr1, hr2 = nr2;
      const h16x8 hv1 = nv1, hv2 = nv2;
      const h16 l_a = lla[(size_t)tile * 512], l_b = lbb[(size_t)tile * 512];
      if (tile + 1 < SEQ / 32) {
        const size_t tok = bS + (size_t)(tile + 1) * 32 + pair * 2;
        nw1 = *(const h16x4*)(aW + tok * 512); nw2 = *(const h16x4*)(aW + (tok + 1) * 512);
        np1 = *(const h16x4*)(aP + tok * 512); np2 = *(const h16x4*)(aP + (tok + 1) * 512);
        na1 = *(const h16x4*)(aA + tok * 512); na2 = *(const h16x4*)(aA + (tok + 1) * 512);
        nk1 = *(const h16x4*)(aK + tok * 512); nk2 = *(const h16x4*)(aK + (tok + 1) * 512);
        nr1 = *(const h16x4*)(aR + tok * 512); nr2 = *(const h16x4*)(aR + (tok + 1) * 512);
        if (l15 == 1) { nv1 = *(const h16x8*)(aV + tok * 512); nv2 = *(const h16x8*)(aV + (tok + 1) * 512); }
      }
      f32x4 P1, P2p, R1p, R2p, W12, AW, KW, A2, K2;
      float sc[8];
#pragma unroll
      for (int e = 0; e < 8; e++) sc[e] = 0.f;
#pragma unroll
      for (int e = 0; e < 4; e++) {
        const float W1 = __expf(-__expf((float)hw1[e])), W2 = __expf(-__expf((float)hw2[e]));
        const float p1 = (float)hp1[e], p2 = (float)hp2[e], a1 = (float)ha1[e], a2 = (float)ha2[e];
        const float k1 = (float)hk1[e], k2 = (float)hk2[e], r1 = (float)hr1[e], r2 = (float)hr2[e];
        const float w12 = W1 * W2, aw = a1 * W2, kw = k1 * W2;
        P1[e] = p1; P2p[e] = W1 * p2; R1p[e] = W1 * r1; R2p[e] = w12 * r2; W12[e] = w12; AW[e] = aw; KW[e] = kw; A2[e] = a2; K2[e] = k2;
        sc[0] += a1 * p2; sc[1] += k1 * p2; sc[2] += a1 * r1; sc[3] += k1 * r1;
        sc[4] += aw * r2; sc[5] += kw * r2; sc[6] += a2 * r2; sc[7] += k2 * r2;
      }
#pragma unroll
      for (int e = 0; e < 8; e++) sc[e] = reduce16(sc[e]);
      float* rec = bufs + (tile & 1) * (16 * PR_NF) + pair * PR_NF;
      *(f32x4*)(rec + c4) = P1;        *(f32x4*)(rec + 64 + c4) = P2p;  *(f32x4*)(rec + 128 + c4) = R1p;
      *(f32x4*)(rec + 192 + c4) = R2p; *(f32x4*)(rec + 256 + c4) = W12; *(f32x4*)(rec + 320 + c4) = AW;
      *(f32x4*)(rec + 384 + c4) = KW;  *(f32x4*)(rec + 448 + c4) = A2;  *(f32x4*)(rec + 512 + c4) = K2;
      if (l15 == 0) {
        f32x4 s0 = {sc[0], sc[1], sc[2], sc[3]}, s1 = {sc[4], sc[5], sc[6], sc[7]};
        *(f32x4*)(rec + 576) = s0; *(f32x4*)(rec + 580) = s1;
      }
      if (l15 == 1) {
#pragma unroll
        for (int r = 0; r < 8; r++) { rec[584 + r] = (float)hv1[r]; rec[592 + r] = (float)hv2[r]; }
      }
      {
        const float a_ = __expf((float)l_a);
        lhs = fmaf(a_, lhs, (float)l_b);
        lap *= a_;
        if (!dry) { lbb[(size_t)tile * 512] = (h16)lhs; lla[(size_t)tile * 512] = (h16)lap; }
      }
      LDS_BARRIER();
    }
    LDS_BARRIER();
    if (!dry) {
      ((float*)(ws + OFF_SUMA))[(lb_ * 32 + lseg) * 512 + lc] = lap;
      ((float*)(ws + OFF_SUMH))[(lb_ * 32 + lseg) * 512 + lc] = lhs;
    }
  } else {
    const int sub = (lane & 15) + ((lane >> 5) << 4), row = wave * 2 + ((lane >> 4) & 1);
    const float m0 = (sub == 0) ? 1.f : 0.f;
    h16* outp = (h16*)(ws + OFF_V) + bS * 512 + (size_t)h * 64 + rowbase;
    f32x2 s = {0.f, 0.f};
    LDS_BARRIER();
#pragma unroll 1
    for (int tile = 0; tile < SEQ / 32; tile++) {
      const float* recb = bufs + (tile & 1) * (16 * PR_NF);
      float yk = 0.f;
#pragma unroll 1
      for (int hb = 0; hb < 2; hb++) {
        float yp[16];
        f32x2 nP1, nP2p, nR1p, nR2p, nW12, nAW, nKW, nA2, nK2; f32x4 nc0, nc1; float nv1, nv2;
        {
          const float* rc = recb + (hb * 8) * PR_NF;
          nP1 = *(const f32x2*)(rc + sub * 2); nP2p = *(const f32x2*)(rc + 64 + sub * 2);
          nR1p = *(const f32x2*)(rc + 128 + sub * 2); nR2p = *(const f32x2*)(rc + 192 + sub * 2);
          nW12 = *(const f32x2*)(rc + 256 + sub * 2); nAW = *(const f32x2*)(rc + 320 + sub * 2);
          nKW = *(const f32x2*)(rc + 384 + sub * 2); nA2 = *(const f32x2*)(rc + 448 + sub * 2); nK2 = *(const f32x2*)(rc + 512 + sub * 2);
          nc0 = *(const f32x4*)(rc + 576); nc1 = *(const f32x4*)(rc + 580);
          nv1 = rc[584 + row]; nv2 = rc[592 + row];
        }
#pragma unroll
        for (int jp = 0; jp < 8; jp++) {
          const f32x2 P1 = nP1, P2p = nP2p, R1p = nR1p, R2p = nR2p, W12 = nW12, AW = nAW, KW = nKW, A2 = nA2, K2 = nK2;
          const f32x4 c0 = nc0, c1 = nc1;
          const float v1 = nv1, v2 = nv2;
          if (jp + 1 < 8) {
            const float* rc = recb + (hb * 8 + jp + 1) * PR_NF;
            nP1 = *(const f32x2*)(rc + sub * 2); nP2p = *(const f32x2*)(rc + 64 + sub * 2);
            nR1p = *(const f32x2*)(rc + 128 + sub * 2); nR2p = *(const f32x2*)(rc + 192 + sub * 2);
            nW12 = *(const f32x2*)(rc + 256 + sub * 2); nAW = *(const f32x2*)(rc + 320 + sub * 2);
            nKW = *(const f32x2*)(rc + 384 + sub * 2); nA2 = *(const f32x2*)(rc + 448 + sub * 2); nK2 = *(const f32x2*)(rc + 512 + sub * 2);
            nc0 = *(const f32x4*)(rc + 576); nc1 = *(const f32x4*)(rc + 580);
            nv1 = rc[584 + row]; nv2 = rc[592 + row];
          }
          float d1 = s[0] * P1[0] + s[1] * P1[1];
          float d2 = s[0] * P2p[0] + s[1] * P2p[1];
          float y1 = s[0] * R1p[0] + s[1] * R1p[1];
          float y2 = s[0] * R2p[0] + s[1] * R2p[1];
          d1 += dpp_f<0xB1>(d1); d2 += dpp_f<0xB1>(d2);
          d1 += dpp_f<0x4E>(d1); d2 += dpp_f<0x4E>(d2);
          d1 += dpp_f<0x141>(d1); d2 += dpp_f<0x141>(d2);
          d1 += dpp_f<0x140>(d1); d2 += dpp_f<0x140>(d2);
          {
            auto r1 = __builtin_amdgcn_permlane32_swap(__float_as_uint(d1), __float_as_uint(d1), false, false);
            auto r2 = __builtin_amdgcn_permlane32_swap(__float_as_uint(d2), __float_as_uint(d2), false, false);
            d1 = __uint_as_float(r1[0]) + __uint_as_float(r1[1]);
            d2 = __uint_as_float(r2[0]) + __uint_as_float(r2[1]);
          }
          d2 = d2 - d1 * c0[0] + v1 * c0[1];
          const f32x2 base = s * W12 + (f32x2{v1, v1} * KW - f32x2{d1, d1} * AW);
          s = base + (f32x2{v2, v2} * K2 - f32x2{d2, d2} * A2);
          y1 += m0 * (v1 * c0[3] - d1 * c0[2]);
          y2 += m0 * (v1 * c1[1] - d1 * c1[0] + v2 * c1[3] - d2 * c1[2]);
          yp[2 * jp] = y1; yp[2 * jp + 1] = y2;
        }
        const float q1 = treduce16(yp, lane);
        yk = ((sub >> 4) == hb) ? q1 : yk;
      }
      if (!dry) outp[(size_t)(tile * 32 + sub) * 512 + row] = (h16)yk;
      LDS_BARRIER();
    }
  }
}

__device__ void even_pre(const Params& p, char* smem) {
  const int tid = get_tid(), lane = tid & 63, wave = tid >> 6;
  const h16* P = (const h16*)(p.ws + OFF_BIG);
  for (int blk = get_bid(); blk < MTOK / 64; blk += VGRID) {
    const int tgs = blk * 64;
    const int t0 = tgs & (SEQ - 1);
    if (wave < 3) {
      const int c0 = wave * 512 + lane * 8;
      const float* cw = p.in[10];
      float cwr[4][8];
#pragma unroll
      for (int j = 0; j < 4; j++) {
        f32x4 x0 = *(const f32x4*)(cw + j * 1536 + c0), x1 = *(const f32x4*)(cw + j * 1536 + c0 + 4);
#pragma unroll
        for (int e = 0; e < 4; e++) { cwr[j][e] = x0[e]; cwr[j][4 + e] = x1[e]; }
      }
      h16* dst = (h16*)(p.ws + (wave == 0 ? OFF_GQ : wave == 1 ? OFF_GK : OFF_GV)) + lane * 8;
      const h16* src = P + 1552 + c0;
      h16x8 xm[3];
#pragma unroll
      for (int j = 0; j < 3; j++) {
#pragma unroll
        for (int e = 0; e < 8; e++) xm[j][e] = (h16)0.f;
        if (t0 > 0) xm[j] = *(const h16x8*)(src + (size_t)(tgs - 3 + j) * EINP);
      }
      const float qs = (wave == 0) ? 0.08838834764831845f : 1.f;
#pragma unroll 1
      for (int tb = 0; tb < 64; tb += 4) {
        h16x8 xn[4];
#pragma unroll
        for (int u = 0; u < 4; u++) xn[u] = *(const h16x8*)(src + (size_t)(tgs + tb + u) * EINP);
#pragma unroll
        for (int u = 0; u < 4; u++) {
          float val[8];
          float ss = 0.f;
#pragma unroll
          for (int e = 0; e < 8; e++) {
            float v = (float)xm[0][e] * cwr[0][e] + (float)xm[1][e] * cwr[1][e] + (float)xm[2][e] * cwr[2][e] + (float)xn[u][e] * cwr[3][e];
            v = silu_(v);
            val[e] = v;
            ss += v * v;
          }
          float sc = 1.f;
          if (wave < 2) { ss = reduce16(ss); sc = rsqrtf(ss + 1e-6f) * qs; }
          h16x8 o;
#pragma unroll
          for (int e = 0; e < 8; e++) o[e] = (h16)(val[e] * sc);
          *(h16x8*)(dst + (size_t)(tgs + tb + u) * 512) = o;
          xm[0] = xm[1]; xm[1] = xm[2]; xm[2] = xn[u];
        }
      }
    } else {
      const int c4 = lane * 4;
      const float* w2 = p.in[7];
      float w2r[16][4];
#pragma unroll
      for (int j = 0; j < 16; j++) {
        f32x4 x0 = *(const f32x4*)(w2 + j * 256 + c4);
#pragma unroll
        for (int e = 0; e < 4; e++) w2r[j][e] = x0[e];
      }
      const f32x4 lb4 = *(const f32x4*)(p.in[8] + c4);
      h16* ELA = (h16*)(p.ws + OFF_ELA);
      float* AB = (float*)(p.ws + OFF_AB);
      const float alog = (lane < 4) ? p.in[11][lane] : 0.f, dtb = (lane < 4) ? p.in[12][lane] : 0.f;
#pragma unroll 2
      for (int tok = 0; tok < 64; tok++) {
        const size_t tg = (size_t)tgs + tok;
        const h16* pr = P + tg * EINP + 1536;
        h16x8 g0 = *(const h16x8*)(pr), g1 = *(const h16x8*)(pr + 8);
        float z[4] = {lb4[0], lb4[1], lb4[2], lb4[3]};
#pragma unroll
        for (int j = 0; j < 16; j++) {
          const float gj = (float)(j < 8 ? g0[j] : g1[j - 8]);
#pragma unroll
          for (int e = 0; e < 4; e++) z[e] = fmaf(gj, w2r[j][e], z[e]);
        }
        h16x4 o;
#pragma unroll
        for (int e = 0; e < 4; e++) o[e] = (h16)(-softplus_(-z[e]) * (1.f / 16.f));
        *(h16x4*)(ELA + tg * 256 + c4) = o;
        if (lane < 4) {
          float da = (float)P[tg * EINP + 3600 + lane];
          float db = (float)P[tg * EINP + 3604 + lane];
          float g = -__expf(alog) * softplus_(da + dtb);
          AB[(tg * 4 + lane) * 2 + 0] = __expf(g);
          AB[(tg * 4 + lane) * 2 + 1] = sigm(db);
        }
      }
    }
  }
}

__device__ void even_post(const Params& p) {
  const int lane = get_tid() & 63;
  const int gw = get_bid() * 4 + (get_tid() >> 6);
  const int nw = VGRID * 4;
  const int half = gw & 1, c8 = lane * 8;
  const h16* __restrict__ P = (const h16*)(p.ws + OFF_BIG);
  const h16* __restrict__ GV = (const h16*)(p.ws + OFF_GV);
  h16* __restrict__ Y = (h16*)(p.ws + OFF_HH);
  const float* nwp = (half ? p.in[13] : p.in[9]) + (c8 & 127);
  float wn[8];
#pragma unroll
  for (int e = 0; e < 8; e++) wn[e] = nwp[e];
  const int tstep = nw >> 1;
  for (int tg = gw >> 1; tg < MTOK; tg += 2 * tstep) {
    h16x8 o[2], z[2];
#pragma unroll
    for (int u = 0; u < 2; u++) {
      const int t = tg + u * tstep;
      if (t < MTOK) {
        const h16* pr = P + (size_t)t * EINP;
        o[u] = half ? *(const h16x8*)(GV + (size_t)t * 512 + c8) : *(const h16x8*)(pr + 512 + c8);
        z[u] = *(const h16x8*)(pr + (half ? 3088 : 1024) + c8);
      }
    }
#pragma unroll
    for (int u = 0; u < 2; u++) {
      const int t = tg + u * tstep;
      if (t < MTOK) {
        float of[8], ss = 0.f;
#pragma unroll
        for (int e = 0; e < 8; e++) { of[e] = (float)o[u][e]; ss += of[e] * of[e]; }
        ss = reduce16(ss);
        const float inv = rsqrtf(ss * (1.f / 128.f) + 1e-6f);
        h16x8 r;
#pragma unroll
        for (int e = 0; e < 8; e++) r[e] = (h16)(of[e] * inv * wn[e] * silu_((float)z[u][e]));
        *(h16x8*)(Y + (size_t)t * DM + half * 512 + c8) = r;
      }
    }
  }
}

__device__ __forceinline__ float psmix(const h16* __restrict__ P, const float* __restrict__ mu, size_t tg, int t, int c) {
  float cur = (float)P[tg * OIN + c];
  float prev = (t > 0) ? (float)P[(tg - 1) * OIN + c] : 0.f;
  return cur + (prev - cur) * mu[c];
}
__device__ __forceinline__ float psmixm(const h16* __restrict__ P, float m, size_t tg, int t, int c) {
  float cur = (float)P[tg * OIN + c];
  float prev = (t > 0) ? (float)P[(tg - 1) * OIN + c] : 0.f;
  return cur + (prev - cur) * m;
}
__device__ __forceinline__ void psmix8(const h16* __restrict__ P, const float* __restrict__ mu, size_t tg, int t, int c0, float* o) {
  h16x8 cur = *(const h16x8*)(P + tg * OIN + c0);
  h16x8 prv = cur;
  if (t > 0) prv = *(const h16x8*)(P + (tg - 1) * OIN + c0);
  f32x4 m0 = *(const f32x4*)(mu + c0), m1 = *(const f32x4*)(mu + c0 + 4);
#pragma unroll
  for (int j = 0; j < 8; j++) {
    float cf = (float)cur[j];
    float pf = (t > 0) ? (float)prv[j] : 0.f;
    o[j] = cf + (pf - cf) * (j < 4 ? m0[j] : m1[j - 4]);
  }
}
__device__ __forceinline__ float half_sum(float x, int lane) {
  x = reduce16(x);
  const unsigned xi = __float_as_uint(x);
  auto r = __builtin_amdgcn_permlane16_swap(xi, xi, false, false);
  return __uint_as_float(r[0]) + __uint_as_float(r[1]);
}

#define OFF_SW (483 * MIB)
#define SW_W2T 0
#define SW_A2T 32768
#define SW_WAT 65536
#define SW_WXT 98304
#define SW_G2T 131072
__device__ void convert_small(const Params& p) {
  h16* sw = (h16*)(p.ws + OFF_SW);
  for (int idx = get_bid() * 256 + get_tid(); idx < 196608; idx += VGRID * 256) {
    float v;
    if (idx < 131072) {
      const int which = idx >> 15, n = (idx >> 6) & 511, k = idx & 63;
      if (which == 0) v = p.in[18][k * 512 + n];
      else if (which == 1) v = p.in[20][k * 512 + n];
      else if (which == 2) v = p.in[29][((n >> 6) * 64 + k) * 64 + (n & 63)];
      else v = p.in[31][((n >> 6) * 64 + k) * 64 + (n & 63)];
    } else {
      const int j = idx - 131072, n = j >> 7, k = j & 127;
      v = p.in[21][k * 512 + n];
    }
    sw[idx] = (h16)v;
  }
}

#define TLD 136
__device__ void odd_pre(const Params& p, char* smem) {
  const int tid = get_tid(), lane = tid & 63, wave = tid >> 6;
  const int l31 = lane & 31, lh = lane >> 5;
  const h16* P = (const h16*)(p.ws + OFF_BIG);
  const float* mu = p.in[16];
  const h16* sw = (const h16*)(p.ws + OFF_SW);
  for (int job = get_bid(); job < 2048; job += VGRID) {
    if (job < 1024) {
#ifndef NO_RWKVPRE
      const int tg0 = job * 32, t0 = tg0 & (SEQ - 1);
      h16* AL = (h16*)smem;
#pragma unroll
      for (int i = 0; i < 2; i++) {
        const int e = tid + i * 256, tok = e >> 4, ch = e & 15;
        float o[8];
        psmix8(P, mu, (size_t)tg0 + tok, t0 + tok, 1536 + ch * 8, o);
        h16x8 hv;
#pragma unroll
        for (int j = 0; j < 8; j++) hv[j] = (h16)(ch < 8 ? fast_tanh(o[j]) : o[j]);
        *(h16x8*)(AL + tok * TLD + ch * 8) = hv;
      }
      LDS_BARRIER();
      h16* W16 = (h16*)(p.ws + OFF_W16);
      h16* KK = (h16*)(p.ws + OFF_KK);
      h16* KKA = (h16*)(p.ws + OFF_KKA);
      h16* KP = (h16*)(p.ws + OFF_KP);
      h16* RR = (h16*)(p.ws + OFF_R);
      h16* VV = (h16*)(p.ws + OFF_V);
      float* BON = (float*)(p.ws + OFF_BON);
#pragma unroll 1
      for (int hh = 0; hh < 2; hh++) {
        const int head = wave * 2 + hh;
        f32x16 accw[2], acca[2];
#pragma unroll
        for (int n = 0; n < 2; n++)
#pragma unroll
          for (int r = 0; r < 16; r++) { accw[n][r] = 0.f; acca[n][r] = 0.f; }
#pragma unroll
        for (int ks = 0; ks < 4; ks++) {
          h16x8 aw = *(const h16x8*)(AL + l31 * TLD + ks * 16 + lh * 8);
          h16x8 aa = *(const h16x8*)(AL + l31 * TLD + 64 + ks * 16 + lh * 8);
#pragma unroll
          for (int q = 0; q < 2; q++) {
            const int n = wave * 128 + (hh * 2 + q) * 32 + l31;
            h16x8 bw = *(const h16x8*)(sw + SW_W2T + n * 64 + ks * 16 + lh * 8);
            h16x8 ba = *(const h16x8*)(sw + SW_A2T + n * 64 + ks * 16 + lh * 8);
            accw[q] = __builtin_amdgcn_mfma_f32_32x32x16_f16(aw, bw, accw[q], 0, 0, 0);
            acca[q] = __builtin_amdgcn_mfma_f32_32x32x16_f16(aa, ba, acca[q], 0, 0, 0);
          }
        }
        float w0c[2], a0c[2], kkc[2], kac[2], rkc[2], mur[2], muk[2], muv[2];
#pragma unroll
        for (int q = 0; q < 2; q++) {
          const int c = wave * 128 + (hh * 2 + q) * 32 + l31;
          w0c[q] = p.in[17][c]; a0c[q] = p.in[19][c]; kkc[q] = p.in[22][c]; kac[q] = p.in[23][c]; rkc[q] = p.in[24][c];
          mur[q] = mu[c]; muk[q] = mu[512 + c]; muv[q] = mu[1024 + c];
        }
        int tgb = tg0;
#pragma unroll
        for (int r = 0; r < 16; r++) {
          if ((r & 3) == 0) asm volatile("" : "+s"(tgb));
          const int tr = (r & 3) + 8 * (r >> 2) + 4 * lh;
          const size_t tg = (size_t)tgb + tr;
          const int t = (tgb & (SEQ - 1)) + tr;
          float kr[2], av[2];
          float ssp = 0.f, bonp = 0.f;
#pragma unroll
          for (int q = 0; q < 2; q++) {
            const int nt = hh * 2 + q;
            const int c = wave * 128 + nt * 32 + l31;
            float r_ = psmixm(P, mur[q], tg, t, c);
            float k_ = psmixm(P, muk[q], tg, t, 512 + c);
            float v_ = psmixm(P, muv[q], tg, t, 1024 + c);
            float w = -softplus_(-(w0c[q] + accw[q][r])) - 0.5f;
            float a = sigm(a0c[q] + acca[q][r]);
            kr[q] = k_ * kkc[q];
            av[q] = a;
            float kp = k_ * (1.f + (a - 1.f) * kac[q]);
            ssp += kr[q] * kr[q];
            bonp += r_ * kp * rkc[q];
            W16[tg * 512 + c] = (h16)w;
            KP[tg * 512 + c] = (h16)kp;
            RR[tg * 512 + c] = (h16)r_;
            VV[tg * 512 + c] = (h16)v_;
          }
          const float ss = half_sum(ssp, lane);
          const float bon = half_sum(bonp, lane);
          const float inv = rsqrtf(ss + 1e-6f);
#pragma unroll
          for (int q = 0; q < 2; q++) {
            const int c = wave * 128 + (hh * 2 + q) * 32 + l31;
            const float kk = kr[q] * inv;
            KK[tg * 512 + c] = (h16)kk;
            KKA[tg * 512 + c] = (h16)(kk * av[q]);
          }
          if (l31 == 0) BON[tg * 8 + head] = bon;
          if ((r & 3) == 3) asm volatile("" ::: "memory");
        }
      }
      LDS_BARRIER();
#endif
    } else {
#ifndef NO_LRUPRE
      const int tg0 = (job - 1024) * 32, t0 = tg0 & (SEQ - 1);
      h16* XB = (h16*)smem + wave * (32 * TLD);
      {
        const int ch = lane & 15, tq = lane >> 4;
        const int c0 = wave * 128 + ch * 8;
        const float* cw = p.in[27];
        float cwr[4][8], cbr[8];
#pragma unroll
        for (int j = 0; j < 4; j++) {
          f32x4 x0 = *(const f32x4*)(cw + j * 512 + c0), x1 = *(const f32x4*)(cw + j * 512 + c0 + 4);
#pragma unroll
          for (int e = 0; e < 4; e++) { cwr[j][e] = x0[e]; cwr[j][4 + e] = x1[e]; }
        }
        {
          f32x4 x0 = *(const f32x4*)(p.in[28] + c0), x1 = *(const f32x4*)(p.in[28] + c0 + 4);
#pragma unroll
          for (int e = 0; e < 4; e++) { cbr[e] = x0[e]; cbr[4 + e] = x1[e]; }
        }
        h16x8 x[11];
#pragma unroll
        for (int j = 0; j < 11; j++) {
          const int tt = tq * 8 - 3 + j;
          h16x8 z;
#pragma unroll
          for (int e = 0; e < 8; e++) z[e] = (h16)0.f;
          x[j] = z;
          if (t0 + tt >= 0) x[j] = *(const h16x8*)(P + (size_t)((long)tg0 + tt) * OIN + 1792 + c0);
        }
#pragma unroll
        for (int tok = 0; tok < 8; tok++) {
          h16x8 hv;
#pragma unroll
          for (int e = 0; e < 8; e++) {
            float xb = cbr[e] + (float)x[tok][e] * cwr[0][e] + (float)x[tok + 1][e] * cwr[1][e] +
                       (float)x[tok + 2][e] * cwr[2][e] + (float)x[tok + 3][e] * cwr[3][e];
            hv[e] = (h16)xb;
          }
          *(h16x8*)(XB + (tq * 8 + tok) * TLD + ch * 8) = hv;
        }
      }
      LDS_BARRIER();
      h16* LLA = (h16*)(p.ws + OFF_LLA);
      h16* LB = (h16*)(p.ws + OFF_LB);
#pragma unroll 1
      for (int blk = 0; blk < 2; blk++) {
        f32x16 accr[2], acci[2];
#pragma unroll
        for (int n = 0; n < 2; n++)
#pragma unroll
          for (int r = 0; r < 16; r++) { accr[n][r] = 0.f; acci[n][r] = 0.f; }
#pragma unroll
        for (int ks = 0; ks < 4; ks++) {
          h16x8 a = *(const h16x8*)(XB + l31 * TLD + blk * 64 + ks * 16 + lh * 8);
#pragma unroll
          for (int q = 0; q < 2; q++) {
            const int n = wave * 128 + (blk * 2 + q) * 32 + l31;
            h16x8 br, bi;
#pragma unroll
            for (int j = 0; j < 8; j++) {
              br[j] = (h16)p.in[29][((n >> 6) * 64 + ks * 16 + lh * 8 + j) * 64 + (n & 63)];
              bi[j] = (h16)p.in[31][((n >> 6) * 64 + ks * 16 + lh * 8 + j) * 64 + (n & 63)];
            }
            accr[q] = __builtin_amdgcn_mfma_f32_32x32x16_f16(a, br, accr[q], 0, 0, 0);
            acci[q] = __builtin_amdgcn_mfma_f32_32x32x16_f16(a, bi, acci[q], 0, 0, 0);
          }
        }
#pragma unroll
        for (int q = 0; q < 2; q++) {
          const int nt = blk * 2 + q;
          const int c = wave * 128 + nt * 32 + l31;
          const float bac = p.in[30][c], bxc = p.in[32][c];
          const float spl = softplus_(-p.in[33][c]);
          int tgb = tg0;
#pragma unroll
          for (int r = 0; r < 16; r++) {
            if ((r & 7) == 0) asm volatile("" : "+s"(tgb));
            const int tr = (r & 3) + 8 * (r >> 2) + 4 * lh;
            const size_t tg = (size_t)tgb + tr;
            float gr = sigm(accr[q][r] + bac);
            float gi = sigm(acci[q][r] + bxc);
            float la = -8.f * gr * spl;
            float mult = __builtin_amdgcn_sqrtf(fmaxf(1.f - __expf(2.f * la), 0.f));
            float xbv = (float)XB[tr * TLD + nt * 32 + l31];
            LLA[tg * 512 + c] = (h16)la;
            LB[tg * 512 + c] = (h16)(mult * gi * xbv);
            if ((r & 7) == 7) asm volatile("" ::: "memory");
          }
        }
      }
      LDS_BARRIER();
#endif
    }
  }
}

__device__ void odd_post(const Params& p, char* smem) {
  const int tid = get_tid(), lane = tid & 63, wave = tid >> 6;
  const int l31 = lane & 31, lh = lane >> 5;
  const h16* P = (const h16*)(p.ws + OFF_BIG);
  const float* mu = p.in[16];
  const h16* G2T = (const h16*)(p.ws + OFF_SW) + SW_G2T;
  const h16* YS = (const h16*)(p.ws + OFF_V);
  const h16* HL = (const h16*)(p.ws + OFF_LB);
  const h16* CA = (const h16*)(p.ws + OFF_LLA);
  const float* BON = (const float*)(p.ws + OFF_BON);
  h16* Y = (h16*)(p.ws + OFF_HH);
  h16* SG = (h16*)smem;
#ifndef NO_POST
  for (int job = get_bid(); job < 1024; job += VGRID) {
    const int tg0 = job * 32, t0 = tg0 & (SEQ - 1);
#pragma unroll
    for (int i = 0; i < 2; i++) {
      const int e = tid + i * 256, tok = e >> 4, ch = e & 15;
      float o[8];
      psmix8(P, mu, (size_t)tg0 + tok, t0 + tok, 1664 + ch * 8, o);
      h16x8 hv;
#pragma unroll
      for (int j = 0; j < 8; j++) hv[j] = (h16)sigm(o[j]);
      *(h16x8*)(SG + tok * TLD + ch * 8) = hv;
    }
    LDS_BARRIER();
    {
      const int c8 = lane * 8, tq = wave;
      float hin[8];
#pragma unroll
      for (int e = 0; e < 8; e++) hin[e] = 0.f;
      const int bq = tg0 >> 13, seg = t0 >> 8;
      const float* SA = (const float*)(p.ws + OFF_SUMA) + (size_t)bq * 32 * 512 + c8;
      const float* SH = (const float*)(p.ws + OFF_SUMH) + (size_t)bq * 32 * 512 + c8;
      for (int sq = 0; sq < seg; sq++) {
        const f32x4 a0 = *(const f32x4*)(SA + sq * 512), a1 = *(const f32x4*)(SA + sq * 512 + 4);
        const f32x4 h0 = *(const f32x4*)(SH + sq * 512), h1 = *(const f32x4*)(SH + sq * 512 + 4);
#pragma unroll
        for (int e = 0; e < 4; e++) { hin[e] = fmaf(a0[e], hin[e], h0[e]); hin[4 + e] = fmaf(a1[e], hin[4 + e], h1[e]); }
      }
#pragma unroll 2
      for (int tk = 0; tk < 8; tk++) {
        const size_t tg = (size_t)tg0 + tq * 8 + tk;
        const h16x8 hl = *(const h16x8*)(HL + tg * 512 + c8);
        const h16x8 ca = *(const h16x8*)(CA + tg * 512 + c8);
        const h16x8 ly = *(const h16x8*)(P + tg * OIN + 2304 + c8);
        h16x8 o;
#pragma unroll
        for (int e = 0; e < 8; e++) o[e] = (h16)(((float)hl[e] + (float)ca[e] * hin[e]) * gelu_tanh((float)ly[e]));
        *(h16x8*)(Y + tg * DM + 512 + c8) = o;
      }
    }
#pragma unroll 1
    for (int hh = 0; hh < 2; hh++) {
      const int head = wave * 2 + hh;
      f32x16 accg[2];
#pragma unroll
      for (int n = 0; n < 2; n++)
#pragma unroll
        for (int r = 0; r < 16; r++) accg[n][r] = 0.f;
#pragma unroll
      for (int ks = 0; ks < 8; ks++) {
        h16x8 a = *(const h16x8*)(SG + l31 * TLD + ks * 16 + lh * 8);
#pragma unroll
        for (int q = 0; q < 2; q++) {
          const int n = wave * 128 + (hh * 2 + q) * 32 + l31;
          h16x8 bg = *(const h16x8*)(G2T + n * 128 + ks * 16 + lh * 8);
          accg[q] = __builtin_amdgcn_mfma_f32_32x32x16_f16(a, bg, accg[q], 0, 0, 0);
        }
      }
      float lnw[2], lnb[2], muv[2];
#pragma unroll
      for (int q = 0; q < 2; q++) {
        const int c = wave * 128 + (hh * 2 + q) * 32 + l31;
        lnw[q] = p.in[25][c]; lnb[q] = p.in[26][c]; muv[q] = mu[1024 + c];
      }
      int tgb = tg0;
#pragma unroll
      for (int r = 0; r < 16; r++) {
        if ((r & 3) == 0) asm volatile("" : "+s"(tgb));
        const int tr = (r & 3) + 8 * (r >> 2) + 4 * lh;
        const size_t tg = (size_t)tgb + tr;
        const int t = (tgb & (SEQ - 1)) + tr;
        float y[2];
#pragma unroll
        for (int q = 0; q < 2; q++) y[q] = (float)YS[tg * 512 + wave * 128 + (hh * 2 + q) * 32 + l31];
        const float mean = half_sum(y[0] + y[1], lane) * (1.f / 64.f);
        const float d0 = y[0] - mean, d1 = y[1] - mean;
        const float var = half_sum(d0 * d0 + d1 * d1, lane) * (1.f / 64.f);
        const float rs = rsqrtf(var + 64e-5f);
        const float bon = BON[tg * 8 + head];
#pragma unroll
        for (int q = 0; q < 2; q++) {
          const int nt = hh * 2 + q;
          const int c = wave * 128 + nt * 32 + l31;
          const float yn = (q == 0 ? d0 : d1) * rs * lnw[q] + lnb[q];
          const float v = psmixm(P, muv[q], tg, t, 1024 + c);
          Y[tg * DM + c] = (h16)((yn + bon * v) * accg[q][r]);
        }
        if ((r & 3) == 3) asm volatile("" ::: "memory");
      }
    }
    LDS_BARRIER();
  }
#endif
}

__device__ void run_phase(const Params& pin, int ph, char* gsm, int dry) {
  char* smem = gsm + (size_t)__builtin_amdgcn_readfirstlane(threadIdx.x >> 8) * 65536;
  Params p = pin;
  asm volatile("" : "+s"(p.ws));
  char* ws = p.ws;
  h16* wb = (h16*)(ws + OFF_WB);
  h16* HH = (h16*)(ws + OFF_HH);
  h16* BIG = (h16*)(ws + OFF_BIG);
  h16* DMb = (h16*)(ws + OFF_DM);
  const float* nw = p.in[1];
  if (ph == 0) {
    convert_weights(p, 0, (float*)smem);
    row_phase(p.in[0], nullptr, nullptr, 0.f, nw, nullptr, HH);
    return;
  }
  const int L = (ph - 1) / 12, s = (ph - 1) % 12;
  const float* nwl = nw + (size_t)L * 6 * DM;
  if (s == 0 || s == 1 || s == 3 || s == 7 || s == 9 || s == 10) {
    const h16* Ap; const h16* Bp; int K, nN, ldc, epi; void* Cp;
    if (s == 0 || s == 9) { Ap = HH; Bp = wb + (s == 0 ? WGU0 : WGU1); K = DM; nN = 22; Cp = BIG; ldc = DFF; epi = 2; }
    else if (s == 1 || s == 10) { Ap = BIG; Bp = wb + (s == 1 ? WD0 : WD1); K = DFF; nN = 4; Cp = DMb; ldc = DM; epi = 1; }
    else if (s == 3) { Ap = HH; Bp = wb + WIN; K = DM; nN = (L == 0) ? 15 : 11; Cp = BIG; ldc = (L == 0) ? EINP : OIN; epi = 1; }
    else { Ap = HH; Bp = wb + WOUT; K = DM; nN = 4; Cp = DMb; ldc = DM; epi = 1; }
    if (epi == 0) gemm_phase<0>(Ap, Bp, K, 128, nN, Cp, ldc, ldc, gsm);
    else if (epi == 1) gemm_phase<1>(Ap, Bp, K, 128, nN, Cp, ldc, ldc, gsm);
    else gemm_phase<2>(Ap, Bp, K, 128, nN, Cp, ldc, ldc, gsm);
    return;
  }
  switch (s) {
    case 2:
      row_phase(L == 0 ? p.in[0] : p.out, DMb, nwl + 1 * DM, 0.5f, nwl + 2 * DM, p.out, HH, dry);
      break;
    case 4:
      if (L == 0) even_pre(p, smem); else odd_pre(p, smem);
      break;
    case 5: {
      const int vb = __builtin_amdgcn_readfirstlane(threadIdx.x >> 8);
      for (int blk = real_bid(); blk < 256; blk += (int)gridDim.x) {
        if (L == 0) {
          { const int xcd_ = blk & 7, j_ = blk >> 3; const int tsk = (xcd_ * 2 + (j_ >> 4)) * 16 + (j_ & 15);
            if (vb == 0) scan_task<1>(p, tsk, smem, dry); else scan_task<0>(p, tsk, smem, dry); }
        } else {
          rwkv_scan_pc(p, blk, gsm, dry);
        }
      }
      break;
    }
    case 6:
      if (L == 0) even_post(p); else odd_post(p, smem);
      break;
    case 8:
      row_phase(p.out, DMb, nwl + 3 * DM, 1.0f, nwl + 4 * DM, p.out, HH, dry);
      break;
    case 11:
      if (L == 0) {
        convert_weights(p, 1, (float*)smem);
        convert_small(p);
        row_phase(p.out, DMb, nwl + 5 * DM, 0.5f, nw + 6 * DM, p.out, HH, dry);
      } else {
        row_phase(p.out, DMb, nwl + 5 * DM, 0.5f, nullptr, p.out, nullptr, dry);
      }
      break;
  }
}

#define OFF_BAR (484 * MIB)
#define XB_TMO      128
#define XB_XCNT(j)  (256  + 64 * (j))
#define XB_XSUB(j)  (1280 + 64 * (j))
#define XB_XGEN(j)  (2304 + 64 * (j))
#define XB_TOP      3328
#define XB_TOPGEN   3392
#define XCD_BAR_WORDS 3456
#define XB_SPIN_CAP (1u << 18)
#define LAS __attribute__((address_space(3)))
__device__ __forceinline__ unsigned xb_ld(unsigned* p) { return __hip_atomic_load(p, __ATOMIC_RELAXED, __HIP_MEMORY_SCOPE_AGENT); }
__device__ __forceinline__ unsigned xb_add(unsigned* p, unsigned v) { return __hip_atomic_fetch_add(p, v, __ATOMIC_RELAXED, __HIP_MEMORY_SCOPE_AGENT); }
__device__ __forceinline__ unsigned xb_xcc_id() { return (unsigned)__builtin_amdgcn_s_getreg((3 << 11) | 20) & 0xFu; }
#define XB_SPIN(cond, bar) do { unsigned _sp = 0; while (cond) { __builtin_amdgcn_s_sleep(1); \
    if ((++_sp & 255u) == 0u) { if (xb_ld(&(bar)[XB_TMO])) break; if (_sp > XB_SPIN_CAP) { atomicAdd(&(bar)[XB_TMO], 1u); break; } } } } while (0)
struct XcdBarrier { unsigned* bar; unsigned x; volatile LAS unsigned* st; };
__device__ __forceinline__ XcdBarrier xcd_barrier_post(unsigned* bar, volatile LAS unsigned* st) {
  XcdBarrier b; b.bar = bar; b.x = xb_xcc_id(); b.st = st;
  if (threadIdx.x == 0) (void)xb_add(&bar[XB_XCNT(b.x)], 1u);
  return b;
}
__device__ __forceinline__ void xcd_barrier_complete(unsigned* bar, unsigned x, unsigned& nloc, unsigned& nx) {
  const unsigned G = gridDim.x * gridDim.y * gridDim.z;
  unsigned sum, cnt, mine, sp = 0u;
  for (;;) {
    sum = 0u; cnt = 0u; mine = 0u;
#pragma unroll
    for (unsigned j = 0; j < 16; ++j) { const unsigned c = xb_ld(&bar[XB_XCNT(j)]); sum += c; cnt += (c > 0u) ? 1u : 0u; mine = (j == x) ? c : mine; }
    if (sum == G) break;
    __builtin_amdgcn_s_sleep(1);
    if ((++sp & 255u) == 0u) { if (xb_ld(&bar[XB_TMO])) break; if (sp > XB_SPIN_CAP) { atomicAdd(&bar[XB_TMO], 1u); break; } }
  }
  nloc = mine > 0u ? mine : 1u; nx = cnt > 0u ? cnt : 1u;
}
__device__ __forceinline__ void xcd_barrier(const XcdBarrier& b) {
  asm volatile("s_waitcnt vmcnt(0)" ::: "memory");
  __syncthreads();
  if (threadIdx.x == 0) {
    unsigned* bar = b.bar;
    __builtin_amdgcn_s_waitcnt(0);
    unsigned nloc = b.st[0], nx = b.st[1];
    if (nloc == 0u) { xcd_barrier_complete(bar, b.x, nloc, nx); b.st[0] = nloc; b.st[1] = nx; }
    const unsigned old = xb_add(&bar[XB_XSUB(b.x)], 1u);
    const unsigned gen = old / nloc;
    if (old + 1u == (gen + 1u) * nloc) {
      __builtin_amdgcn_fence(__ATOMIC_RELEASE, "agent");
      asm volatile("s_waitcnt vmcnt(0)" ::: "memory");
      const unsigned og = xb_add(&bar[XB_TOP], 1u);
      const unsigned tg = og / nx;
      if (og + 1u == (tg + 1u) * nx) xb_add(&bar[XB_TOPGEN], 1u);
      else XB_SPIN(xb_ld(&bar[XB_TOPGEN]) == tg, bar);
      __builtin_amdgcn_fence(__ATOMIC_ACQUIRE, "agent");
      xb_add(&bar[XB_XGEN(b.x)], 1u);
      asm volatile("s_waitcnt vmcnt(0)" ::: "memory");
    } else {
      XB_SPIN(xb_ld(&bar[XB_XGEN(b.x)]) == gen, bar);
      __builtin_amdgcn_fence(__ATOMIC_ACQUIRE, "agent");
      asm volatile("s_waitcnt vmcnt(0)" ::: "memory");
    }
  }
  __syncthreads();
}

__global__ void __launch_bounds__(512, 2) mega_kernel(Params p, int ph0, int ph1, int dup_mask) {
  extern __shared__ __attribute__((aligned(16))) char smem[];
  __shared__ uint4 xb_words;
  cg::grid_group grid = cg::this_grid();
  if (threadIdx.x == 0) xb_words = make_uint4(0u, 0u, 0u, 0u);
  __syncthreads();
  XcdBarrier xb = xcd_barrier_post((unsigned*)(p.ws + OFF_BAR), (volatile LAS unsigned*)&xb_words);
  int rep = 0;
  for (int ph = ph0; ph < ph1;) {
    run_phase(p, ph, smem, rep);
    const int bit = (ph == 0) ? 12 : (ph - 1) % 12;
    if (((dup_mask >> bit) & 1) && rep == 0) { rep = 1; } else { rep = 0; ph++; }
    if (ph < ph1) { if (ph1 < 0) grid.sync(); else xcd_barrier(xb); }
  }
}

extern "C" void kernel_launch(void* const* d_in, const int* in_sizes, int n_in, void* d_out, int out_size, void* d_ws,
                              size_t ws_size, hipStream_t stream) {
  static int grid_blocks = 0;
  if (!grid_blocks) {
    int dev = 0, cus = 0, per_cu = 0;
    hipGetDevice(&dev);
    hipDeviceGetAttribute(&cus, hipDeviceAttributeMultiprocessorCount, dev);
    hipFuncSetAttribute((const void*)mega_kernel, hipFuncAttributeMaxDynamicSharedMemorySize, 131072);
    hipOccupancyMaxActiveBlocksPerMultiprocessor(&per_cu, mega_kernel, 512, 131072);
    if (per_cu > 1) per_cu = 1;
    if (per_cu < 1) per_cu = 1;
    grid_blocks = cus * per_cu;
  }
  Params p{};
  for (int i = 0; i < 34; i++) p.in[i] = (const float*)d_in[i];
  p.out = (float*)d_out;
  p.ws = (char*)d_ws;
  int ph0 = 0, ph1 = NPHASE, dup = DUPMASK;
  void* args[] = {&p, &ph0, &ph1, &dup};
  hipMemsetAsync((char*)d_ws + OFF_BAR, 0, XCD_BAR_WORDS * sizeof(unsigned), stream);
  hipError_t e = hipLaunchCooperativeKernel((void*)mega_kernel, dim3(grid_blocks), dim3(512), args, 131072, stream);
  if (e != hipSuccess) fprintf(stderr, "cooperative launch failed: %s (grid %d)\n", hipGetErrorString(e), grid_blocks);
}
```

```cpp
#include <hip/hip_runtime.h>
#include <hip/hip_fp16.h>
#include <hip/hip_cooperative_groups.h>
#include <cstdio>
namespace cg = cooperative_groups;

typedef _Float16 h16;
typedef h16 h16x8 __attribute__((ext_vector_type(8)));
typedef h16 h16x4 __attribute__((ext_vector_type(4)));
typedef float f32x16 __attribute__((ext_vector_type(16)));
typedef unsigned int u32x4 __attribute__((ext_vector_type(4)));
typedef float f32x4 __attribute__((ext_vector_type(4)));

#define MTOK 32768
#define SEQ 8192
#define DM 1024
#define DFF 2816
#define EIN 3608
#define EINP 3712
#define OIN 2816

#define MIB ((size_t)1 << 20)
#define OFF_WB   ((size_t)0)
#define OFF_HH   (48 * MIB)
#define OFF_BIG  (112 * MIB)
#define OFF_DM   (344 * MIB)
#define OFF_ELA  (OFF_DM)
#define OFF_GQ   (OFF_DM + 16 * MIB)
#define OFF_GK   (OFF_DM + 48 * MIB)
#define OFF_GV   (OFF_DM + 80 * MIB)
#define OFF_AB   (OFF_DM + 112 * MIB)
#define OFF_KK   (OFF_HH)
#define OFF_KKA  (OFF_HH + 32 * MIB)
#define OFF_W16  (288 * MIB)
#define OFF_KP   (320 * MIB)
#define OFF_R    (352 * MIB)
#define OFF_V    (384 * MIB)
#define OFF_LLA  (416 * MIB)
#define OFF_LB   (448 * MIB)
#define OFF_BON  (480 * MIB)
#define WGU0 0
#define WD0  5767168
#define WGU1 8650752
#define WD1  14417920
#define WIN  17301504
#define WOUT 21233664

#define SMEM_BYTES 45056
#define NPHASE 25
#define DUPMASK 0x0

struct Params {
  const float* in[34];
  float* out;
  char* ws;
};

__device__ __forceinline__ int get_tid() { int t = threadIdx.x & 255; asm volatile("" : "+v"(t)); return t; }
__device__ __forceinline__ int get_bid() { int t = blockIdx.x * 2 + __builtin_amdgcn_readfirstlane(threadIdx.x >> 8); asm volatile("" : "+s"(t)); return t; }
__device__ __forceinline__ int real_tid() { int t = threadIdx.x; asm volatile("" : "+v"(t)); return t; }
__device__ __forceinline__ int real_bid() { int t = blockIdx.x; asm volatile("" : "+s"(t)); return t; }
#define VGRID ((int)gridDim.x * 2)
__device__ __forceinline__ float sigm(float x) { return __builtin_amdgcn_rcpf(1.f + __expf(-x)); }
__device__ __forceinline__ float softplus_(float x) { return fmaxf(x, 0.f) + __logf(1.f + __expf(-fabsf(x))); }
__device__ __forceinline__ float silu_(float x) { return x * __builtin_amdgcn_rcpf(1.f + __expf(-x)); }
__device__ __forceinline__ float fast_tanh(float u) { return 1.f - 2.f * __builtin_amdgcn_rcpf(1.f + __expf(2.f * u)); }
__device__ __forceinline__ float gelu_tanh(float x) {
  float u = 0.7978845608028654f * (x + 0.044715f * x * x * x);
  return 0.5f * x * (1.f + fast_tanh(u));
}

template <int CTRL>
__device__ __forceinline__ float dpp_f(float x) {
  return __int_as_float(__builtin_amdgcn_update_dpp(0, __float_as_int(x), CTRL, 0xF, 0xF, true));
}
__device__ __forceinline__ float reduce16(float x) {
  x += dpp_f<0xB1>(x);
  x += dpp_f<0x4E>(x);
  x += dpp_f<0x141>(x);
  x += dpp_f<0x140>(x);
  return x;
}

__device__ __forceinline__ float wave_sum(float v) {
  v = reduce16(v);
  const int vi = __float_as_int(v);
  float t = __int_as_float(__builtin_amdgcn_readlane(vi, 0));
  t += __int_as_float(__builtin_amdgcn_readlane(vi, 16));
  t += __int_as_float(__builtin_amdgcn_readlane(vi, 32));
  t += __int_as_float(__builtin_amdgcn_readlane(vi, 48));
  return t;
}

#define LDS_BARRIER() do { asm volatile("s_waitcnt lgkmcnt(0)" ::: "memory"); __builtin_amdgcn_s_barrier(); asm volatile("" ::: "memory"); } while (0)

__device__ void conv_tile(const float* __restrict__ src, int K, int N, h16* __restrict__ dst, int mode, int kt, int nt,
                          float* sm) {
  const int tid = get_tid();
#pragma unroll
  for (int i = 0; i < 4; i++) {
    const int idx = tid + i * 256, r = idx >> 4, c4 = (idx & 15) * 4;
    const int n = nt * 64 + c4;
    f32x4 v = {0.f, 0.f, 0.f, 0.f};
    if (n < N) v = __builtin_nontemporal_load((const f32x4*)(src + (size_t)(kt * 64 + r) * N + n));
#pragma unroll
    for (int e = 0; e < 4; e++) sm[r * 65 + c4 + e] = v[e];
  }
  LDS_BARRIER();
#pragma unroll
  for (int i = 0; i < 2; i++) {
    const int idx = tid + i * 256, nl = idx >> 3, kc = (idx & 7) * 8;
    const int n = nt * 64 + nl;
    const int row = (mode == 0) ? n : ((n >> 4) * 32 + (mode - 1) * 16 + (n & 15));
    h16x8 o;
#pragma unroll
    for (int j = 0; j < 8; j++) o[j] = (h16)sm[(kc + j) * 65 + nl];
    *(h16x8*)(dst + (size_t)row * K + kt * 64 + kc) = o;
  }
  LDS_BARRIER();
}

__device__ void convert_weights(const Params& p, int L, float* sm) {
  h16* wb = (h16*)(p.ws + OFF_WB);
  const int T_G = 16 * 44, T_D = 44 * 16;
  const int T_F = 2 * T_G + T_D;
  const int nin = (L == 0) ? 60 : 44;
  const int T_IN = 16 * nin, T_OUT = 256;
  const int total = 2 * T_F + T_IN + T_OUT;
  for (int j = get_bid(); j < total; j += VGRID) {
    int q = j;
    const float* src; int K, N, mode, ntn; h16* dst;
    if (q < 2 * T_F) {
      int f = q / T_F; q -= f * T_F;
      int lf = L * 2 + f;
      if (q < T_G) { src = p.in[2] + (size_t)lf * DM * DFF; K = DM; N = DFF; dst = wb + (f ? WGU1 : WGU0); mode = 1; ntn = 44; }
      else if (q < 2 * T_G) { q -= T_G; src = p.in[3] + (size_t)lf * DM * DFF; K = DM; N = DFF; dst = wb + (f ? WGU1 : WGU0); mode = 2; ntn = 44; }
      else { q -= 2 * T_G; src = p.in[4] + (size_t)lf * DFF * DM; K = DFF; N = DM; dst = wb + (f ? WD1 : WD0); mode = 0; ntn = 16; }
    } else {
      q -= 2 * T_F;
      if (q < T_IN) { src = (L == 0) ? p.in[5] : p.in[14]; K = DM; N = (L == 0) ? EIN : OIN; dst = wb + WIN; mode = 0; ntn = nin; }
      else { q -= T_IN; src = (L == 0) ? p.in[6] : p.in[15]; K = DM; N = DM; dst = wb + WOUT; mode = 0; ntn = 16; }
    }
    int kt = q / ntn, nt = q % ntn;
    conv_tile(src, K, N, dst, mode, kt, nt, sm);
  }
}

__device__ void row_phase(const float* __restrict__ xin, const h16* __restrict__ Dmat, const float* __restrict__ wpost,
                          float res, const float* __restrict__ wpre, float* __restrict__ xout, h16* __restrict__ hh, int dry = 0) {
  const int lane = get_tid() & 63;
  const int gw = get_bid() * 4 + (get_tid() >> 6);
  const int nw = VGRID * 4;
  float4 nx[4];
  h16x4 nd[4];
  if (gw < MTOK) {
#pragma unroll
    for (int i = 0; i < 4; i++) {
      { f32x4 t_ = __builtin_nontemporal_load((const f32x4*)(xin + (size_t)gw * DM + i * 256 + lane * 4)); nx[i] = make_float4(t_[0], t_[1], t_[2], t_[3]); }
      if (Dmat) nd[i] = __builtin_nontemporal_load((const h16x4*)(Dmat + (size_t)gw * DM + i * 256 + lane * 4));
    }
  }
  for (int row = gw; row < MTOK; row += nw) {
    float4 xv[4];
    h16x4 dh[4];
#pragma unroll
    for (int i = 0; i < 4; i++) { xv[i] = nx[i]; dh[i] = nd[i]; }
    const int nrow = row + nw;
    if (nrow < MTOK) {
#pragma unroll
      for (int i = 0; i < 4; i++) {
        { f32x4 t_ = __builtin_nontemporal_load((const f32x4*)(xin + (size_t)nrow * DM + i * 256 + lane * 4)); nx[i] = make_float4(t_[0], t_[1], t_[2], t_[3]); }
        if (Dmat) nd[i] = __builtin_nontemporal_load((const h16x4*)(Dmat + (size_t)nrow * DM + i * 256 + lane * 4));
      }
    }
    if (Dmat) {
      float4 dv[4];
      float ss = 0.f;
#pragma unroll
      for (int i = 0; i < 4; i++) {
        dv[i].x = (float)dh[i][0]; dv[i].y = (float)dh[i][1]; dv[i].z = (float)dh[i][2]; dv[i].w = (float)dh[i][3];
        ss += dv[i].x * dv[i].x + dv[i].y * dv[i].y + dv[i].z * dv[i].z + dv[i].w * dv[i].w;
      }
      ss = wave_sum(ss);
      float inv = rsqrtf(ss * (1.f / DM) + 1e-6f) * res;
#pragma unroll
      for (int i = 0; i < 4; i++) {
        float4 w = *(const float4*)(wpost + i * 256 + lane * 4);
        xv[i].x += dv[i].x * inv * w.x; xv[i].y += dv[i].y * inv * w.y;
        xv[i].z += dv[i].z * inv * w.z; xv[i].w += dv[i].w * inv * w.w;
        if (!dry) { f32x4 t_ = {xv[i].x, xv[i].y, xv[i].z, xv[i].w}; __builtin_nontemporal_store(t_, (f32x4*)(xout + (size_t)row * DM + i * 256 + lane * 4)); }
      }
    }
    if (hh) {
      float ss = 0.f;
#pragma unroll
      for (int i = 0; i < 4; i++) ss += xv[i].x * xv[i].x + xv[i].y * xv[i].y + xv[i].z * xv[i].z + xv[i].w * xv[i].w;
      ss = wave_sum(ss);
      float inv = rsqrtf(ss * (1.f / DM) + 1e-6f);
#pragma unroll
      for (int i = 0; i < 4; i++) {
        float4 w = *(const float4*)(wpre + i * 256 + lane * 4);
        h16x4 o;
        o[0] = (h16)(xv[i].x * inv * w.x); o[1] = (h16)(xv[i].y * inv * w.y);
        o[2] = (h16)(xv[i].z * inv * w.z); o[3] = (h16)(xv[i].w * inv * w.w);
        if (!dry) *(h16x4*)(hh + (size_t)row * DM + i * 256 + lane * 4) = o;
      }
    }
  }
}

typedef float f32x4v __attribute__((ext_vector_type(4)));
#define G_BM 256
#define G_BK 64
#define G_HALF 128
#define G_HT (G_HALF * G_BK)
__device__ __forceinline__ int lds_byte(int r, int c) {
  int st = (r >> 4) * 2 + (c >> 5), rr = r & 15, cc = c & 31, ob = rr * 64 + cc * 2;
  return st * 1024 + (ob ^ (((ob >> 9) & 1) << 5));
}
__device__ __forceinline__ void stage_rc(int b, int& R, int& C) {
  int st = b / 1024, sb = b % 1024, swz = sb ^ (((sb >> 9) & 1) << 5);
  R = (st >> 1) * 16 + swz / 64; C = (st & 1) * 32 + (swz % 64) / 2;
}
template <int EPI>
__device__ void gemm_phase(const h16* __restrict__ A, const h16* __restrict__ Bt, int K, int nM, int nN,
                           void* __restrict__ Cout, int ldc, int ncv, char* smem) {
  h16* shm = (h16*)smem;
#define SA(b, h) (shm + ((b) * 2 + (h)) * G_HT)
#define SB(b, h) (shm + (4 + (b) * 2 + (h)) * G_HT)
#define STAGE(P, BASE, br, kt) do { const char* _gb = (const char*)(BASE) + ((long)(br) * K + (long)(kt) * G_BK) * 2; \
    __builtin_amdgcn_global_load_lds((const unsigned*)(_gb + voff), (unsigned*)((char*)(P) + tid * 16), 16, 0, 0); \
    __builtin_amdgcn_global_load_lds((const unsigned*)(_gb + (long)K * 128 + voff), (unsigned*)((char*)(P) + tid * 16 + 8192), 16, 0, 0); } while (0)
#define LDA(dst, b, h) for (int m = 0; m < 4; ++m) for (int k = 0; k < 2; ++k) \
    dst[m][k] = *reinterpret_cast<const h16x8*>((char*)SA(b, h) + lds_byte(wr * 64 + m * 16 + fr, k * 32 + fq * 8))
#define LDB(dst, b, h) for (int n = 0; n < 2; ++n) for (int k = 0; k < 2; ++k) \
    dst[n][k] = *reinterpret_cast<const h16x8*>((char*)SB(b, h) + lds_byte(wc * 32 + n * 16 + fr, k * 32 + fq * 8))
#define MMA(ai, bj, At_, Bt_) do { __builtin_amdgcn_s_setprio(1); \
    for (int m = 0; m < 4; ++m) for (int n = 0; n < 2; ++n) for (int k = 0; k < 2; ++k) \
      acc[ai][bj][m][n] = __builtin_amdgcn_mfma_f32_16x16x32_f16(Bt_[n][k], At_[m][k], acc[ai][bj][m][n], 0, 0, 0); \
    __builtin_amdgcn_s_setprio(0); } while (0)
#define WAIT_V(n) asm volatile("s_waitcnt vmcnt(" #n ")" ::: "memory")
#define WAIT_L(n) asm volatile("s_waitcnt lgkmcnt(" #n ")" ::: "memory")
#define BAR __builtin_amdgcn_s_barrier()
#define SCHED __builtin_amdgcn_sched_barrier(0)
  const int tid = real_tid();
  const int G = gridDim.x;
  const int nwg = nM * nN;
  const int wid = tid >> 6, lane = tid & 63, wr = wid >> 2, wc = wid & 3, fr = lane & 15, fq = lane >> 4;
  const int nt = K / G_BK;
  unsigned voff;
  { int R0, C0; stage_rc(tid * 16, R0, C0); voff = (unsigned)((R0 * K + C0) * 2); }
  for (int L = real_bid(); L < nwg; L += G) {
    int wgid = L;
    { int q = nwg / 8, r = nwg % 8, xcd = wgid % 8, off = wgid / 8;
      wgid = (xcd < r ? xcd * (q + 1) : r * (q + 1) + (xcd - r) * q) + off; }
    const int nig = 4 * nN, gid = wgid / nig, fm = gid * 4, gsz = min(nM - fm, 4);
    const int pm = fm + ((wgid % nig) % gsz), pn = (wgid % nig) / gsz, brow = pm * G_BM, bcol = pn * G_BM;
    f32x4v acc[2][2][4][2];
#pragma unroll
    for (int a_ = 0; a_ < 2; a_++)
#pragma unroll
      for (int b_ = 0; b_ < 2; b_++)
#pragma unroll
        for (int m = 0; m < 4; m++)
#pragma unroll
          for (int n = 0; n < 2; n++) acc[a_][b_][m][n] = f32x4v{0.f, 0.f, 0.f, 0.f};
    h16x8 At[4][2], B0[2][2], B1[2][2];
    WAIT_V(0);
    __syncthreads();
    STAGE(SB(0, 0), Bt, bcol, 0); STAGE(SA(0, 0), A, brow, 0);
    STAGE(SB(0, 1), Bt, bcol + G_HALF, 0); STAGE(SA(0, 1), A, brow + G_HALF, 0);
    if (wr == 1) BAR;
    WAIT_V(4); BAR;
    STAGE(SB(1, 0), Bt, bcol, 1); STAGE(SA(1, 0), A, brow, 1); STAGE(SB(1, 1), Bt, bcol + G_HALF, 1);
    WAIT_V(6); BAR;
    for (int t = 0; t < nt - 2; t += 2) {
      LDB(B0, 0, 0); SCHED; LDA(At, 0, 0); STAGE(SA(1, 1), A, brow + G_HALF, t + 1);
      WAIT_L(8); BAR; WAIT_L(0); MMA(0, 0, At, B0); BAR; SCHED;
      LDB(B1, 0, 1); STAGE(SB(0, 0), Bt, bcol, t + 2);
      BAR; WAIT_L(0); MMA(0, 1, At, B1); BAR;
      LDA(At, 0, 1); STAGE(SA(0, 0), A, brow, t + 2);
      BAR; WAIT_L(0); MMA(1, 0, At, B0); BAR; SCHED;
      STAGE(SB(0, 1), Bt, bcol + G_HALF, t + 2);
      WAIT_V(6); BAR; MMA(1, 1, At, B1); BAR;
      LDB(B0, 1, 0); SCHED; LDA(At, 1, 0); STAGE(SA(0, 1), A, brow + G_HALF, t + 2);
      WAIT_L(8); BAR; WAIT_L(0); MMA(0, 0, At, B0); BAR; SCHED;
      LDB(B1, 1, 1); STAGE(SB(1, 0), Bt, bcol, t + 3);
      BAR; WAIT_L(0); MMA(0, 1, At, B1); BAR;
      LDA(At, 1, 1); STAGE(SA(1, 0), A, brow, t + 3);
      BAR; WAIT_L(0); MMA(1, 0, At, B0); BAR; SCHED;
      STAGE(SB(1, 1), Bt, bcol + G_HALF, t + 3);
      WAIT_V(6); BAR; MMA(1, 1, At, B1); BAR;
    }
    { LDB(B0, 0, 0); LDA(At, 0, 0); STAGE(SA(1, 1), A, brow + G_HALF, nt - 1);
      BAR; WAIT_L(0); MMA(0, 0, At, B0); BAR;
      LDB(B1, 0, 1); BAR; WAIT_L(0); MMA(0, 1, At, B1); BAR;
      LDA(At, 0, 1); WAIT_V(4); BAR; WAIT_L(0); MMA(1, 0, At, B0); MMA(1, 1, At, B1); BAR; }
    { LDB(B0, 1, 0); LDA(At, 1, 0); WAIT_V(2); BAR; WAIT_L(0); MMA(0, 0, At, B0); BAR;
      LDB(B1, 1, 1); WAIT_V(0); BAR; WAIT_L(0); MMA(0, 1, At, B1); BAR;
      LDA(At, 1, 1); BAR; WAIT_L(0); MMA(1, 0, At, B0); MMA(1, 1, At, B1); BAR; }
    if (wr == 0) BAR;
#pragma unroll
    for (int ai = 0; ai < 2; ++ai)
#pragma unroll
      for (int bj = 0; bj < 2; ++bj)
#pragma unroll
        for (int m = 0; m < 4; ++m) {
          const long row = brow + ai * G_HALF + wr * 64 + m * 16 + fr;
          if (EPI == 2) {
            const f32x4v g = acc[ai][bj][m][0], u = acc[ai][bj][m][1];
            const int col = (bcol >> 1) + bj * 64 + wc * 16 + fq * 4;
            h16x4 o;
#pragma unroll
            for (int j = 0; j < 4; ++j) o[j] = (h16)(silu_(g[j]) * u[j]);
            *(h16x4*)((h16*)Cout + row * ldc + col) = o;
          } else {
#pragma unroll
            for (int n = 0; n < 2; ++n) {
              const int col = bcol + bj * G_HALF + wc * 32 + n * 16 + fq * 4;
              if (EPI == 0) {
                *(f32x4v*)((float*)Cout + row * ldc + col) = acc[ai][bj][m][n];
              } else if (col < ncv) {
                h16x4 o;
#pragma unroll
                for (int j = 0; j < 4; ++j) o[j] = (h16)acc[ai][bj][m][n][j];
                *(h16x4*)((h16*)Cout + row * ldc + col) = o;
              }
            }
          }
        }
  }
#undef SA
#undef SB
}

#define TT 32
template <int MODE> struct ScanCfg;
template <> struct ScanCfg<0> { static constexpr int NF = 200, E = 2, NA = 3, VOFF = 192; };
template <> struct ScanCfg<1> { static constexpr int NF = 268, E = 4, NA = 4, VOFF = 256; };
template <> struct ScanCfg<2> { static constexpr int NF = 328, E = 2, NA = 5, VOFF = 320; };
typedef float f32x2 __attribute__((ext_vector_type(2)));

__device__ __forceinline__ float reduce32(float x) {
  x = reduce16(x);
  const unsigned xi = __float_as_uint(x);
  auto r = __builtin_amdgcn_permlane32_swap(xi, xi, false, false);
  return __uint_as_float(r[0]) + __uint_as_float(r[1]);
}

template <int MODE>
__device__ void scan_task(const Params& p, int task, char* smem, int dry) {
  constexpr int NF = ScanCfg<MODE>::NF, E = ScanCfg<MODE>::E, NA = ScanCfg<MODE>::NA, VOFF = ScanCfg<MODE>::VOFF;
  float* rec = (float*)smem;
  const int tid = get_tid(), lane = tid & 63, wave = tid >> 6;
  const int sub = (lane & 15) + ((lane >> 5) << 4), row = wave * 2 + ((lane >> 4) & 1);
  int b, h, rowbase;
  if (MODE == 2) { int bh = task >> 3; b = bh >> 3; h = bh & 7; rowbase = (task & 7) * 8; }
  else { int bh = task >> 4; b = bh >> 2; h = bh & 3; rowbase = (task & 15) * 8; }
  char* ws = p.ws;
  const size_t bS = (size_t)b * SEQ;

  const h16* src[NA];
  int dsto[NA];
  int ldm;
  const h16* srcv;
  int ldv;
  const int tokv = tid & 31;
  const int dstv = tokv * NF + VOFF;
  if (MODE == 0) {
    const int tok = tid >> 3, ch = tid & 7;
    const h16* P = (const h16*)(ws + OFF_BIG);
    src[0] = (const h16*)(ws + OFF_ELA) + (bS + tok) * 256 + h * 64 + ch * 8;
    src[1] = P + (bS + tok) * EINP + 256 + h * 64 + ch * 8;
    src[2] = P + (bS + tok) * EINP + h * 64 + ch * 8;
    for (int a = 0; a < NA; a++) dsto[a] = tok * NF + a * 64 + ch * 8;
    ldm = EINP;
    srcv = P + (bS + tokv) * EINP + 512 + h * 128 + rowbase; ldv = EINP;
  } else if (MODE == 1) {
    for (int a = 0; a < NA; a++) {
      const int idx = tid + (a & 1) * 256, tok = idx >> 4, ch = idx & 15;
      src[a] = (const h16*)(ws + (a < 2 ? OFF_GK : OFF_GQ)) + (bS + tok) * 512 + h * 128 + ch * 8;
      dsto[a] = tok * NF + (a < 2 ? 0 : 128) + ch * 8;
    }
    ldm = 512;
    srcv = (const h16*)(ws + OFF_GV) + (bS + tokv) * 512 + h * 128 + rowbase; ldv = 512;
  } else {
    const int tok = tid >> 3, ch = tid & 7;
    for (int a = 0; a < NA; a++) {
      const size_t off = a == 0 ? OFF_W16 : a == 1 ? OFF_KK : a == 2 ? OFF_KKA : a == 3 ? OFF_KP : OFF_R;
      src[a] = (const h16*)(ws + off) + (bS + tok) * 512 + h * 64 + ch * 8;
      dsto[a] = tok * NF + a * 64 + ch * 8;
    }
    ldm = 512;
    srcv = (const h16*)(ws + OFF_V) + (bS + tokv) * 512 + h * 64 + rowbase; ldv = 512;
  }
  const float* srcab = (const float*)(ws + OFF_AB) + ((bS + (tid & 31)) * 4 + h) * 2;

  h16* outp; int ldo;
  if (MODE == 0) { outp = (h16*)(ws + OFF_BIG) + 512 + h * 128 + rowbase; ldo = EINP; }
  else if (MODE == 1) { outp = (h16*)(ws + OFF_GV) + h * 128 + rowbase; ldo = 512; }
  else { outp = (h16*)(ws + OFF_V) + h * 64 + rowbase; ldo = 512; }
  outp += bS * ldo;

  float s[E];
#pragma unroll
  for (int e = 0; e < E; e++) s[e] = 0.f;

  u32x4 pre[NA];
  u32x4 prev = {0u, 0u, 0u, 0u};
  float pab0 = 0.f, pab1 = 0.f;
#pragma unroll
  for (int a = 0; a < NA; a++) pre[a] = *(const u32x4*)(src[a]);
  if (tid < 32) prev = *(const u32x4*)(srcv);
  if (MODE == 1 && tid < 32) { pab0 = srcab[0]; pab1 = srcab[1]; }

  for (int t0 = 0; t0 < SEQ; t0 += TT) {
#pragma unroll
    for (int a = 0; a < NA; a++) {
      h16x8 hv = __builtin_bit_cast(h16x8, pre[a]);
      float f[8];
#pragma unroll
      for (int j = 0; j < 8; j++) {
        float x = (float)hv[j];
        if (MODE == 0 && a == 0) x = __expf(x);
        if (MODE == 0 && a == 2) x *= 0.125f;
        if (MODE == 2 && a == 0) x = __expf(-__expf(x));
        f[j] = x;
      }
      f32x4 lo = {f[0], f[1], f[2], f[3]}, hi = {f[4], f[5], f[6], f[7]};
      *(f32x4*)(rec + dsto[a]) = lo;
      *(f32x4*)(rec + dsto[a] + 4) = hi;
    }
    if (tid < 32) {
      h16x8 hv = __builtin_bit_cast(h16x8, prev);
      f32x4 lo = {(float)hv[0], (float)hv[1], (float)hv[2], (float)hv[3]};
      f32x4 hi = {(float)hv[4], (float)hv[5], (float)hv[6], (float)hv[7]};
      *(f32x4*)(rec + dstv) = lo;
      *(f32x4*)(rec + dstv + 4) = hi;
    }
    if (MODE == 1 && tid < 32) { rec[tid * NF + 264] = pab0; rec[tid * NF + 265] = pab1; }
    LDS_BARRIER();
    if (t0 + TT < SEQ) {
      const size_t tn = (size_t)(t0 + TT);
#pragma unroll
      for (int a = 0; a < NA; a++) {
        const int ld = (MODE == 0 && a == 0) ? 256 : ldm;
        pre[a] = *(const u32x4*)(src[a] + tn * ld);
      }
      if (tid < 32) prev = *(const u32x4*)(srcv + tn * ldv);
      if (MODE == 1 && tid < 32) { pab0 = srcab[tn * 8]; pab1 = srcab[tn * 8 + 1]; }
    }
    float yk = 0.f;
#pragma unroll 1
    for (int hb = 0; hb < TT / 16; hb++) {
      float yp[16];
#pragma unroll
      for (int j = 0; j < 16; j++) {
        const float* rc = rec + (hb * 16 + j) * NF;
        float y;
        if (MODE == 0) {
          f32x2 W = *(const f32x2*)(rc + sub * 2);
          f32x2 Kv = *(const f32x2*)(rc + 64 + sub * 2);
          f32x2 R = *(const f32x2*)(rc + 128 + sub * 2);
          float v = rc[VOFF + row];
          s[0] = fmaf(v, Kv[0], s[0] * W[0]);
          s[1] = fmaf(v, Kv[1], s[1] * W[1]);
          y = s[0] * R[0] + s[1] * R[1];
        } else if (MODE == 1) {
          f32x4 Kv = *(const f32x4*)(rc + sub * 4);
          f32x4 R = *(const f32x4*)(rc + 128 + sub * 4);
          float v = rc[VOFF + row];
          f32x2 ab = *(const f32x2*)(rc + 264);
          const float al = ab[0], be = ab[1];
          float d = (s[0] * Kv[0] + s[1] * Kv[1]) + (s[2] * Kv[2] + s[3] * Kv[3]);
          d = reduce32(d);
          float c = be * (v - al * d);
#pragma unroll
          for (int e = 0; e < 4; e++) s[e] = fmaf(c, Kv[e], al * s[e]);
          y = (s[0] * R[0] + s[1] * R[1]) + (s[2] * R[2] + s[3] * R[3]);
        } else {
          f32x2 W = *(const f32x2*)(rc + sub * 2);
          f32x2 Pv = *(const f32x2*)(rc + 64 + sub * 2);
          f32x2 Av = *(const f32x2*)(rc + 128 + sub * 2);
          f32x2 Kv = *(const f32x2*)(rc + 192 + sub * 2);
          f32x2 R = *(const f32x2*)(rc + 256 + sub * 2);
          float v = rc[VOFF + row];
          float d = s[0] * Pv[0] + s[1] * Pv[1];
          d = reduce32(d);
          s[0] = fmaf(v, Kv[0], fmaf(-d, Av[0], s[0] * W[0]));
          s[1] = fmaf(v, Kv[1], fmaf(-d, Av[1], s[1] * W[1]));
          y = s[0] * R[0] + s[1] * R[1];
        }
        yp[j] = y;
      }
      {
        const bool b3 = (lane & 8) != 0, b2 = (lane & 4) != 0, b1 = (lane & 2) != 0, b0 = (lane & 1) != 0;
        float q8[8], q4[4], q2[2];
#pragma unroll
        for (int i = 0; i < 8; i++) {
          float keep = b3 ? yp[i + 8] : yp[i], send = b3 ? yp[i] : yp[i + 8];
          q8[i] = keep + dpp_f<0x140>(send);
        }
#pragma unroll
        for (int i = 0; i < 4; i++) {
          float keep = b2 ? q8[i + 4] : q8[i], send = b2 ? q8[i] : q8[i + 4];
          q4[i] = keep + dpp_f<0x141>(send);
        }
#pragma unroll
        for (int i = 0; i < 2; i++) {
          float keep = b1 ? q4[i + 2] : q4[i], send = b1 ? q4[i] : q4[i + 2];
          q2[i] = keep + dpp_f<0x4E>(send);
        }
        float keep = b0 ? q2[1] : q2[0], send = b0 ? q2[0] : q2[1];
        float q1 = keep + dpp_f<0xB1>(send);
        const unsigned qi = __float_as_uint(q1);
        auto r = __builtin_amdgcn_permlane32_swap(qi, qi, false, false);
        q1 = __uint_as_float(r[0]) + __uint_as_float(r[1]);
        yk = ((sub >> 4) == hb) ? q1 : yk;
      }
    }
    if (!dry) outp[(size_t)(t0 + sub) * ldo + row] = (h16)yk;
    LDS_BARRIER();
  }
}
#define SCAN_BARRIERS (2 * (SEQ / TT))

#define OFF_SUMA (OFF_BON + 1 * MIB)
#define OFF_SUMH (OFF_BON + 1 * MIB + 256 * 1024)
__device__ void lru_scan_task(const Params& p, int task, int dry) {
  const int tid = get_tid();
  const int half = task & 1, seg = (task >> 1) & 31, b = task >> 6;
  const int c = half * 256 + tid;
  const size_t base = ((size_t)b * SEQ + seg * 256) * 512 + c;
  h16* la = (h16*)(p.ws + OFF_LLA) + base;
  h16* bb = (h16*)(p.ws + OFF_LB) + base;
  float hs = 0.f, ap = 1.f;
  h16 na[16], nb[16];
#pragma unroll
  for (int i = 0; i < 16; i++) { na[i] = la[(size_t)i * 512]; nb[i] = bb[(size_t)i * 512]; }
  for (int t0 = 0; t0 < 256; t0 += 16) {
    h16 ca[16], cb[16];
#pragma unroll
    for (int i = 0; i < 16; i++) { ca[i] = na[i]; cb[i] = nb[i]; }
    if (t0 + 16 < 256) {
#pragma unroll
      for (int i = 0; i < 16; i++) { na[i] = la[(size_t)(t0 + 16 + i) * 512]; nb[i] = bb[(size_t)(t0 + 16 + i) * 512]; }
    }
#pragma unroll
    for (int i = 0; i < 16; i++) {
      float a = __expf((float)ca[i]);
      hs = fmaf(a, hs, (float)cb[i]);
      ap *= a;
      if (!dry) { bb[(size_t)(t0 + i) * 512] = (h16)hs;
      la[(size_t)(t0 + i) * 512] = (h16)ap; }
    }
  }
  if (!dry) { ((float*)(p.ws + OFF_SUMA))[(b * 32 + seg) * 512 + c] = ap;
  ((float*)(p.ws + OFF_SUMH))[(b * 32 + seg) * 512 + c] = hs; }
}

#define PR_NF 600
__device__ __forceinline__ float treduce16(const float (&yp)[16], int lane) {
  const bool b3 = (lane & 8) != 0, b2 = (lane & 4) != 0, b1 = (lane & 2) != 0, b0 = (lane & 1) != 0;
  float q8[8], q4[4], q2[2];
#pragma unroll
  for (int i = 0; i < 8; i++) { float keep = b3 ? yp[i + 8] : yp[i], send = b3 ? yp[i] : yp[i + 8]; q8[i] = keep + dpp_f<0x140>(send); }
#pragma unroll
  for (int i = 0; i < 4; i++) { float keep = b2 ? q8[i + 4] : q8[i], send = b2 ? q8[i] : q8[i + 4]; q4[i] = keep + dpp_f<0x141>(send); }
#pragma unroll
  for (int i = 0; i < 2; i++) { float keep = b1 ? q4[i + 2] : q4[i], send = b1 ? q4[i] : q4[i + 2]; q2[i] = keep + dpp_f<0x4E>(send); }
  float keep = b0 ? q2[1] : q2[0], send = b0 ? q2[0] : q2[1];
  float q1 = keep + dpp_f<0xB1>(send);
  const unsigned qi = __float_as_uint(q1);
  auto r = __builtin_amdgcn_permlane32_swap(qi, qi, false, false);
  return __uint_as_float(r[0]) + __uint_as_float(r[1]);
}

__device__ void lru_scan_task(const Params& p, int task, int dry);

__device__ void rwkv_scan_pc(const Params& p, int blk, char* gsm, int dry) {
  const int rtid = real_tid();
  const int vb = __builtin_amdgcn_readfirstlane(rtid >> 8), tid = rtid & 255, lane = tid & 63, wave = tid >> 6;
  float* bufs = (float*)gsm;
  const int tsk_ = ((blk & 7) * 4 + ((blk >> 3) >> 3)) * 8 + ((blk >> 3) & 7);
  const int bh = tsk_ >> 3, b = bh >> 3, h = bh & 7, rowbase = (tsk_ & 7) * 8;
  const size_t bS = (size_t)b * SEQ;
  char* ws = p.ws;
  if (vb == 1) {
    const int pair = tid >> 4, l15 = tid & 15, c4 = l15 * 4;
    const size_t cofs = (size_t)h * 64 + c4;
    const h16* aW = (const h16*)(ws + OFF_W16) + cofs;
    const h16* aP = (const h16*)(ws + OFF_KK) + cofs;
    const h16* aA = (const h16*)(ws + OFF_KKA) + cofs;
    const h16* aK = (const h16*)(ws + OFF_KP) + cofs;
    const h16* aR = (const h16*)(ws + OFF_R) + cofs;
    const h16* aV = (const h16*)(ws + OFF_V) + (size_t)h * 64 + rowbase;
    const int lhalf = blk & 1, lseg = (blk >> 1) & 31, lb_ = blk >> 6;
    const int lc = lhalf * 256 + tid;
    const size_t lbase = ((size_t)lb_ * SEQ + lseg * 256) * 512 + lc;
    h16* lla = (h16*)(ws + OFF_LLA) + lbase;
    h16* lbb = (h16*)(ws + OFF_LB) + lbase;
    float lhs = 0.f, lap = 1.f;
    h16x4 nw1, nw2, np1, np2, na1, na2, nk1, nk2, nr1, nr2;
    h16x8 nv1, nv2;
    {
      const size_t tok = bS + pair * 2;
      nw1 = *(const h16x4*)(aW + tok * 512); nw2 = *(const h16x4*)(aW + (tok + 1) * 512);
      np1 = *(const h16x4*)(aP + tok * 512); np2 = *(const h16x4*)(aP + (tok + 1) * 512);
      na1 = *(const h16x4*)(aA + tok * 512); na2 = *(const h16x4*)(aA + (tok + 1) * 512);
      nk1 = *(const h16x4*)(aK + tok * 512); nk2 = *(const h16x4*)(aK + (tok + 1) * 512);
      nr1 = *(const h16x4*)(aR + tok * 512); nr2 = *(const h16x4*)(aR + (tok + 1) * 512);
      if (l15 == 1) { nv1 = *(const h16x8*)(aV + tok * 512); nv2 = *(const h16x8*)(aV + (tok + 1) * 512); }
    }
#pragma unroll 1
    for (int tile = 0; tile < SEQ / 32; tile++) {
      const h16x4 hw1 = nw1, hw2 = nw2, hp1 = np1, hp2 = np2, ha1 = na1, ha2 = na2, hk1 = nk1, hk2 = nk2, hr1 = nr1, hr2 = nr2;
      const h16x8 hv1 = nv1, hv2 = nv2;
      const h16 l_a = lla[(size_t)tile * 512], l_b = lbb[(size_t)tile * 512];
      if (tile + 1 < SEQ / 32) {
        const size_t tok = bS + (size_t)(tile + 1) * 32 + pair * 2;
        nw1 = *(const h16x4*)(aW + tok * 512); nw2 = *(const h16x4*)(aW + (tok + 1) * 512);
        np1 = *(const h16x4*)(aP + tok * 512); np2 = *(const h16x4*)(aP + (tok + 1) * 512);
        na1 = *(const h16x4*)(aA + tok * 512); na2 = *(const h16x4*)(aA + (tok + 1) * 512);
        nk1 = *(const h16x4*)(aK + tok * 512); nk2 = *(const h16x4*)(aK + (tok + 1) * 512);
        nr1 = *(const h16x4*)(aR + tok * 512); nr2 = *(const h16x4*)(aR + (tok + 1) * 512);
        if (l15 == 1) { nv1 = *(const h16x8*)(aV + tok * 512); nv2 = *(const h16x8*)(aV + (tok + 1) * 512); }
      }
      f32x4 P1, P2p, R1p, R2p, W12, AW, KW, A2, K2;
      float sc[8];
#pragma unroll
      for (int e = 0; e < 8; e++) sc[e] = 0.f;
#pragma unroll
      for (int e = 0; e < 4; e++) {
        const float W1 = __expf(-__expf((float)hw1[e])), W2 = __expf(-__expf((float)hw2[e]));
        const float p1 = (float)hp1[e], p2 = (float)hp2[e], a1 = (float)ha1[e], a2 = (float)ha2[e];
        const float k1 = (float)hk1[e], k2 = (float)hk2[e], r1 = (float)hr1[e], r2 = (float)hr2[e];
        const float w12 = W1 * W2, aw = a1 * W2, kw = k1 * W2;
        P1[e] = p1; P2p[e] = W1 * p2; R1p[e] = W1 * r1; R2p[e] = w12 * r2; W12[e] = w12; AW[e] = aw; KW[e] = kw; A2[e] = a2; K2[e] = k2;
        sc[0] += a1 * p2; sc[1] += k1 * p2; sc[2] += a1 * r1; sc[3] += k1 * r1;
        sc[4] += aw * r2; sc[5] += kw * r2; sc[6] += a2 * r2; sc[7] += k2 * r2;
      }
#pragma unroll
      for (int e = 0; e < 8; e++) sc[e] = reduce16(sc[e]);
      float* rec = bufs + (tile & 1) * (16 * PR_NF) + pair * PR_NF;
      *(f32x4*)(rec + c4) = P1;        *(f32x4*)(rec + 64 + c4) = P2p;  *(f32x4*)(rec + 128 + c4) = R1p;
      *(f32x4*)(rec + 192 + c4) = R2p; *(f32x4*)(rec + 256 + c4) = W12; *(f32x4*)(rec + 320 + c4) = AW;
      *(f32x4*)(rec + 384 + c4) = KW;  *(f32x4*)(rec + 448 + c4) = A2;  *(f32x4*)(rec + 512 + c4) = K2;
      if (l15 == 0) {
        f32x4 s0 = {sc[0], sc[1], sc[2], sc[3]}, s1 = {sc[4], sc[5], sc[6], sc[7]};
        *(f32x4*)(rec + 576) = s0; *(f32x4*)(rec + 580) = s1;
      }
      if (l15 == 1) {
#pragma unroll
        for (int r = 0; r < 8; r++) { rec[584 + r] = (float)hv1[r]; rec[592 + r] = (float)hv2[r]; }
      }
      {
        const float a_ = __expf((float)l_a);
        lhs = fmaf(a_, lhs, (float)l_b);
        lap *= a_;
        if (!dry) { lbb[(size_t)tile * 512] = (h16)lhs; lla[(size_t)tile * 512] = (h16)lap; }
      }
      LDS_BARRIER();
    }
    LDS_BARRIER();
    if (!dry) {
      ((float*)(ws + OFF_SUMA))[(lb_ * 32 + lseg) * 512 + lc] = lap;
      ((float*)(ws + OFF_SUMH))[(lb_ * 32 + lseg) * 512 + lc] = lhs;
    }
  } else {
    const int sub = (lane & 15) + ((lane >> 5) << 4), row = wave * 2 + ((lane >> 4) & 1);
    const float m0 = (sub == 0) ? 1.f : 0.f;
    h16* outp = (h16*)(ws + OFF_V) + bS * 512 + (size_t)h * 64 + rowbase;
    f32x2 s = {0.f, 0.f};
    LDS_BARRIER();
#pragma unroll 1
    for (int tile = 0; tile < SEQ / 32; tile++) {
      const float* recb = bufs + (tile & 1) * (16 * PR_NF);
      float yk = 0.f;
#pragma unroll 1
      for (int hb = 0; hb < 2; hb++) {
        float yp[16];
        f32x2 nP1, nP2p, nR1p, nR2p, nW12, nAW, nKW, nA2, nK2; f32x4 nc0, nc1; float nv1, nv2;
        {
          const float* rc = recb + (hb * 8) * PR_NF;
          nP1 = *(const f32x2*)(rc + sub * 2); nP2p = *(const f32x2*)(rc + 64 + sub * 2);
          nR1p = *(const f32x2*)(rc + 128 + sub * 2); nR2p = *(const f32x2*)(rc + 192 + sub * 2);
          nW12 = *(const f32x2*)(rc + 256 + sub * 2); nAW = *(const f32x2*)(rc + 320 + sub * 2);
          nKW = *(const f32x2*)(rc + 384 + sub * 2); nA2 = *(const f32x2*)(rc + 448 + sub * 2); nK2 = *(const f32x2*)(rc + 512 + sub * 2);
          nc0 = *(const f32x4*)(rc + 576); nc1 = *(const f32x4*)(rc + 580);
          nv1 = rc[584 + row]; nv2 = rc[592 + row];
        }
#pragma unroll
        for (int jp = 0; jp < 8; jp++) {
          const f32x2 P1 = nP1, P2p = nP2p, R1p = nR1p, R2p = nR2p, W12 = nW12, AW = nAW, KW = nKW, A2 = nA2, K2 = nK2;
          const f32x4 c0 = nc0, c1 = nc1;
          const float v1 = nv1, v2 = nv2;
          if (jp + 1 < 8) {
            const float* rc = recb + (hb * 8 + jp + 1) * PR_NF;
            nP1 = *(const f32x2*)(rc + sub * 2); nP2p = *(const f32x2*)(rc + 64 + sub * 2);
            nR1p = *(const f32x2*)(rc + 128 + sub * 2); nR2p = *(const f32x2*)(rc + 192 + sub * 2);
            nW12 = *(const f32x2*)(rc + 256 + sub * 2); nAW = *(const f32x2*)(rc + 320 + sub * 2);
            nKW = *(const f32x2*)(rc + 384 + sub * 2); nA2 = *(const f32x2*)(rc + 448 + sub * 2); nK2 = *(const f32x2*)(rc + 512 + sub * 2);
            nc0 = *(const f32x4*)(rc + 576); nc1 = *(const f32x4*)(rc + 580);
            nv1 = rc[584 + row]; nv2 = rc[592 + row];
          }
          float d1 = s[0] * P1[0] + s[1] * P1[1];
          float d2 = s[0] * P2p[0] + s[1] * P2p[1];
          float y1 = s[0] * R1p[0] + s[1] * R1p[1];
          float y2 = s[0] * R2p[0] + s[1] * R2p[1];
          d1 += dpp_f<0xB1>(d1); d2 += dpp_f<0xB1>(d2);
          d1 += dpp_f<0x4E>(d1); d2 += dpp_f<0x4E>(d2);
          d1 += dpp_f<0x141>(d1); d2 += dpp_f<0x141>(d2);
          d1 += dpp_f<0x140>(d1); d2 += dpp_f<0x140>(d2);
          {
            auto r1 = __builtin_amdgcn_permlane32_swap(__float_as_uint(d1), __float_as_uint(d1), false, false);
            auto r2 = __builtin_amdgcn_permlane32_swap(__float_as_uint(d2), __float_as_uint(d2), false, false);
            d1 = __uint_as_float(r1[0]) + __uint_as_float(r1[1]);
            d2 = __uint_as_float(r2[0]) + __uint_as_float(r2[1]);
          }
          d2 = d2 - d1 * c0[0] + v1 * c0[1];
          const f32x2 base = s * W12 + (f32x2{v1, v1} * KW - f32x2{d1, d1} * AW);
          s = base + (f32x2{v2, v2} * K2 - f32x2{d2, d2} * A2);
          y1 += m0 * (v1 * c0[3] - d1 * c0[2]);
          y2 += m0 * (v1 * c1[1] - d1 * c1[0] + v2 * c1[3] - d2 * c1[2]);
          yp[2 * jp] = y1; yp[2 * jp + 1] = y2;
        }
        const float q1 = treduce16(yp, lane);
        yk = ((sub >> 4) == hb) ? q1 : yk;
      }
      if (!dry) outp[(size_t)(tile * 32 + sub) * 512 + row] = (h16)yk;
      LDS_BARRIER();
    }
  }
}

__device__ void even_pre(const Params& p, char* smem) {
  const int tid = get_tid(), lane = tid & 63, wave = tid >> 6;
  const h16* P = (const h16*)(p.ws + OFF_BIG);
  for (int blk = get_bid(); blk < MTOK / 64; blk += VGRID) {
    const int tgs = blk * 64;
    const int t0 = tgs & (SEQ - 1);
    if (wave < 3) {
      const int c0 = wave * 512 + lane * 8;
      const float* cw = p.in[10];
      float cwr[4][8];
#pragma unroll
      for (int j = 0; j < 4; j++) {
        f32x4 x0 = *(const f32x4*)(cw + j * 1536 + c0), x1 = *(const f32x4*)(cw + j * 1536 + c0 + 4);
#pragma unroll
        for (int e = 0; e < 4; e++) { cwr[j][e] = x0[e]; cwr[j][4 + e] = x1[e]; }
      }
      h16* dst = (h16*)(p.ws + (wave == 0 ? OFF_GQ : wave == 1 ? OFF_GK : OFF_GV)) + lane * 8;
      const h16* src = P + 1552 + c0;
      h16x8 xm[3];
#pragma unroll
      for (int j = 0; j < 3; j++) {
#pragma unroll
        for (int e = 0; e < 8; e++) xm[j][e] = (h16)0.f;
        if (t0 > 0) xm[j] = *(const h16x8*)(src + (size_t)(tgs - 3 + j) * EINP);
      }
      const float qs = (wave == 0) ? 0.08838834764831845f : 1.f;
#pragma unroll 1
      for (int tb = 0; tb < 64; tb += 4) {
        h16x8 xn[4];
#pragma unroll
        for (int u = 0; u < 4; u++) xn[u] = *(const h16x8*)(src + (size_t)(tgs + tb + u) * EINP);
#pragma unroll
        for (int u = 0; u < 4; u++) {
          float val[8];
          float ss = 0.f;
#pragma unroll
          for (int e = 0; e < 8; e++) {
            float v = (float)xm[0][e] * cwr[0][e] + (float)xm[1][e] * cwr[1][e] + (float)xm[2][e] * cwr[2][e] + (float)xn[u][e] * cwr[3][e];
            v = silu_(v);
            val[e] = v;
            ss += v * v;
          }
          float sc = 1.f;
          if (wave < 2) { ss = reduce16(ss); sc = rsqrtf(ss + 1e-6f) * qs; }
          h16x8 o;
#pragma unroll
          for (int e = 0; e < 8; e++) o[e] = (h16)(val[e] * sc);
          *(h16x8*)(dst + (size_t)(tgs + tb + u) * 512) = o;
          xm[0] = xm[1]; xm[1] = xm[2]; xm[2] = xn[u];
        }
      }
    } else {
      const int c4 = lane * 4;
      const float* w2 = p.in[7];
      float w2r[16][4];
#pragma unroll
      for (int j = 0; j < 16; j++) {
        f32x4 x0 = *(const f32x4*)(w2 + j * 256 + c4);
#pragma unroll
        for (int e = 0; e < 4; e++) w2r[j][e] = x0[e];
      }
      const f32x4 lb4 = *(const f32x4*)(p.in[8] + c4);
      h16* ELA = (h16*)(p.ws + OFF_ELA);
      float* AB = (float*)(p.ws + OFF_AB);
      const float alog = (lane < 4) ? p.in[11][lane] : 0.f, dtb = (lane < 4) ? p.in[12][lane] : 0.f;
#pragma unroll 2
      for (int tok = 0; tok < 64; tok++) {
        const size_t tg = (size_t)tgs + tok;
        const h16* pr = P + tg * EINP + 1536;
        h16x8 g0 = *(const h16x8*)(pr), g1 = *(const h16x8*)(pr + 8);
        float z[4] = {lb4[0], lb4[1], lb4[2], lb4[3]};
#pragma unroll
        for (int j = 0; j < 16; j++) {
          const float gj = (float)(j < 8 ? g0[j] : g1[j - 8]);
#pragma unroll
          for (int e = 0; e < 4; e++) z[e] = fmaf(gj, w2r[j][e], z[e]);
        }
        h16x4 o;
#pragma unroll
        for (int e = 0; e < 4; e++) o[e] = (h16)(-softplus_(-z[e]) * (1.f / 16.f));
        *(h16x4*)(ELA + tg * 256 + c4) = o;
        if (lane < 4) {
          float da = (float)P[tg * EINP + 3600 + lane];
          float db = (float)P[tg * EINP + 3604 + lane];
          float g = -__expf(alog) * softplus_(da + dtb);
          AB[(tg * 4 + lane) * 2 + 0] = __expf(g);
          AB[(tg * 4 + lane) * 2 + 1] = sigm(db);
        }
      }
    }
  }
}

__device__ void even_post(const Params& p) {
  const int lane = get_tid() & 63;
  const int gw = get_bid() * 4 + (get_tid() >> 6);
  const int nw = VGRID * 4;
  const int half = gw & 1, c8 = lane * 8;
  const h16* __restrict__ P = (const h16*)(p.ws + OFF_BIG);
  const h16* __restrict__ GV = (const h16*)(p.ws + OFF_GV);
  h16* __restrict__ Y = (h16*)(p.ws + OFF_HH);
  const float* nwp = (half ? p.in[13] : p.in[9]) + (c8 & 127);
  float wn[8];
#pragma unroll
  for (int e = 0; e < 8; e++) wn[e] = nwp[e];
  const int tstep = nw >> 1;
  for (int tg = gw >> 1; tg < MTOK; tg += 2 * tstep) {
    h16x8 o[2], z[2];
#pragma unroll
    for (int u = 0; u < 2; u++) {
      const int t = tg + u * tstep;
      if (t < MTOK) {
        const h16* pr = P + (size_t)t * EINP;
        o[u] = half ? *(const h16x8*)(GV + (size_t)t * 512 + c8) : *(const h16x8*)(pr + 512 + c8);
        z[u] = *(const h16x8*)(pr + (half ? 3088 : 1024) + c8);
      }
    }
#pragma unroll
    for (int u = 0; u < 2; u++) {
      const int t = tg + u * tstep;
      if (t < MTOK) {
        float of[8], ss = 0.f;
#pragma unroll
        for (int e = 0; e < 8; e++) { of[e] = (float)o[u][e]; ss += of[e] * of[e]; }
        ss = reduce16(ss);
        const float inv = rsqrtf(ss * (1.f / 128.f) + 1e-6f);
        h16x8 r;
#pragma unroll
        for (int e = 0; e < 8; e++) r[e] = (h16)(of[e] * inv * wn[e] * silu_((float)z[u][e]));
        *(h16x8*)(Y + (size_t)t * DM + half * 512 + c8) = r;
      }
    }
  }
}

__device__ __forceinline__ float psmix(const h16* __restrict__ P, const float* __restrict__ mu, size_t tg, int t, int c) {
  float cur = (float)P[tg * OIN + c];
  float prev = (t > 0) ? (float)P[(tg - 1) * OIN + c] : 0.f;
  return cur + (prev - cur) * mu[c];
}
__device__ __forceinline__ float psmixm(const h16* __restrict__ P, float m, size_t tg, int t, int c) {
  float cur = (float)P[tg * OIN + c];
  float prev = (t > 0) ? (float)P[(tg - 1) * OIN + c] : 0.f;
  return cur + (prev - cur) * m;
}
__device__ __forceinline__ void psmix8(const h16* __restrict__ P, const float* __restrict__ mu, size_t tg, int t, int c0, float* o) {
  h16x8 cur = *(const h16x8*)(P + tg * OIN + c0);
  h16x8 prv = cur;
  if (t > 0) prv = *(const h16x8*)(P + (tg - 1) * OIN + c0);
  f32x4 m0 = *(const f32x4*)(mu + c0), m1 = *(const f32x4*)(mu + c0 + 4);
#pragma unroll
  for (int j = 0; j < 8; j++) {
    float cf = (float)cur[j];
    float pf = (t > 0) ? (float)prv[j] : 0.f;
    o[j] = cf + (pf - cf) * (j < 4 ? m0[j] : m1[j - 4]);
  }
}
__device__ __forceinline__ float half_sum(float x, int lane) {
  x = reduce16(x);
  const unsigned xi = __float_as_uint(x);
  auto r = __builtin_amdgcn_permlane16_swap(xi, xi, false, false);
  return __uint_as_float(r[0]) + __uint_as_float(r[1]);
}

#define OFF_SW (483 * MIB)
#define SW_W2T 0
#define SW_A2T 32768
#define SW_WAT 65536
#define SW_WXT 98304
#define SW_G2T 131072
__device__ void convert_small(const Params& p) {
  h16* sw = (h16*)(p.ws + OFF_SW);
  for (int idx = get_bid() * 256 + get_tid(); idx < 196608; idx += VGRID * 256) {
    float v;
    if (idx < 131072) {
      const int which = idx >> 15, n = (idx >> 6) & 511, k = idx & 63;
      if (which == 0) v = p.in[18][k * 512 + n];
      else if (which == 1) v = p.in[20][k * 512 + n];
      else if (which == 2) v = p.in[29][((n >> 6) * 64 + k) * 64 + (n & 63)];
      else v = p.in[31][((n >> 6) * 64 + k) * 64 + (n & 63)];
    } else {
      const int j = idx - 131072, n = j >> 7, k = j & 127;
      v = p.in[21][k * 512 + n];
    }
    sw[idx] = (h16)v;
  }
}

#define TLD 136
__device__ void odd_pre(const Params& p, char* smem) {
  const int tid = get_tid(), lane = tid & 63, wave = tid >> 6;
  const int l31 = lane & 31, lh = lane >> 5;
  const h16* P = (const h16*)(p.ws + OFF_BIG);
  const float* mu = p.in[16];
  const h16* sw = (const h16*)(p.ws + OFF_SW);
  for (int job = get_bid(); job < 2048; job += VGRID) {
    if (job < 1024) {
#ifndef NO_RWKVPRE
      const int tg0 = job * 32, t0 = tg0 & (SEQ - 1);
      h16* AL = (h16*)smem;
#pragma unroll
      for (int i = 0; i < 2; i++) {
        const int e = tid + i * 256, tok = e >> 4, ch = e & 15;
        float o[8];
        psmix8(P, mu, (size_t)tg0 + tok, t0 + tok, 1536 + ch * 8, o);
        h16x8 hv;
#pragma unroll
        for (int j = 0; j < 8; j++) hv[j] = (h16)(ch < 8 ? fast_tanh(o[j]) : o[j]);
        *(h16x8*)(AL + tok * TLD + ch * 8) = hv;
      }
      LDS_BARRIER();
      h16* W16 = (h16*)(p.ws + OFF_W16);
      h16* KK = (h16*)(p.ws + OFF_KK);
      h16* KKA = (h16*)(p.ws + OFF_KKA);
      h16* KP = (h16*)(p.ws + OFF_KP);
      h16* RR = (h16*)(p.ws + OFF_R);
      h16* VV = (h16*)(p.ws + OFF_V);
      float* BON = (float*)(p.ws + OFF_BON);
#pragma unroll 1
      for (int hh = 0; hh < 2; hh++) {
        const int head = wave * 2 + hh;
        f32x16 accw[2], acca[2];
#pragma unroll
        for (int n = 0; n < 2; n++)
#pragma unroll
          for (int r = 0; r < 16; r++) { accw[n][r] = 0.f; acca[n][r] = 0.f; }
#pragma unroll
        for (int ks = 0; ks < 4; ks++) {
          h16x8 aw = *(const h16x8*)(AL + l31 * TLD + ks * 16 + lh * 8);
          h16x8 aa = *(const h16x8*)(AL + l31 * TLD + 64 + ks * 16 + lh * 8);
#pragma unroll
          for (int q = 0; q < 2; q++) {
            const int n = wave * 128 + (hh * 2 + q) * 32 + l31;
            h16x8 bw = *(const h16x8*)(sw + SW_W2T + n * 64 + ks * 16 + lh * 8);
            h16x8 ba = *(const h16x8*)(sw + SW_A2T + n * 64 + ks * 16 + lh * 8);
            accw[q] = __builtin_amdgcn_mfma_f32_32x32x16_f16(aw, bw, accw[q], 0, 0, 0);
            acca[q] = __builtin_amdgcn_mfma_f32_32x32x16_f16(aa, ba, acca[q], 0, 0, 0);
          }
        }
        float w0c[2], a0c[2], kkc[2], kac[2], rkc[2], mur[2], muk[2], muv[2];
#pragma unroll
        for (int q = 0; q < 2; q++) {
          const int c = wave * 128 + (hh * 2 + q) * 32 + l31;
          w0c[q] = p.in[17][c]; a0c[q] = p.in[19][c]; kkc[q] = p.in[22][c]; kac[q] = p.in[23][c]; rkc[q] = p.in[24][c];
          mur[q] = mu[c]; muk[q] = mu[512 + c]; muv[q] = mu[1024 + c];
        }
        int tgb = tg0;
#pragma unroll
        for (int r = 0; r < 16; r++) {
          if ((r & 3) == 0) asm volatile("" : "+s"(tgb));
          const int tr = (r & 3) + 8 * (r >> 2) + 4 * lh;
          const size_t tg = (size_t)tgb + tr;
          const int t = (tgb & (SEQ - 1)) + tr;
          float kr[2], av[2];
          float ssp = 0.f, bonp = 0.f;
#pragma unroll
          for (int q = 0; q < 2; q++) {
            const int nt = hh * 2 + q;
            const int c = wave * 128 + nt * 32 + l31;
            float r_ = psmixm(P, mur[q], tg, t, c);
            float k_ = psmixm(P, muk[q], tg, t, 512 + c);
            float v_ = psmixm(P, muv[q], tg, t, 1024 + c);
            float w = -softplus_(-(w0c[q] + accw[q][r])) - 0.5f;
            float a = sigm(a0c[q] + acca[q][r]);
            kr[q] = k_ * kkc[q];
            av[q] = a;
            float kp = k_ * (1.f + (a - 1.f) * kac[q]);
            ssp += kr[q] * kr[q];
            bonp += r_ * kp * rkc[q];
            W16[tg * 512 + c] = (h16)w;
            KP[tg * 512 + c] = (h16)kp;
            RR[tg * 512 + c] = (h16)r_;
            VV[tg * 512 + c] = (h16)v_;
          }
          const float ss = half_sum(ssp, lane);
          const float bon = half_sum(bonp, lane);
          const float inv = rsqrtf(ss + 1e-6f);
#pragma unroll
          for (int q = 0; q < 2; q++) {
            const int c = wave * 128 + (hh * 2 + q) * 32 + l31;
            const float kk = kr[q] * inv;
            KK[tg * 512 + c] = (h16)kk;
            KKA[tg * 512 + c] = (h16)(kk * av[q]);
          }
          if (l31 == 0) BON[tg * 8 + head] = bon;
          if ((r & 3) == 3) asm volatile("" ::: "memory");
        }
      }
      LDS_BARRIER();
#endif
    } else {
#ifndef NO_LRUPRE
      const int tg0 = (job - 1024) * 32, t0 = tg0 & (SEQ - 1);
      h16* XB = (h16*)smem + wave * (32 * TLD);
      {
        const int ch = lane & 15, tq = lane >> 4;
        const int c0 = wave * 128 + ch * 8;
        const float* cw = p.in[27];
        float cwr[4][8], cbr[8];
#pragma unroll
        for (int j = 0; j < 4; j++) {
          f32x4 x0 = *(const f32x4*)(cw + j * 512 + c0), x1 = *(const f32x4*)(cw + j * 512 + c0 + 4);
#pragma unroll
          for (int e = 0; e < 4; e++) { cwr[j][e] = x0[e]; cwr[j][4 + e] = x1[e]; }
        }
        {
          f32x4 x0 = *(const f32x4*)(p.in[28] + c0), x1 = *(const f32x4*)(p.in[28] + c0 + 4);
#pragma unroll
          for (int e = 0; e < 4; e++) { cbr[e] = x0[e]; cbr[4 + e] = x1[e]; }
        }
        h16x8 x[11];
#pragma unroll
        for (int j = 0; j < 11; j++) {
          const int tt = tq * 8 - 3 + j;
          h16x8 z;
#pragma unroll
          for (int e = 0; e < 8; e++) z[e] = (h16)0.f;
          x[j] = z;
          if (t0 + tt >= 0) x[j] = *(const h16x8*)(P + (size_t)((long)tg0 + tt) * OIN + 1792 + c0);
        }
#pragma unroll
        for (int tok = 0; tok < 8; tok++) {
          h16x8 hv;
#pragma unroll
          for (int e = 0; e < 8; e++) {
            float xb = cbr[e] + (float)x[tok][e] * cwr[0][e] + (float)x[tok + 1][e] * cwr[1][e] +
                       (float)x[tok + 2][e] * cwr[2][e] + (float)x[tok + 3][e] * cwr[3][e];
            hv[e] = (h16)xb;
          }
          *(h16x8*)(XB + (tq * 8 + tok) * TLD + ch * 8) = hv;
        }
      }
      LDS_BARRIER();
      h16* LLA = (h16*)(p.ws + OFF_LLA);
      h16* LB = (h16*)(p.ws + OFF_LB);
#pragma unroll 1
      for (int blk = 0; blk < 2; blk++) {
        f32x16 accr[2], acci[2];
#pragma unroll
        for (int n = 0; n < 2; n++)
#pragma unroll
          for (int r = 0; r < 16; r++) { accr[n][r] = 0.f; acci[n][r] = 0.f; }
#pragma unroll
        for (int ks = 0; ks < 4; ks++) {
          h16x8 a = *(const h16x8*)(XB + l31 * TLD + blk * 64 + ks * 16 + lh * 8);
#pragma unroll
          for (int q = 0; q < 2; q++) {
            const int n = wave * 128 + (blk * 2 + q) * 32 + l31;
            h16x8 br, bi;
#pragma unroll
            for (int j = 0; j < 8; j++) {
              br[j] = (h16)p.in[29][((n >> 6) * 64 + ks * 16 + lh * 8 + j) * 64 + (n & 63)];
              bi[j] = (h16)p.in[31][((n >> 6) * 64 + ks * 16 + lh * 8 + j) * 64 + (n & 63)];
            }
            accr[q] = __builtin_amdgcn_mfma_f32_32x32x16_f16(a, br, accr[q], 0, 0, 0);
            acci[q] = __builtin_amdgcn_mfma_f32_32x32x16_f16(a, bi, acci[q], 0, 0, 0);
          }
        }
#pragma unroll
        for (int q = 0; q < 2; q++) {
          const int nt = blk * 2 + q;
          const int c = wave * 128 + nt * 32 + l31;
          const float bac = p.in[30][c], bxc = p.in[32][c];
          const float spl = softplus_(-p.in[33][c]);
          int tgb = tg0;
#pragma unroll
          for (int r = 0; r < 16; r++) {
            if ((r & 7) == 0) asm volatile("" : "+s"(tgb));
            const int tr = (r & 3) + 8 * (r >> 2) + 4 * lh;
            const size_t tg = (size_t)tgb + tr;
            float gr = sigm(accr[q][r] + bac);
            float gi = sigm(acci[q][r] + bxc);
            float la = -8.f * gr * spl;
            float mult = __builtin_amdgcn_sqrtf(fmaxf(1.f - __expf(2.f * la), 0.f));
            float xbv = (float)XB[tr * TLD + nt * 32 + l31];
            LLA[tg * 512 + c] = (h16)la;
            LB[tg * 512 + c] = (h16)(mult * gi * xbv);
            if ((r & 7) == 7) asm volatile("" ::: "memory");
          }
        }
      }
      LDS_BARRIER();
#endif
    }
  }
}

__device__ void odd_post(const Params& p, char* smem) {
  const int tid = get_tid(), lane = tid & 63, wave = tid >> 6;
  const int l31 = lane & 31, lh = lane >> 5;
  const h16* P = (const h16*)(p.ws + OFF_BIG);
  const float* mu = p.in[16];
  const h16* G2T = (const h16*)(p.ws + OFF_SW) + SW_G2T;
  const h16* YS = (const h16*)(p.ws + OFF_V);
  const h16* HL = (const h16*)(p.ws + OFF_LB);
  const h16* CA = (const h16*)(p.ws + OFF_LLA);
  const float* BON = (const float*)(p.ws + OFF_BON);
  h16* Y = (h16*)(p.ws + OFF_HH);
  h16* SG = (h16*)smem;
#ifndef NO_POST
  for (int job = get_bid(); job < 1024; job += VGRID) {
    const int tg0 = job * 32, t0 = tg0 & (SEQ - 1);
#pragma unroll
    for (int i = 0; i < 2; i++) {
      const int e = tid + i * 256, tok = e >> 4, ch = e & 15;
      float o[8];
      psmix8(P, mu, (size_t)tg0 + tok, t0 + tok, 1664 + ch * 8, o);
      h16x8 hv;
#pragma unroll
      for (int j = 0; j < 8; j++) hv[j] = (h16)sigm(o[j]);
      *(h16x8*)(SG + tok * TLD + ch * 8) = hv;
    }
    LDS_BARRIER();
    {
      const int c8 = lane * 8, tq = wave;
      float hin[8];
#pragma unroll
      for (int e = 0; e < 8; e++) hin[e] = 0.f;
      const int bq = tg0 >> 13, seg = t0 >> 8;
      const float* SA = (const float*)(p.ws + OFF_SUMA) + (size_t)bq * 32 * 512 + c8;
      const float* SH = (const float*)(p.ws + OFF_SUMH) + (size_t)bq * 32 * 512 + c8;
      for (int sq = 0; sq < seg; sq++) {
        const f32x4 a0 = *(const f32x4*)(SA + sq * 512), a1 = *(const f32x4*)(SA + sq * 512 + 4);
        const f32x4 h0 = *(const f32x4*)(SH + sq * 512), h1 = *(const f32x4*)(SH + sq * 512 + 4);
#pragma unroll
        for (int e = 0; e < 4; e++) { hin[e] = fmaf(a0[e], hin[e], h0[e]); hin[4 + e] = fmaf(a1[e], hin[4 + e], h1[e]); }
      }
#pragma unroll 2
      for (int tk = 0; tk < 8; tk++) {
        const size_t tg = (size_t)tg0 + tq * 8 + tk;
        const h16x8 hl = *(const h16x8*)(HL + tg * 512 + c8);
        const h16x8 ca = *(const h16x8*)(CA + tg * 512 + c8);
        const h16x8 ly = *(const h16x8*)(P + tg * OIN + 2304 + c8);
        h16x8 o;
#pragma unroll
        for (int e = 0; e < 8; e++) o[e] = (h16)(((float)hl[e] + (float)ca[e] * hin[e]) * gelu_tanh((float)ly[e]));
        *(h16x8*)(Y + tg * DM + 512 + c8) = o;
      }
    }
#pragma unroll 1
    for (int hh = 0; hh < 2; hh++) {
      const int head = wave * 2 + hh;
      f32x16 accg[2];
#pragma unroll
      for (int n = 0; n < 2; n++)
#pragma unroll
        for (int r = 0; r < 16; r++) accg[n][r] = 0.f;
#pragma unroll
      for (int ks = 0; ks < 8; ks++) {
        h16x8 a = *(const h16x8*)(SG + l31 * TLD + ks * 16 + lh * 8);
#pragma unroll
        for (int q = 0; q < 2; q++) {
          const int n = wave * 128 + (hh * 2 + q) * 32 + l31;
          h16x8 bg = *(const h16x8*)(G2T + n * 128 + ks * 16 + lh * 8);
          accg[q] = __builtin_amdgcn_mfma_f32_32x32x16_f16(a, bg, accg[q], 0, 0, 0);
        }
      }
      float lnw[2], lnb[2], muv[2];
#pragma unroll
      for (int q = 0; q < 2; q++) {
        const int c = wave * 128 + (hh * 2 + q) * 32 + l31;
        lnw[q] = p.in[25][c]; lnb[q] = p.in[26][c]; muv[q] = mu[1024 + c];
      }
      int tgb = tg0;
#pragma unroll
      for (int r = 0; r < 16; r++) {
        if ((r & 3) == 0) asm volatile("" : "+s"(tgb));
        const int tr = (r & 3) + 8 * (r >> 2) + 4 * lh;
        const size_t tg = (size_t)tgb + tr;
        const int t = (tgb & (SEQ - 1)) + tr;
        float y[2];
#pragma unroll
        for (int q = 0; q < 2; q++) y[q] = (float)YS[tg * 512 + wave * 128 + (hh * 2 + q) * 32 + l31];
        const float mean = half_sum(y[0] + y[1], lane) * (1.f / 64.f);
        const float d0 = y[0] - mean, d1 = y[1] - mean;
        const float var = half_sum(d0 * d0 + d1 * d1, lane) * (1.f / 64.f);
        const float rs = rsqrtf(var + 64e-5f);
        const float bon = BON[tg * 8 + head];
#pragma unroll
        for (int q = 0; q < 2; q++) {
          const int nt = hh * 2 + q;
          const int c = wave * 128 + nt * 32 + l31;
          const float yn = (q == 0 ? d0 : d1) * rs * lnw[q] + lnb[q];
          const float v = psmixm(P, muv[q], tg, t, 1024 + c);
          Y[tg * DM + c] = (h16)((yn + bon * v) * accg[q][r]);
        }
        if ((r & 3) == 3) asm volatile("" ::: "memory");
      }
    }
    LDS_BARRIER();
  }
#endif
}

__device__ void run_phase(const Params& pin, int ph, char* gsm, int dry) {
  char* smem = gsm + (size_t)__builtin_amdgcn_readfirstlane(threadIdx.x >> 8) * 65536;
  Params p = pin;
  asm volatile("" : "+s"(p.ws));
  char* ws = p.ws;
  h16* wb = (h16*)(ws + OFF_WB);
  h16* HH = (h16*)(ws + OFF_HH);
  h16* BIG = (h16*)(ws + OFF_BIG);
  h16* DMb = (h16*)(ws + OFF_DM);
  const float* nw = p.in[1];
  if (ph == 0) {
    convert_weights(p, 0, (float*)smem);
    row_phase(p.in[0], nullptr, nullptr, 0.f, nw, nullptr, HH);
    return;
  }
  const int L = (ph - 1) / 12, s = (ph - 1) % 12;
  const float* nwl = nw + (size_t)L * 6 * DM;
  if (s == 0 || s == 1 || s == 3 || s == 7 || s == 9 || s == 10) {
    const h16* Ap; const h16* Bp; int K, nN, ldc, epi; void* Cp;
    if (s == 0 || s == 9) { Ap = HH; Bp = wb + (s == 0 ? WGU0 : WGU1); K = DM; nN = 22; Cp = BIG; ldc = DFF; epi = 2; }
    else if (s == 1 || s == 10) { Ap = BIG; Bp = wb + (s == 1 ? WD0 : WD1); K = DFF; nN = 4; Cp = DMb; ldc = DM; epi = 1; }
    else if (s == 3) { Ap = HH; Bp = wb + WIN; K = DM; nN = (L == 0) ? 15 : 11; Cp = BIG; ldc = (L == 0) ? EINP : OIN; epi = 1; }
    else { Ap = HH; Bp = wb + WOUT; K = DM; nN = 4; Cp = DMb; ldc = DM; epi = 1; }
    if (epi == 0) gemm_phase<0>(Ap, Bp, K, 128, nN, Cp, ldc, ldc, gsm);
    else if (epi == 1) gemm_phase<1>(Ap, Bp, K, 128, nN, Cp, ldc, ldc, gsm);
    else gemm_phase<2>(Ap, Bp, K, 128, nN, Cp, ldc, ldc, gsm);
    return;
  }
  switch (s) {
    case 2:
      row_phase(L == 0 ? p.in[0] : p.out, DMb, nwl + 1 * DM, 0.5f, nwl + 2 * DM, p.out, HH, dry);
      break;
    case 4:
      if (L == 0) even_pre(p, smem); else odd_pre(p, smem);
      break;
    case 5: {
      const int vb = __builtin_amdgcn_readfirstlane(threadIdx.x >> 8);
      for (int blk = real_bid(); blk < 256; blk += (int)gridDim.x) {
        if (L == 0) {
          { const int xcd_ = blk & 7, j_ = blk >> 3; const int tsk = (xcd_ * 2 + (j_ >> 4)) * 16 + (j_ & 15);
            if (vb == 0) scan_task<1>(p, tsk, smem, dry); else scan_task<0>(p, tsk, smem, dry); }
        } else {
          rwkv_scan_pc(p, blk, gsm, dry);
        }
      }
      break;
    }
    case 6:
      if (L == 0) even_post(p); else odd_post(p, smem);
      break;
    case 8:
      row_phase(p.out, DMb, nwl + 3 * DM, 1.0f, nwl + 4 * DM, p.out, HH, dry);
      break;
    case 11:
      if (L == 0) {
        convert_weights(p, 1, (float*)smem);
        convert_small(p);
        row_phase(p.out, DMb, nwl + 5 * DM, 0.5f, nw + 6 * DM, p.out, HH, dry);
      } else {
        row_phase(p.out, DMb, nwl + 5 * DM, 0.5f, nullptr, p.out, nullptr, dry);
      }
      break;
  }
}

#define OFF_BAR (484 * MIB)
#define XB_TMO      128
#define XB_XCNT(j)  (256  + 64 * (j))
#define XB_XSUB(j)  (1280 + 64 * (j))
#define XB_XGEN(j)  (2304 + 64 * (j))
#define XB_TOP      3328
#define XB_TOPGEN   3392
#define XCD_BAR_WORDS 3456
#define XB_SPIN_CAP (1u << 18)
#define LAS __attribute__((address_space(3)))
__device__ __forceinline__ unsigned xb_ld(unsigned* p) { return __hip_atomic_load(p, __ATOMIC_RELAXED, __HIP_MEMORY_SCOPE_AGENT); }
__device__ __forceinline__ unsigned xb_add(unsigned* p, unsigned v) { return __hip_atomic_fetch_add(p, v, __ATOMIC_RELAXED, __HIP_MEMORY_SCOPE_AGENT); }
__device__ __forceinline__ unsigned xb_xcc_id() { return (unsigned)__builtin_amdgcn_s_getreg((3 << 11) | 20) & 0xFu; }
#define XB_SPIN(cond, bar) do { unsigned _sp = 0; while (cond) { __builtin_amdgcn_s_sleep(1); \
    if ((++_sp & 255u) == 0u) { if (xb_ld(&(bar)[XB_TMO])) break; if (_sp > XB_SPIN_CAP) { atomicAdd(&(bar)[XB_TMO], 1u); break; } } } } while (0)
struct XcdBarrier { unsigned* bar; unsigned x; volatile LAS unsigned* st; };
__device__ __forceinline__ XcdBarrier xcd_barrier_post(unsigned* bar, volatile LAS unsigned* st) {
  XcdBarrier b; b.bar = bar; b.x = xb_xcc_id(); b.st = st;
  if (threadIdx.x == 0) (void)xb_add(&bar[XB_XCNT(b.x)], 1u);
  return b;
}
__device__ __forceinline__ void xcd_barrier_complete(unsigned* bar, unsigned x, unsigned& nloc, unsigned& nx) {
  const unsigned G = gridDim.x * gridDim.y * gridDim.z;
  unsigned sum, cnt, mine, sp = 0u;
  for (;;) {
    sum = 0u; cnt = 0u; mine = 0u;
#pragma unroll
    for (unsigned j = 0; j < 16; ++j) { const unsigned c = xb_ld(&bar[XB_XCNT(j)]); sum += c; cnt += (c > 0u) ? 1u : 0u; mine = (j == x) ? c : mine; }
    if (sum == G) break;
    __builtin_amdgcn_s_sleep(1);
    if ((++sp & 255u) == 0u) { if (xb_ld(&bar[XB_TMO])) break; if (sp > XB_SPIN_CAP) { atomicAdd(&bar[XB_TMO], 1u); break; } }
  }
  nloc = mine > 0u ? mine : 1u; nx = cnt > 0u ? cnt : 1u;
}
__device__ __forceinline__ void xcd_barrier(const XcdBarrier& b) {
  asm volatile("s_waitcnt vmcnt(0)" ::: "memory");
  __syncthreads();
  if (threadIdx.x == 0) {
    unsigned* bar = b.bar;
    __builtin_amdgcn_s_waitcnt(0);
    unsigned nloc = b.st[0], nx = b.st[1];
    if (nloc == 0u) { xcd_barrier_complete(bar, b.x, nloc, nx); b.st[0] = nloc; b.st[1] = nx; }
    const unsigned old = xb_add(&bar[XB_XSUB(b.x)], 1u);
    const unsigned gen = old / nloc;
    if (old + 1u == (gen + 1u) * nloc) {
      __builtin_amdgcn_fence(__ATOMIC_RELEASE, "agent");
      asm volatile("s_waitcnt vmcnt(0)" ::: "memory");
      const unsigned og = xb_add(&bar[XB_TOP], 1u);
      const unsigned tg = og / nx;
      if (og + 1u == (tg + 1u) * nx) xb_add(&bar[XB_TOPGEN], 1u);
      else XB_SPIN(xb_ld(&bar[XB_TOPGEN]) == tg, bar);
      __builtin_amdgcn_fence(__ATOMIC_ACQUIRE, "agent");
      xb_add(&bar[XB_XGEN(b.x)], 1u);
      asm volatile("s_waitcnt vmcnt(0)" ::: "memory");
    } else {
      XB_SPIN(xb_ld(&bar[XB_XGEN(b.x)]) == gen, bar);
      __builtin_amdgcn_fence(__ATOMIC_ACQUIRE, "agent");
      asm volatile("s_waitcnt vmcnt(0)" ::: "memory");
    }
  }
  __syncthreads();
}

__global__ void __launch_bounds__(512, 2) mega_kernel(Params p, int ph0, int ph1, int dup_mask) {
  extern __shared__ __attribute__((aligned(16))) char smem[];
  __shared__ uint4 xb_words;
  cg::grid_group grid = cg::this_grid();
  if (threadIdx.x == 0) xb_words = make_uint4(0u, 0u, 0u, 0u);
  __syncthreads();
  XcdBarrier xb = xcd_barrier_post((unsigned*)(p.ws + OFF_BAR), (volatile LAS unsigned*)&xb_words);
  (void)dup_mask;
  for (int ph = ph0; ph < ph1; ph++) {
    run_phase(p, ph, smem, 0);
    if (ph + 1 < ph1) { if (ph1 < 0) grid.sync(); else xcd_barrier(xb); }
  }
}

extern "C" void kernel_launch(void* const* d_in, const int* in_sizes, int n_in, void* d_out, int out_size, void* d_ws,
                              size_t ws_size, hipStream_t stream) {
  static int grid_blocks = 0;
  if (!grid_blocks) {
    int dev = 0, cus = 0, per_cu = 0;
    hipGetDevice(&dev);
    hipDeviceGetAttribute(&cus, hipDeviceAttributeMultiprocessorCount, dev);
    hipFuncSetAttribute((const void*)mega_kernel, hipFuncAttributeMaxDynamicSharedMemorySize, 131072);
    hipOccupancyMaxActiveBlocksPerMultiprocessor(&per_cu, mega_kernel, 512, 131072);
    if (per_cu > 1) per_cu = 1;
    if (per_cu < 1) per_cu = 1;
    grid_blocks = cus * per_cu;
  }
  Params p{};
  for (int i = 0; i < 34; i++) p.in[i] = (const float*)d_in[i];
  p.out = (float*)d_out;
  p.ws = (char*)d_ws;
  int ph0 = 0, ph1 = NPHASE, dup = DUPMASK;
  void* args[] = {&p, &ph0, &ph1, &dup};
  hipMemsetAsync((char*)d_ws + OFF_BAR, 0, XCD_BAR_WORDS * sizeof(unsigned), stream);
  hipError_t e = hipLaunchCooperativeKernel((void*)mega_kernel, dim3(grid_blocks), dim3(512), args, 131072, stream);
  if (e != hipSuccess) fprintf(stderr, "cooperative launch failed: %s (grid %d)\n", hipGetErrorString(e), grid_blocks);
}
```
